# Optimizing an MI355X kernel written in HIP

```python
import math
import jax, jax.numpy as jnp
from jax import lax
import numpy as np

D_MODEL = 1024
BATCH = 16
SEQ = 256
DEPTH = 4
DEC_BATCH = 2
DEC_SEQ = 1024
PAST_LEN = 256

GRID_W = 64
N_MIXERS = 4
HEAD_DIM = 64
N_HEADS = D_MODEL // HEAD_DIM
N_KV = N_HEADS // 4
GQA_GROUP = N_HEADS // N_KV
DIFF_HEADS = D_MODEL // (2 * HEAD_DIM)
POOL_WINDOWS = (2, 4, 8, 16)
POOL_GROUPS = len(POOL_WINDOWS)
POOL_CH = D_MODEL // POOL_GROUPS
WINDOW = 128
Q_BLOCK = 128
D_FF = ((8 * D_MODEL // 3 + 127) // 128) * 128
CONV_W = 3
ROPE_THETA = 10000.0
EPS = 1e-6
NEG = -1e30
N_POOL = (DEPTH + 3) // 4
N_GQA = (DEPTH + 2) // 4
N_DIFF = (DEPTH + 1) // 4
N_WIN = DEPTH // 4

kernel_name = "hybrid_dit_prefix_ctx_step"

F32 = jnp.float32


def rmsnorm(x, g):
    xf = x.astype(F32)
    y = xf * lax.rsqrt(jnp.mean(xf * xf, axis=-1, keepdims=True) + EPS)
    return (y * g.astype(F32)).astype(x.dtype)


def modulation(cvec, w_mod, b_mod):
    m = jax.nn.silu(cvec) @ w_mod + b_mod
    return jnp.split(m, 6, axis=-1)


def modulate(h, shift, scale):
    return h * (1 + scale) + shift


def rope_tables(S):
    rows = S // GRID_W
    row = jnp.repeat(jnp.arange(rows), GRID_W).astype(F32)
    col = jnp.tile(jnp.arange(GRID_W), rows).astype(F32)
    half = HEAD_DIM // 2
    inv = ROPE_THETA ** (-jnp.arange(0, half, 2, dtype=F32) / half)
    ang = jnp.stack([row[:, None] * inv, col[:, None] * inv], axis=1)
    return jnp.cos(ang), jnp.sin(ang)


def apply_rope(x, cos, sin):
    shp = x.shape
    xa = x.astype(F32).reshape(shp[:-1] + (2, 2, HEAD_DIM // 4))
    x1, x2 = xa[..., 0, :], xa[..., 1, :]
    bshape = (shp[1],) + (1,) * (x.ndim - 3) + (2, HEAD_DIM // 4)
    cs, sn = cos.reshape(bshape), sin.reshape(bshape)
    out = jnp.stack([x1 * cs - x2 * sn, x2 * cs + x1 * sn], axis=-2)
    return out.reshape(shp).astype(x.dtype)


def pool_mix(h, w_pool, scale):
    B, S, D = h.shape
    hf = h.astype(F32)
    cs = jnp.concatenate([jnp.zeros((B, 1, D), F32), jnp.cumsum(hf, axis=1)], axis=1)
    t = jnp.arange(S)
    outs = []
    for g, w in enumerate(POOL_WINDOWS):
        lo = jnp.clip(t - w // 2, 0, S)
        hi = jnp.clip(t - w // 2 + w, 0, S)
        sl = slice(g * POOL_CH, (g + 1) * POOL_CH)
        csg = cs[:, :, sl]
        cnt = (hi - lo).astype(F32)[None, :, None]
        pooled = (csg[:, hi] - csg[:, lo]) / cnt - hf[:, :, sl]
        outs.append(pooled.astype(h.dtype) @ w_pool[g])
    return jnp.concatenate(outs, axis=-1) * scale


def conv_ffn(h, w_in, conv_w, conv_b, w_out):
    u = h @ w_in
    up = jnp.pad(u, ((0, 0), (1, 1), (0, 0)))
    uc = up[:, :-2] * conv_w[0] + up[:, 1:-1] * conv_w[1] + up[:, 2:] * conv_w[2] + conv_b
    a, b = jnp.split(uc, 2, axis=-1)
    return (jax.nn.silu(a) * b) @ w_out


def gqa_proj(h, w_qkv, qn, kn):
    B, S, _ = h.shape
    qkv = h @ w_qkv
    nq, nk = N_HEADS * HEAD_DIM, N_KV * HEAD_DIM
    q = qkv[..., :nq].reshape(B, S, N_HEADS, HEAD_DIM)
    k = qkv[..., nq:nq + nk].reshape(B, S, N_KV, HEAD_DIM)
    v = qkv[..., nq + nk:].reshape(B, S, N_KV, HEAD_DIM)
    return rmsnorm(q, qn), rmsnorm(k, kn), v


def gqa_attend(q, k, v, sink=None):
    B, S, H, Dh = q.shape
    nb = S // Q_BLOCK
    qb = q.reshape(B, nb, Q_BLOCK, N_KV, GQA_GROUP, Dh).transpose(1, 0, 2, 3, 4, 5)
    scale = Dh ** -0.5

    def one(qblk):
        s = jnp.einsum('bqkgd,blkd->bkgql', qblk, k).astype(F32) * scale
        if sink is not None:
            col = jnp.broadcast_to(sink.astype(F32).reshape(1, N_KV, GQA_GROUP, 1, 1), s.shape[:-1] + (1,))
            p = jax.nn.softmax(jnp.concatenate([s, col], axis=-1), axis=-1)[..., :-1]
        else:
            p = jax.nn.softmax(s, axis=-1)
        return jnp.einsum('bkgql,blkd->bqkgd', p.astype(v.dtype), v)

    o = lax.map(one, qb)
    return o.transpose(1, 0, 2, 3, 4, 5).reshape(B, S, H * Dh)


def window_attend(q, k_lat, v_lat, k_ctx, v_ctx, sink):
    B, S, H, Dh = q.shape
    nb = S // Q_BLOCK
    scale = Dh ** -0.5

    def band(a):
        ap = jnp.pad(a, ((0, 0), (WINDOW, WINDOW), (0, 0), (0, 0)))
        ab = ap.reshape(B, nb + 2, Q_BLOCK, N_KV, Dh)
        return jnp.concatenate([ab[:, :-2], ab[:, 1:-1], ab[:, 2:]], axis=2)

    kw, vw = band(k_lat), band(v_lat)
    qb = q.reshape(B, nb, Q_BLOCK, N_KV, GQA_GROUP, Dh)
    s_loc = jnp.einsum('bnqkgd,bnlkd->bnkgql', qb, kw).astype(F32) * scale
    s_ctx = jnp.einsum('bnqkgd,blkd->bnkgql', qb, k_ctx).astype(F32) * scale
    qi = jnp.arange(Q_BLOCK)[:, None]
    kj = jnp.arange(3 * Q_BLOCK)[None, :]
    kpos = jnp.arange(nb)[:, None, None] * Q_BLOCK - Q_BLOCK + kj
    valid = (jnp.abs(kj - Q_BLOCK - qi) <= WINDOW)[None] & (kpos >= 0) & (kpos < S)
    s_loc = jnp.where(valid[None, :, None, None], s_loc, NEG)
    col = jnp.broadcast_to(sink.astype(F32).reshape(1, 1, N_KV, GQA_GROUP, 1, 1), s_loc.shape[:-1] + (1,))
    p = jax.nn.softmax(jnp.concatenate([s_loc, s_ctx, col], axis=-1), axis=-1)
    nl = 3 * Q_BLOCK
    p_loc = p[..., :nl].astype(v_lat.dtype)
    p_ctx = p[..., nl:-1].astype(v_lat.dtype)
    o = jnp.einsum('bnkgql,bnlkd->bnqkgd', p_loc, vw) + jnp.einsum('bnkgql,blkd->bnqkgd', p_ctx, v_ctx)
    return o.reshape(B, S, H * Dh)


def diff_proj(h, w_qkv, qn, kn):
    B, S, _ = h.shape
    qkv = h @ w_qkv
    q = qkv[..., :D_MODEL].reshape(B, S, DIFF_HEADS, 2, HEAD_DIM)
    k = qkv[..., D_MODEL:2 * D_MODEL].reshape(B, S, DIFF_HEADS, 2, HEAD_DIM)
    v = qkv[..., 2 * D_MODEL:].reshape(B, S, DIFF_HEADS, 2 * HEAD_DIM)
    return rmsnorm(q, qn), rmsnorm(k, kn), v


def diff_attend(q, k, v, lam):
    B, S, H, _, Dh = q.shape
    nb = S // Q_BLOCK
    qb = q.reshape(B, nb, Q_BLOCK, H, 2, Dh).transpose(1, 0, 2, 3, 4, 5)
    scale = Dh ** -0.5

    def one(qblk):
        s = jnp.einsum('bqhcd,blhcd->bhcql', qblk, k).astype(F32) * scale
        p = jax.nn.softmax(s, axis=-1)
        pd = p[:, :, 0] - lam * p[:, :, 1]
        return jnp.einsum('bhql,blhe->bqhe', pd.astype(v.dtype), v)

    o = lax.map(one, qb)
    return o.transpose(1, 0, 2, 3, 4).reshape(B, S, H, 2 * Dh)


def diff_lambda(lq1, lk1, lq2, lk2, lambda_init):
    return (jnp.exp(jnp.sum(lq1.astype(F32) * lk1.astype(F32)))
            - jnp.exp(jnp.sum(lq2.astype(F32) * lk2.astype(F32))) + lambda_init)


def diff_out(o, sub_g, lambda_init, w_o):
    B, S = o.shape[:2]
    o = rmsnorm(o, sub_g) * (1.0 - lambda_init)
    return o.reshape(B, S, D_MODEL) @ w_o


def setup_inputs(seed: int = 0) -> dict:
    key = jax.random.key(seed)
    ks = iter(jax.random.split(key, 64))
    nrm = lambda shape, s=1.0: jax.random.normal(next(ks), shape, F32) * s
    D, F = D_MODEL, D_FF
    return {
        "x_prompt": nrm((BATCH, SEQ, D)),
        "x_sample": nrm((DEC_BATCH, DEC_SEQ, D)),
        "cache_gqa_k": nrm((DEC_BATCH, N_GQA, PAST_LEN, N_KV, HEAD_DIM)),
        "cache_gqa_v": nrm((DEC_BATCH, N_GQA, PAST_LEN, N_KV, HEAD_DIM)),
        "cache_diff_k": nrm((DEC_BATCH, N_DIFF, PAST_LEN, DIFF_HEADS, 2, HEAD_DIM)),
        "cache_diff_v": nrm((DEC_BATCH, N_DIFF, PAST_LEN, DIFF_HEADS, 2 * HEAD_DIM)),
        "cache_win_k": nrm((DEC_BATCH, N_WIN, PAST_LEN, N_KV, HEAD_DIM)),
        "cache_win_v": nrm((DEC_BATCH, N_WIN, PAST_LEN, N_KV, HEAD_DIM)),
        "c": nrm((DEC_BATCH, D)),
        "c_ctx": nrm((D,)),
        "norm1_g": 1.0 + nrm((DEPTH, D), 0.05),
        "norm2_g": 1.0 + nrm((DEPTH, D), 0.05),
        "w_mod": nrm((DEPTH, D, 6 * D), 0.5 * D ** -0.5),
        "b_mod": nrm((DEPTH, 6 * D), 0.02),
        "ffn_w_in": nrm((DEPTH, D, 2 * F), D ** -0.5),
        "ffn_conv_w": nrm((DEPTH, CONV_W, 2 * F), CONV_W ** -0.5),
        "ffn_conv_b": nrm((DEPTH, 2 * F), 0.02),
        "ffn_w_out": nrm((DEPTH, F, D), F ** -0.5),
        "pool_w": nrm((N_POOL, POOL_GROUPS, POOL_CH, POOL_CH), POOL_CH ** -0.5),
        "pool_scale": 1.0 + nrm((N_POOL, D), 0.1),
        "gqa_w_qkv": nrm((N_GQA, D, (N_HEADS + 2 * N_KV) * HEAD_DIM), D ** -0.5),
        "gqa_q_norm": 1.0 + nrm((N_GQA, HEAD_DIM), 0.05),
        "gqa_k_norm": 1.0 + nrm((N_GQA, HEAD_DIM), 0.05),
        "gqa_w_o": nrm((N_GQA, N_HEADS * HEAD_DIM, D), (N_HEADS * HEAD_DIM) ** -0.5),
        "diff_w_qkv": nrm((N_DIFF, D, 3 * D), D ** -0.5),
        "diff_q_norm": 1.0 + nrm((N_DIFF, HEAD_DIM), 0.05),
        "diff_k_norm": 1.0 + nrm((N_DIFF, HEAD_DIM), 0.05),
        "diff_lambda_q1": nrm((N_DIFF, HEAD_DIM), 0.1),
        "diff_lambda_k1": nrm((N_DIFF, HEAD_DIM), 0.1),
        "diff_lambda_q2": nrm((N_DIFF, HEAD_DIM), 0.1),
        "diff_lambda_k2": nrm((N_DIFF, HEAD_DIM), 0.1),
        "diff_sub_norm": 1.0 + nrm((N_DIFF, 2 * HEAD_DIM), 0.05),
        "diff_w_o": nrm((N_DIFF, D, D), D ** -0.5),
        "win_w_qkv": nrm((N_WIN, D, (N_HEADS + 2 * N_KV) * HEAD_DIM), D ** -0.5),
        "win_q_norm": 1.0 + nrm((N_WIN, HEAD_DIM), 0.05),
        "win_k_norm": 1.0 + nrm((N_WIN, HEAD_DIM), 0.05),
        "win_sink": nrm((N_WIN, N_HEADS), 0.5),
        "win_w_o": nrm((N_WIN, N_HEADS * HEAD_DIM, D), (N_HEADS * HEAD_DIM) ** -0.5),
    }


def reference(x_prompt, x_sample, cache_gqa_k, cache_gqa_v, cache_diff_k, cache_diff_v,
              cache_win_k, cache_win_v, c, c_ctx, norm1_g, norm2_g, w_mod, b_mod,
              ffn_w_in, ffn_conv_w, ffn_conv_b, ffn_w_out, pool_w, pool_scale,
              gqa_w_qkv, gqa_q_norm, gqa_k_norm, gqa_w_o,
              diff_w_qkv, diff_q_norm, diff_k_norm, diff_lambda_q1, diff_lambda_k1,
              diff_lambda_q2, diff_lambda_k2, diff_sub_norm, diff_w_o,
              win_w_qkv, win_q_norm, win_k_norm, win_sink, win_w_o):
    xp, xs = x_prompt, x_sample
    cos, sin = rope_tables(xs.shape[1])
    gk, gv, dk, dv, wk, wv = [], [], [], [], [], []
    for i in range(DEPTH):
        m, j = i % N_MIXERS, i // N_MIXERS
        p_sh1, p_sc1, p_g1, p_sh2, p_sc2, p_g2 = modulation(c_ctx, w_mod[i], b_mod[i])
        s_sh1, s_sc1, s_g1, s_sh2, s_sc2, s_g2 = [t[:, None, :] for t in modulation(c, w_mod[i], b_mod[i])]
        hp = modulate(rmsnorm(xp, norm1_g[i]), p_sh1, p_sc1)
        hs = modulate(rmsnorm(xs, norm1_g[i]), s_sh1, s_sc1)
        if m == 0:
            op = pool_mix(hp, pool_w[j], pool_scale[j])
            os_ = pool_mix(hs, pool_w[j], pool_scale[j])
        elif m == 1:
            q, k, v = gqa_proj(hp, gqa_w_qkv[j], gqa_q_norm[j], gqa_k_norm[j])
            gk.append(k); gv.append(v)
            op = gqa_attend(q, k, v) @ gqa_w_o[j]
            q, k, v = gqa_proj(hs, gqa_w_qkv[j], gqa_q_norm[j], gqa_k_norm[j])
            q, k = apply_rope(q, cos, sin), apply_rope(k, cos, sin)
            k_all = jnp.concatenate([cache_gqa_k[:, j], k], axis=1)
            v_all = jnp.concatenate([cache_gqa_v[:, j], v], axis=1)
            os_ = gqa_attend(q, k_all, v_all) @ gqa_w_o[j]
        elif m == 2:
            lam_init = 0.8 - 0.6 * math.exp(-0.3 * i)
            lam = diff_lambda(diff_lambda_q1[j], diff_lambda_k1[j], diff_lambda_q2[j], diff_lambda_k2[j], lam_init)
            q, k, v = diff_proj(hp, diff_w_qkv[j], diff_q_norm[j], diff_k_norm[j])
            dk.append(k); dv.append(v)
            op = diff_out(diff_attend(q, k, v, lam), diff_sub_norm[j], lam_init, diff_w_o[j])
            q, k, v = diff_proj(hs, diff_w_qkv[j], diff_q_norm[j], diff_k_norm[j])
            q, k = apply_rope(q, cos, sin), apply_rope(k, cos, sin)
            k_all = jnp.concatenate([cache_diff_k[:, j], k], axis=1)
            v_all = jnp.concatenate([cache_diff_v[:, j], v], axis=1)
            os_ = diff_out(diff_attend(q, k_all, v_all, lam), diff_sub_norm[j], lam_init, diff_w_o[j])
        else:
            q, k, v = gqa_proj(hp, win_w_qkv[j], win_q_norm[j], win_k_norm[j])
            wk.append(k); wv.append(v)
            op = gqa_attend(q, k, v, win_sink[j]) @ win_w_o[j]
            q, k, v = gqa_proj(hs, win_w_qkv[j], win_q_norm[j], win_k_norm[j])
            q, k = apply_rope(q, cos, sin), apply_rope(k, cos, sin)
            os_ = window_attend(q, k, v, cache_win_k[:, j], cache_win_v[:, j], win_sink[j]) @ win_w_o[j]
        xp = xp + p_g1 * op
        xs = xs + s_g1 * os_
        hp = modulate(rmsnorm(xp, norm2_g[i]), p_sh2, p_sc2)
        hs = modulate(rmsnorm(xs, norm2_g[i]), s_sh2, s_sc2)
        xp = xp + p_g2 * conv_ffn(hp, ffn_w_in[i], ffn_conv_w[i], ffn_conv_b[i], ffn_w_out[i])
        xs = xs + s_g2 * conv_ffn(hs, ffn_w_in[i], ffn_conv_w[i], ffn_conv_b[i], ffn_w_out[i])
    new_gqa_k = jnp.stack(gk, axis=1)
    new_gqa_v = jnp.stack(gv, axis=1)
    new_diff_k = jnp.stack(dk, axis=1)
    new_diff_v = jnp.stack(dv, axis=1)
    new_win_k = jnp.stack(wk, axis=1)
    new_win_v = jnp.stack(wv, axis=1)
    return (xp, xs, new_gqa_k, new_gqa_v, new_diff_k, new_diff_v, new_win_k, new_win_v)
```

```cpp
#ifndef HOST_EMU
#include <hip/hip_runtime.h>
#include <hip/hip_cooperative_groups.h>
#include <cstdio>
#include <cstdint>
#include <cmath>
namespace cg = cooperative_groups;
#endif

#ifndef CFG_BATCH
#define CFG_BATCH 16
#endif
#ifndef ATT_FIXED_REF
#define ATT_FIXED_REF 1
#endif
#ifndef BG_QUEUE
#define BG_QUEUE 0
#endif
#ifndef FUSE_QKEPI
#define FUSE_QKEPI 1
#endif
#ifndef FUSE_QKPOST
#define FUSE_QKPOST 0
#endif
#ifndef FUSE_CONV
#define FUSE_CONV 1
#endif
#ifndef CFG_DFF
#define CFG_DFF 2816
#endif

namespace cfg {
constexpr int D = 1024, BATCH = CFG_BATCH, SEQ = 256, DEC_BATCH = 2, DEC_SEQ = 1024, PAST = 256;
constexpr int TCTX = BATCH * SEQ, TLAT = DEC_BATCH * DEC_SEQ, T = TCTX + TLAT;
constexpr int DFF = CFG_DFF, DFF2 = 2 * DFF;
constexpr int NCOND = 3, MODW = 6 * D;
constexpr float EPS = 1e-6f;
}
using namespace cfg;

typedef unsigned short bf16_t;
#ifdef HOST_EMU
static inline float bf2f(bf16_t v) { unsigned u = (unsigned)v << 16; float f; memcpy(&f, &u, 4); return f; }
static inline bf16_t f2bf(float f) { unsigned u; memcpy(&u, &f, 4); return (bf16_t)((u + 0x7fffu + ((u >> 16) & 1u)) >> 16); }
#else
__device__ __forceinline__ float bf2f(bf16_t v) { return __uint_as_float((unsigned)v << 16); }
__device__ __forceinline__ bf16_t f2bf(float f) { unsigned u = __float_as_uint(f); return (bf16_t)((u + 0x7fffu + ((u >> 16) & 1u)) >> 16); }
#endif

__device__ __forceinline__ int tok_cond(int t) { return t < TCTX ? 0 : 1 + (t - TCTX) / DEC_SEQ; }
__device__ __forceinline__ void tok_seq(int t, int& s0, int& L) {
  if (t < TCTX) { s0 = (t / SEQ) * SEQ; L = SEQ; } else { s0 = TCTX + ((t - TCTX) / DEC_SEQ) * DEC_SEQ; L = DEC_SEQ; }
}
__device__ __forceinline__ float silu_f(float x) { return x / (1.0f + expf(-x)); }

#ifdef HOST_EMU
static inline long opaque_tid() { return (long)blockIdx.x * blockDim.x + threadIdx.x; }
#else
__device__ __forceinline__ long opaque_tid() { int t = (int)(blockIdx.x * blockDim.x + threadIdx.x); asm volatile("" : "+v"(t)); return (long)t; }
#endif
#define GRID_STRIDE(idx, total) \
  for (long idx = opaque_tid(), _gs = (long)gridDim.x * blockDim.x; idx < (long)(total); idx += _gs)

__device__ void nk_copy_x(const float* xp, const float* xs, float* X) {
  GRID_STRIDE(i, (long)T * D) X[i] = i < (long)TCTX * D ? xp[i] : xs[i - (long)TCTX * D];
}

__device__ void nk_mod(const float* c, const float* c_ctx, const float* w_mod, const float* b_mod, float* MOD, int nlayer) {
  GRID_STRIDE(i, (long)nlayer * NCOND * MODW) {
    const int n = (int)(i % MODW), cd = (int)((i / MODW) % NCOND), l = (int)(i / ((long)MODW * NCOND));
    const float* cv = cd == 0 ? c_ctx : c + (cd - 1) * D;
    const float* w = w_mod + (long)l * D * MODW + n;
    float acc = 0.f;
    for (int k = 0; k < D; ++k) acc += silu_f(cv[k]) * w[(long)k * MODW];
    MOD[i] = acc + b_mod[(long)l * MODW + n];
  }
}

__device__ void nk_rope_table(float* ROPE) {
  GRID_STRIDE(i, (long)DEC_SEQ * 32) {
    const int pos = (int)(i / 32), a = (int)((i / 16) % 2), f = (int)(i % 16);
    const float inv = powf(10000.0f, -(float)(2 * f) / 32.0f), ang = (a == 0 ? (float)(pos / 64) : (float)(pos % 64)) * inv;
    ROPE[2 * i] = cosf(ang); ROPE[2 * i + 1] = sinf(ang);
  }
}

__device__ void nk_wt(const float* W, int K, int N, bf16_t* WT) {
  GRID_STRIDE(i, (long)K * N) { const int n = (int)(i / K), k = (int)(i % K); WT[i] = f2bf(W[(long)k * N + n]); }
}

__device__ void nk_rstd(const float* X, float* RSTD) {
  GRID_STRIDE(t, T) {
    const float* x = X + t * D; float ss = 0.f;
    for (int d = 0; d < D; ++d) ss += x[d] * x[d];
    RSTD[t] = 1.0f / sqrtf(ss / (float)D + EPS);
  }
}

__device__ void nk_normmod(const float* X, const float* RSTD, const float* g, const float* MODl, int sh_chunk, int sc_chunk, bf16_t* Hb) {
  GRID_STRIDE(i, (long)T * D) {
    const int t = (int)(i / D), d = (int)(i % D); const float* m = MODl + (long)tok_cond(t) * MODW;
    Hb[i] = f2bf(X[i] * RSTD[t] * g[d] * (1.0f + m[sc_chunk * D + d]) + m[sh_chunk * D + d]);
  }
}

__device__ void nk_gemm_bf(const bf16_t* A, int lda, const bf16_t* Bt, int ldb, bf16_t* C, int ldc, int M, int N, int K) {
  GRID_STRIDE(i, (long)M * N) {
    const int t = (int)(i / N), n = (int)(i % N); const bf16_t* a = A + (long)t * lda; const bf16_t* b = Bt + (long)n * ldb;
    float acc = 0.f;
    for (int k = 0; k < K; ++k) acc += bf2f(a[k]) * bf2f(b[k]);
    C[(long)t * ldc + n] = f2bf(acc);
  }
}

__device__ void nk_gemm_res(const bf16_t* A, int lda, int a_pn_step, const bf16_t* Bt, int ldb, float* X, int M, int N, int K,
                            const float* MODl, int gate_chunk, const float* colscale) {
  GRID_STRIDE(i, (long)M * N) {
    const int t = (int)(i / N), n = (int)(i % N); const bf16_t* a = A + (long)t * lda + (n / 256) * a_pn_step; const bf16_t* b = Bt + (long)n * ldb;
    float acc = 0.f;
    for (int k = 0; k < K; ++k) acc += bf2f(a[k]) * bf2f(b[k]);
    if (colscale) acc *= colscale[n];
    X[(long)t * D + n] += MODl[(long)tok_cond(t) * MODW + gate_chunk * D + n] * acc;
  }
}

__device__ void nk_pool(const bf16_t* Hb, bf16_t* PDb) {
  GRID_STRIDE(i, (long)T * D) {
    const int t = (int)(i / D), d = (int)(i % D), g = d / 256, w = 2 << g; int s0, L; tok_seq(t, s0, L);
    const int pos = t - s0; int lo = pos - w / 2, hi = pos - w / 2 + w; lo = lo < 0 ? 0 : lo; hi = hi > L ? L : hi;
    float s = 0.f;
    for (int j = lo; j < hi; ++j) s += bf2f(Hb[(long)(s0 + j) * D + d]);
    PDb[i] = f2bf(s / (float)(hi - lo) - bf2f(Hb[i]));
  }
}

__device__ void nk_qknorm_rope(bf16_t* QKV, int ld, int nq, int nk, int kcol0, const float* qn, const float* kn, float* kout) {
  GRID_STRIDE(i, (long)T * (nq + nk)) {
    const int t = (int)(i / (nq + nk)), s = (int)(i % (nq + nk));
    bf16_t* v = QKV + (long)t * ld + (s < nq ? s * 64 : kcol0 + (s - nq) * 64); const float* w = s < nq ? qn : kn;
    float ss = 0.f;
    for (int d = 0; d < 64; ++d) ss += bf2f(v[d]) * bf2f(v[d]);
    const float r = 1.0f / sqrtf(ss / 64.0f + EPS);
    if (t < TCTX) {
      for (int d = 0; d < 64; ++d) { const float y = bf2f(v[d]) * r * w[d]; v[d] = f2bf(y); if (s >= nq) kout[(long)t * (nk * 64) + (s - nq) * 64 + d] = y; }
    } else {
      const int pos = (t - TCTX) % DEC_SEQ; const float prow = (float)(pos / 64), pcol = (float)(pos % 64);
      for (int a = 0; a < 2; ++a)
        for (int f = 0; f < 16; ++f) {
          const float inv = powf(10000.0f, -(float)(2 * f) / 32.0f), ang = (a == 0 ? prow : pcol) * inv, cs = cosf(ang), sn = sinf(ang);
          const int i1 = a * 32 + f, i2 = a * 32 + 16 + f; const float x1 = bf2f(v[i1]) * r * w[i1], x2 = bf2f(v[i2]) * r * w[i2];
          v[i1] = f2bf(x1 * cs - x2 * sn); v[i2] = f2bf(x2 * cs + x1 * sn);
        }
    }
  }
}

__device__ void nk_copy_cols_f(const bf16_t* S, int ld, int col0, int width, int rows, float* out) {
  GRID_STRIDE(i, (long)rows * width) { const int t = (int)(i / width), j = (int)(i % width); out[i] = bf2f(S[(long)t * ld + col0 + j]); }
}

__device__ __forceinline__ float dot64_bb(const bf16_t* a, const bf16_t* b) {
  float s = 0.f;
  for (int d = 0; d < 64; ++d) s += bf2f(a[d]) * bf2f(b[d]);
  return s;
}
__device__ __forceinline__ float dot64_bf(const bf16_t* a, const float* b) {
  float s = 0.f;
  for (int d = 0; d < 64; ++d) s += bf2f(a[d]) * bf2f(f2bf(b[d]));
  return s;
}

template <int MODE>
__device__ void nk_attn(const bf16_t* QKV, int ld, int kcol0, int vcol0, const float* ck, const float* cv, int cld,
                        const float* sink, const float* lq1, const float* lk1, const float* lq2, const float* lk2, float lam_init, bf16_t* O) {
  GRID_STRIDE(i, (long)T * 64) {
    const int t = (int)(i / 64), r = (int)(i % 64); const bool lat = t >= TCTX; int s0, L; tok_seq(t, s0, L);
    const int b = lat ? (t - TCTX) / DEC_SEQ : 0, ncache = lat ? PAST : 0;
    int jlo = 0, jhi = L - 1;
    if (MODE == 1 && lat) { const int pos = t - s0; jlo = pos - 128 < 0 ? 0 : pos - 128; jhi = pos + 128 > L - 1 ? L - 1 : pos + 128; }
    if (MODE != 2) {
      const int h = r / 4, ch = r % 4, koff = (h / 4) * 64, voff = (h / 4) * 64 + ch * 16; const bf16_t* q = QKV + (long)t * ld + h * 64;
      float m = -3.0e38f;
      for (int p = 0; p < ncache; ++p) m = fmaxf(m, dot64_bf(q, ck + (long)(b * PAST + p) * cld + koff) * 0.125f);
      for (int j = jlo; j <= jhi; ++j) m = fmaxf(m, dot64_bb(q, QKV + (long)(s0 + j) * ld + kcol0 + koff) * 0.125f);
      if (MODE == 1) m = fmaxf(m, sink[h]);
      float sum = 0.f, o[16];
#pragma unroll
      for (int e = 0; e < 16; ++e) o[e] = 0.f;
      for (int p = 0; p < ncache; ++p) {
        const float pr = expf(dot64_bf(q, ck + (long)(b * PAST + p) * cld + koff) * 0.125f - m); sum += pr; const float* v = cv + (long)(b * PAST + p) * cld + voff;
#pragma unroll
        for (int e = 0; e < 16; ++e) o[e] += pr * v[e];
      }
      for (int j = jlo; j <= jhi; ++j) {
        const float pr = expf(dot64_bb(q, QKV + (long)(s0 + j) * ld + kcol0 + koff) * 0.125f - m); sum += pr; const bf16_t* v = QKV + (long)(s0 + j) * ld + vcol0 + voff;
#pragma unroll
        for (int e = 0; e < 16; ++e) o[e] += pr * bf2f(v[e]);
      }
      if (MODE == 1) sum += expf(sink[h] - m);
#pragma unroll
      for (int e = 0; e < 16; ++e) O[(long)t * D + h * 64 + ch * 16 + e] = f2bf(o[e] / sum);
    } else {
      float d1 = 0.f, d2 = 0.f;
      for (int d = 0; d < 64; ++d) { d1 += lq1[d] * lk1[d]; d2 += lq2[d] * lk2[d]; }
      const float lam = expf(d1) - expf(d2) + lam_init;
      const int hd = r / 8, ch = r % 8, voff = hd * 128 + ch * 16; float res[16];
#pragma unroll
      for (int e = 0; e < 16; ++e) res[e] = 0.f;
      for (int c = 0; c < 2; ++c) {
        const int koff = hd * 128 + c * 64; const bf16_t* q = QKV + (long)t * ld + koff;
        float m = -3.0e38f;
        for (int p = 0; p < ncache; ++p) m = fmaxf(m, dot64_bf(q, ck + (long)(b * PAST + p) * cld + koff) * 0.125f);
        for (int j = jlo; j <= jhi; ++j) m = fmaxf(m, dot64_bb(q, QKV + (long)(s0 + j) * ld + kcol0 + koff) * 0.125f);
        float sum = 0.f, o[16];
#pragma unroll
        for (int e = 0; e < 16; ++e) o[e] = 0.f;
        for (int p = 0; p < ncache; ++p) {
          const float pr = expf(dot64_bf(q, ck + (long)(b * PAST + p) * cld + koff) * 0.125f - m); sum += pr; const float* v = cv + (long)(b * PAST + p) * cld + voff;
#pragma unroll
          for (int e = 0; e < 16; ++e) o[e] += pr * v[e];
        }
        for (int j = jlo; j <= jhi; ++j) {
          const float pr = expf(dot64_bb(q, QKV + (long)(s0 + j) * ld + kcol0 + koff) * 0.125f - m); sum += pr; const bf16_t* v = QKV + (long)(s0 + j) * ld + vcol0 + voff;
#pragma unroll
          for (int e = 0; e < 16; ++e) o[e] += pr * bf2f(v[e]);
        }
        const float f = (c == 0 ? 1.0f : -lam) / sum;
#pragma unroll
        for (int e = 0; e < 16; ++e) res[e] += f * o[e];
      }
#pragma unroll
      for (int e = 0; e < 16; ++e) O[(long)t * D + voff + e] = f2bf(res[e]);
    }
  }
}

__device__ void nk_subnorm(bf16_t* O, const float* sub_g, float factor) {
  GRID_STRIDE(i, (long)T * 8) {
    bf16_t* o = O + i * 128; float ss = 0.f;
    for (int e = 0; e < 128; ++e) ss += bf2f(o[e]) * bf2f(o[e]);
    const float r = factor / sqrtf(ss / 128.0f + EPS);
    for (int e = 0; e < 128; ++e) o[e] = f2bf(bf2f(o[e]) * r * sub_g[e]);
  }
}

__device__ void nk_convgate(const bf16_t* U, const float* cw, const float* cb, bf16_t* G) {
  GRID_STRIDE(i, (long)T * DFF) {
    const int t = (int)(i / DFF), f = (int)(i % DFF); int s0, L; tok_seq(t, s0, L); const int pos = t - s0; float uc[2];
#pragma unroll
    for (int hf = 0; hf < 2; ++hf) {
      const int col = hf * DFF + f; const bf16_t* u = U + (long)t * DFF2 + col;
      float a = bf2f(u[0]) * cw[DFF2 + col] + cb[col];
      if (pos > 0) a += bf2f(u[-DFF2]) * cw[col];
      if (pos < L - 1) a += bf2f(u[DFF2]) * cw[2 * DFF2 + col];
      uc[hf] = a;
    }
    G[i] = f2bf(silu_f(uc[0]) * uc[1]);
  }
}

#ifndef HOST_EMU
#ifndef USE_ENGINE
#define USE_ENGINE 1
#endif
namespace pg8 {
#define PG8_LAS __attribute__((address_space(3)))
typedef unsigned short bf16_t;
typedef short bf16x8 __attribute__((ext_vector_type(8)));
typedef float f32x4 __attribute__((ext_vector_type(4)));
typedef unsigned u32x4 __attribute__((ext_vector_type(4)));
typedef unsigned u32x2v __attribute__((ext_vector_type(2)));
constexpr int BM = 256, BK = 64, HALF = 128, HTB = HALF * BK * 2  , STAGE_BYTES = 8 * HTB, NXCD = 8, WGM = 8;

__host__ __device__ __forceinline__ int lds_byte(int r, int c) { const int st = (r >> 4) * 2 + (c >> 5), rr = r & 15, cc = c & 31, ob = rr * 64 + cc * 2; return st * 1024 + (ob ^ (((ob >> 9) & 1) << 5)); }
__host__ __device__ __forceinline__ void stage_rc(int b, int& R, int& C) { const int st = b / 1024, sb = b % 1024, swz = sb ^ (((sb >> 9) & 1) << 5); R = (st >> 1) * 16 + swz / 64; C = (st & 1) * 32 + (swz % 64) / 2; }
__host__ __device__ __forceinline__ int perm32(int rho) { const int n = rho >> 4, i = rho & 15; return 8 * (i >> 2) + 4 * n + (i & 3); }

struct Unit { int pm, pn, kh; };
struct Gemm { const bf16_t* A; const bf16_t* Bt; int M, N, K, lda, ldb, a_pn_step, ksplit; };

struct StaticOrder {
    int nM, nN, nwg, G, c, ks;
    __host__ __device__ __forceinline__ void init(int M, int N, int G_, int c_, int ks_ = 1) { nM = M / BM; nN = (N / BM) * ks_; nwg = nM * nN; G = G_; c = c_; ks = ks_; }
    __host__ __device__ __forceinline__ bool next(int i, Unit& u) const {
        const long L = (long)i * G + c; if (L >= nwg) return false;
        int wgid = (int)L; { const int q = nwg / NXCD, r = nwg % NXCD, xcd = wgid % NXCD, off = wgid / NXCD; wgid = (xcd < r ? xcd * (q + 1) : r * (q + 1) + (xcd - r) * q) + off; }
        const int nig = WGM * nN, gid = wgid / nig, fm = gid * WGM, gsz = (nM - fm) < WGM ? (nM - fm) : WGM;
        u.pm = fm + ((wgid % nig) % gsz); const int pv = (wgid % nig) / gsz; u.kh = pv % ks; u.pn = pv / ks; return true;
    }
    __device__ __forceinline__ void a_ready(const Unit&) const {}
    __device__ __forceinline__ void done(const Unit&) const {}
};

__device__ __forceinline__ unsigned cvt_pk_bf16(float lo, float hi) { unsigned r; asm volatile("v_cvt_pk_bf16_f32 %0, %1, %2" : "=v"(r) : "v"(lo), "v"(hi)); return r; }
typedef float f32x2 __attribute__((ext_vector_type(2)));
__device__ __forceinline__ f32x2 gelu_pk(f32x2 v) {
    const f32x2 av = __builtin_elementwise_abs(v), d = av * 0.2316418882f + 1.0f;
    f32x2 t; t.x = __builtin_amdgcn_rcpf(d.x); t.y = __builtin_amdgcn_rcpf(d.y);
    f32x2 q = t * 0.5307027145f + (-0.7265760135f); q = q * t + 0.7107068705f; q = q * t + (-0.142248368f); q = q * t + 0.127414796f; q = q * t;
    const f32x2 s = (v * v) * (-0.72134752044f);
    f32x2 e; e.x = __builtin_amdgcn_exp2f(s.x); e.y = __builtin_amdgcn_exp2f(s.y);
    const f32x2 m = v * (q * e), r = v - m;
    f32x2 o; o.x = v.x < 0.f ? m.x : r.x; o.y = v.y < 0.f ? m.y : r.y; return o;
}

template <int ACT  > struct EpiBf16 {
    static constexpr bool PERM = true, AFTER_DRAIN = false; static_assert(ACT == 0 || ACT == 1, "EpiBf16: ACT is 0 (none) or 1 (gelu_pk)");
    bf16_t* O; int ldc; const float* bias; int split_cols; size_t split_stride; float scale0;
    __device__ __forceinline__ void operator()(const f32x4 (&acc)[2][2][4][2], const Unit& u, int wr, int wc, int fr, int fq) const {
        const int row0 = u.pm * BM + wr * 64 + fr; int colt = u.pn * BM; bf16_t* base = O;
        float sc = 1.f; if (split_cols) { const int t = colt / split_cols; base += (size_t)t * split_stride; colt -= t * split_cols; if (t == 0) sc = scale0; }
        const int col0 = colt + wc * 32 + 8 * fq, bcol0 = u.pn * BM + wc * 32 + 8 * fq;
        f32x4 bv[2][2];
#pragma unroll
        for (int bj = 0; bj < 2; ++bj)
#pragma unroll
            for (int n = 0; n < 2; ++n) bv[bj][n] = bias ? *(const f32x4*)(bias + bcol0 + bj * HALF + 4 * n) : (f32x4){0.f, 0.f, 0.f, 0.f};
#pragma unroll
        for (int ai = 0; ai < 2; ++ai)
#pragma unroll
            for (int m = 0; m < 4; ++m) { bf16_t* rowp = base + (size_t)(row0 + ai * HALF + m * 16) * ldc + col0;
#pragma unroll
                for (int bj = 0; bj < 2; ++bj) { f32x4 v0 = acc[ai][bj][m][0] + bv[bj][0], v1 = acc[ai][bj][m][1] + bv[bj][1];
                    if (ACT == 1) { f32x2 a = gelu_pk((f32x2){v0[0], v0[1]}), b = gelu_pk((f32x2){v0[2], v0[3]}), c = gelu_pk((f32x2){v1[0], v1[1]}), d = gelu_pk((f32x2){v1[2], v1[3]});
                        v0 = (f32x4){a.x, a.y, b.x, b.y}; v1 = (f32x4){c.x, c.y, d.x, d.y}; }
                    v0 = v0 * sc; v1 = v1 * sc; u32x4 w; w.x = cvt_pk_bf16(v0[0], v0[1]); w.y = cvt_pk_bf16(v0[2], v0[3]); w.z = cvt_pk_bf16(v1[0], v1[1]); w.w = cvt_pk_bf16(v1[2], v1[3]);
                    *(u32x4*)(rowp + bj * HALF) = w; } }
    }
};

struct EpiRes {
    static constexpr bool PERM = false, AFTER_DRAIN = false;
    float* X; const float* Xin_c; const float* Xin_l; const float* MODl; int gate_chunk; const float* colscale; const bf16_t* pend; bf16_t* slab;
    __device__ __forceinline__ void operator()(const f32x4 (&acc)[2][2][4][2], const Unit& u, int wr, int wc, int fr, int fq) const {
        const int row0 = u.pm * BM + wr * 64 + fr, col0 = u.pn * BM + wc * 32 + 4 * fq;
        const int trow = u.pm * BM; const int cond = trow < TCTX ? 0 : 1 + (trow - TCTX) / DEC_SEQ;
        const float* gate = MODl + (size_t)cond * MODW + gate_chunk * D;
        f32x4 gv[2][2];
#pragma unroll
        for (int bj = 0; bj < 2; ++bj)
#pragma unroll
            for (int n = 0; n < 2; ++n) { gv[bj][n] = *(const f32x4*)(gate + col0 + bj * HALF + n * 16); if (colscale) gv[bj][n] = gv[bj][n] * *(const f32x4*)(colscale + col0 + bj * HALF + n * 16); }
        if (u.kh == 0) {
#pragma unroll
          for (int ai = 0; ai < 2; ++ai)
#pragma unroll
            for (int m = 0; m < 4; ++m) { const size_t off = (size_t)(row0 + ai * HALF + m * 16) * D + col0;
#pragma unroll
                for (int bj = 0; bj < 2; ++bj)
#pragma unroll
                    for (int n = 0; n < 2; ++n) { f32x4* p = (f32x4*)(X + off + bj * HALF + n * 16); f32x4 v = *(const f32x4*)((trow < TCTX ? Xin_c : Xin_l) + off + bj * HALF + n * 16) + gv[bj][n] * acc[ai][bj][m][n];
                        if (pend) { const u32x2v q = *(const u32x2v*)(pend + off + bj * HALF + n * 16); v = v + (f32x4){__uint_as_float(q.x << 16), __uint_as_float(q.x & 0xffff0000u), __uint_as_float(q.y << 16), __uint_as_float(q.y & 0xffff0000u)}; }
                        *p = v; }
                asm volatile("" ::: "memory"); }
        } else {
#pragma unroll
          for (int ai = 0; ai < 2; ++ai)
#pragma unroll
            for (int m = 0; m < 4; ++m) { const size_t off = (size_t)(row0 + ai * HALF + m * 16) * D + col0;
#pragma unroll
                for (int bj = 0; bj < 2; ++bj)
#pragma unroll
                    for (int n = 0; n < 2; ++n) { const f32x4 v = gv[bj][n] * acc[ai][bj][m][n]; u32x2v q; q.x = cvt_pk_bf16(v[0], v[1]); q.y = cvt_pk_bf16(v[2], v[3]); *(u32x2v*)(slab + off + bj * HALF + n * 16) = q; } }
        }
    }
};

struct EpiConv {
    static constexpr bool PERM = true, AFTER_DRAIN = false;
    bf16_t* G; const float* cw; const float* cb; float* edgebuf; PG8_LAS unsigned* E;
    __device__ __forceinline__ static unsigned perm(unsigned v, int src4) { return (unsigned)__builtin_amdgcn_ds_bpermute(src4, (int)v); }
    __device__ __forceinline__ static float lo(unsigned u) { return __uint_as_float(u << 16); }
    __device__ __forceinline__ static float hi(unsigned u) { return __uint_as_float(u & 0xffff0000u); }
    __device__ __forceinline__ void operator()(const f32x4 (&acc)[2][2][4][2], const Unit& u, int wr, int wc, int fr_in, int fq_in) const {
        int fr = fr_in, fq = fq_in; asm volatile("" : "+v"(fr), "+v"(fq));
        const int lane = fq * 16 + fr, srcP4 = ((lane & 48) | ((fr + 15) & 15)) << 2, srcN4 = ((lane & 48) | ((fr + 1) & 15)) << 2;
        const int lc = wc * 32 + 8 * fq;
        unsigned pk[2][2][4][4];
#pragma unroll
        for (int ai = 0; ai < 2; ++ai)
#pragma unroll
          for (int bj = 0; bj < 2; ++bj)
#pragma unroll
            for (int m = 0; m < 4; ++m)
#pragma unroll
              for (int n = 0; n < 2; ++n) { const f32x4 v = acc[ai][bj][m][n]; pk[ai][bj][m][2 * n] = cvt_pk_bf16(v[0], v[1]); pk[ai][bj][m][2 * n + 1] = cvt_pk_bf16(v[2], v[3]); }
        if (fr == 0 || fr == 15) { const int which = fr == 0 ? 0 : 1;
#pragma unroll
          for (int ai = 0; ai < 2; ++ai)
#pragma unroll
            for (int bj = 0; bj < 2; ++bj) { u32x4 w;
              if (fr == 0) { w.x = pk[ai][bj][0][0]; w.y = pk[ai][bj][0][1]; w.z = pk[ai][bj][0][2]; w.w = pk[ai][bj][0][3]; } else { w.x = pk[ai][bj][3][0]; w.y = pk[ai][bj][3][1]; w.z = pk[ai][bj][3][2]; w.w = pk[ai][bj][3][3]; }
              *(PG8_LAS u32x4*)(E + (((ai * 2 + wr) * 2 + which) * 2 + bj) * 64 + (lc >> 1)) = w; } }
        if (u.pm * BM >= TCTX) { const bool top = (wr == 0 && fr < 2), bot = (wr == 1 && fr >= 14);
          if (top || bot) { const int r4 = top ? fr : fr - 12; float* eb = edgebuf + ((size_t)((u.pm - TCTX / BM) * (DFF / 128) + u.pn) * 4 + r4) * 256 + lc;
#pragma unroll
            for (int bj = 0; bj < 2; ++bj) { unsigned q0, q1, q2, q3;
              if (top) { q0 = pk[0][bj][0][0]; q1 = pk[0][bj][0][1]; q2 = pk[0][bj][0][2]; q3 = pk[0][bj][0][3]; } else { q0 = pk[1][bj][3][0]; q1 = pk[1][bj][3][1]; q2 = pk[1][bj][3][2]; q3 = pk[1][bj][3][3]; }
              *(f32x4*)(eb + bj * 128) = (f32x4){lo(q0), hi(q0), lo(q1), hi(q1)}; *(f32x4*)(eb + bj * 128 + 4) = (f32x4){lo(q2), hi(q2), lo(q3), hi(q3)}; } } }
        asm volatile("s_waitcnt lgkmcnt(0)" ::: "memory"); __builtin_amdgcn_s_barrier(); asm volatile("" ::: "memory");
        const int gcol = u.pn * 128 + lc;
#pragma unroll
        for (int ai = 0; ai < 2; ++ai) {
          float ca[4][8];
#pragma unroll
          for (int bj = 0; bj < 2; ++bj) {
            const int col = bj * DFF + gcol;
            float w0[8], w1[8], w2[8], bb[8];
#pragma unroll
            for (int e = 0; e < 8; e += 4) { const f32x4 a0 = *(const f32x4*)(cw + col + e), a1 = *(const f32x4*)(cw + DFF2 + col + e), a2 = *(const f32x4*)(cw + 2 * DFF2 + col + e), a3 = *(const f32x4*)(cb + col + e);
#pragma unroll
              for (int q = 0; q < 4; ++q) { w0[e + q] = a0[q]; w1[e + q] = a1[q]; w2[e + q] = a2[q]; bb[e + q] = a3[q]; } }
            u32x4 eP = (u32x4){0u, 0u, 0u, 0u}, eN = (u32x4){0u, 0u, 0u, 0u};
            if (wr == 1) eP = *(const PG8_LAS u32x4*)(E + (((ai * 2 + 0) * 2 + 1) * 2 + bj) * 64 + (lc >> 1));
            else if (ai == 1) eP = *(const PG8_LAS u32x4*)(E + (((0 * 2 + 1) * 2 + 1) * 2 + bj) * 64 + (lc >> 1));
            if (wr == 0) eN = *(const PG8_LAS u32x4*)(E + (((ai * 2 + 1) * 2 + 0) * 2 + bj) * 64 + (lc >> 1));
            else if (ai == 0) eN = *(const PG8_LAS u32x4*)(E + (((1 * 2 + 0) * 2 + 0) * 2 + bj) * 64 + (lc >> 1));
            unsigned spm1[4] = {eP.x, eP.y, eP.z, eP.w}, sn0[4];
#pragma unroll
            for (int h = 0; h < 4; ++h) sn0[h] = perm(pk[ai][bj][0][h], srcN4);
#pragma unroll
            for (int m = 0; m < 4; ++m) {
              unsigned sp[4], sn1[4] = {eN.x, eN.y, eN.z, eN.w};
#pragma unroll
              for (int h = 0; h < 4; ++h) { sp[h] = perm(pk[ai][bj][m][h], srcP4); if (m < 3) sn1[h] = perm(pk[ai][bj][m < 3 ? m + 1 : 3][h], srcN4); }
#pragma unroll
              for (int h = 0; h < 4; ++h) {
                const unsigned pv = fr == 0 ? spm1[h] : sp[h], nx = fr == 15 ? sn1[h] : sn0[h], cu = pk[ai][bj][m][h];
                const float c0 = lo(cu) * w1[2 * h] + bb[2 * h] + lo(pv) * w0[2 * h] + lo(nx) * w2[2 * h];
                const float c1 = hi(cu) * w1[2 * h + 1] + bb[2 * h + 1] + hi(pv) * w0[2 * h + 1] + hi(nx) * w2[2 * h + 1];
                if (bj == 0) { ca[m][2 * h] = c0; ca[m][2 * h + 1] = c1; }
                else { ca[m][2 * h] = ca[m][2 * h] / (1.0f + __expf(-ca[m][2 * h])) * c0; ca[m][2 * h + 1] = ca[m][2 * h + 1] / (1.0f + __expf(-ca[m][2 * h + 1])) * c1; }
                spm1[h] = sp[h]; sn0[h] = sn1[h];
              }
              if (bj == 1) { u32x4 w; w.x = cvt_pk_bf16(ca[m][0], ca[m][1]); w.y = cvt_pk_bf16(ca[m][2], ca[m][3]); w.z = cvt_pk_bf16(ca[m][4], ca[m][5]); w.w = cvt_pk_bf16(ca[m][6], ca[m][7]);
                *(u32x4*)(G + (size_t)(u.pm * BM + ai * HALF + wr * 64 + m * 16 + fr) * DFF + gcol) = w; }
            }
            asm volatile("" ::: "memory");
          }
        }
    }
};

struct EpiQK {
    static constexpr bool PERM = true, AFTER_DRAIN = false;
    bf16_t* O; int ldc, kcol0, vcol0; const float* qn; const float* kn; const float* rope; float* kout; float* vout; int kow; PG8_LAS float* SS;
    __device__ __forceinline__ static float perm(float v, int src4) { return __int_as_float(__builtin_amdgcn_ds_bpermute(src4, __float_as_int(v))); }
    __device__ __forceinline__ void operator()(const f32x4 (&acc)[2][2][4][2], const Unit& u, int wr, int wc, int fr_in, int fq_in) const {
        int fr = fr_in, fq = fq_in; asm volatile("" : "+v"(fr), "+v"(fq));
        const int lane = fq * 16 + fr, x16 = (lane ^ 16) << 2, x32 = (lane ^ 32) << 2;
        const int colt = u.pn * BM, kind = colt < kcol0 ? 0 : (colt < vcol0 ? 1 : 2);
        const bool lat = u.pm * BM >= TCTX;
        float ss[2][2][4];
        if (kind != 2) {
#pragma unroll
          for (int ai = 0; ai < 2; ++ai)
#pragma unroll
            for (int bj = 0; bj < 2; ++bj)
#pragma unroll
              for (int m = 0; m < 4; ++m) { const f32x4 a0 = acc[ai][bj][m][0], a1 = acc[ai][bj][m][1];
                float t = (a0[0] * a0[0] + a0[1] * a0[1]) + (a0[2] * a0[2] + a0[3] * a0[3]) + (a1[0] * a1[0] + a1[1] * a1[1]) + (a1[2] * a1[2] + a1[3] * a1[3]);
                t += perm(t, x16); t += perm(t, x32); ss[ai][bj][m] = t;
                if (fq == 0) SS[(((wr * 4 + wc) * 2 + ai) * 2 + bj) * 64 + m * 16 + fr] = t; }
        }
        asm volatile("s_waitcnt lgkmcnt(0)" ::: "memory"); __builtin_amdgcn_s_barrier(); asm volatile("" ::: "memory");
        const int dh = 32 * (wc & 1) + 8 * fq;
        f32x4 w0 = (f32x4){1.f, 1.f, 1.f, 1.f}, w1 = w0;
        if (kind != 2) { const float* wp = (kind == 0 ? qn : kn) + dh; w0 = *(const f32x4*)wp; w1 = *(const f32x4*)(wp + 4); }
        const bool x2side = (fq & 2) != 0;
#pragma unroll
        for (int ai = 0; ai < 2; ++ai)
#pragma unroll
          for (int m = 0; m < 4; ++m) {
            const int row = u.pm * BM + ai * HALF + wr * 64 + m * 16 + fr;
#pragma unroll
            for (int bj = 0; bj < 2; ++bj) {
              float y[8]; { const f32x4 a0 = acc[ai][bj][m][0], a1 = acc[ai][bj][m][1]; y[0] = a0[0]; y[1] = a0[1]; y[2] = a0[2]; y[3] = a0[3]; y[4] = a1[0]; y[5] = a1[1]; y[6] = a1[2]; y[7] = a1[3]; }
              if (kind != 2) {
                const float tot = ss[ai][bj][m] + SS[(((wr * 4 + (wc ^ 1)) * 2 + ai) * 2 + bj) * 64 + m * 16 + fr];
                const float r = 1.0f / sqrtf(tot / 64.0f + EPS);
                y[0] *= r * w0[0]; y[1] *= r * w0[1]; y[2] *= r * w0[2]; y[3] *= r * w0[3]; y[4] *= r * w1[0]; y[5] *= r * w1[1]; y[6] *= r * w1[2]; y[7] *= r * w1[3];
                if (lat) { const int pos = (row - TCTX) % DEC_SEQ; const f32x4* tb = (const f32x4*)(rope + ((size_t)(pos * 2 + (wc & 1)) * 16 + 8 * (fq & 1)) * 2);
#pragma unroll
                  for (int e2 = 0; e2 < 4; ++e2) { const f32x4 cs = tb[e2]; const float p0 = perm(y[2 * e2], x32), p1 = perm(y[2 * e2 + 1], x32);
                    y[2 * e2] = x2side ? y[2 * e2] * cs[0] + p0 * cs[1] : y[2 * e2] * cs[0] - p0 * cs[1];
                    y[2 * e2 + 1] = x2side ? y[2 * e2 + 1] * cs[2] + p1 * cs[3] : y[2 * e2 + 1] * cs[2] - p1 * cs[3]; } }
              }
              const int cl = bj * HALF + wc * 32 + 8 * fq;
              u32x4 w; w.x = cvt_pk_bf16(y[0], y[1]); w.y = cvt_pk_bf16(y[2], y[3]); w.z = cvt_pk_bf16(y[4], y[5]); w.w = cvt_pk_bf16(y[6], y[7]);
              *(u32x4*)(O + (size_t)row * ldc + colt + cl) = w;
              if (!lat && kind != 0) { float* op = (kind == 1 ? kout + (size_t)row * kow + (colt - kcol0) : vout + (size_t)row * kow + (colt - vcol0)) + cl;
                *(f32x4*)op = (f32x4){y[0], y[1], y[2], y[3]}; *(f32x4*)(op + 4) = (f32x4){y[4], y[5], y[6], y[7]}; }
            }
            asm volatile("" ::: "memory");
          }
    }
};

template <class Epi, class Sched, bool ALIGN_EPI = false, bool SP2 = false>
__device__ __forceinline__ void gemm_phase(PG8_LAS unsigned char* lds, const Gemm g, const Sched& S, const Epi& E) {
    int tid_ = threadIdx.x; asm volatile("" : "+v"(tid_));
    const int tid = tid_, wid = __builtin_amdgcn_readfirstlane(tid >> 6), lane = tid & 63, wr = wid >> 2, wc = wid & 3, fr = lane & 15, fq = lane >> 4;
    const int K = g.K / g.ksplit, nt = K / BK;
    unsigned voffA[2], voffB[2];
#pragma unroll
    for (int i = 0; i < 2; ++i) { int R, C; stage_rc(tid * 16 + i * 8192, R, C); const int Rb = Epi::PERM ? ((R & ~31) + perm32(R & 31)) : R;
        voffA[i] = (unsigned)(R * g.lda + C) * 2u; voffB[i] = (unsigned)(Rb * g.ldb + C) * 2u; }
    const size_t kstep = (size_t)(BK * 2);
    const size_t hstepA = (size_t)HALF * g.lda * 2, hstepB = (size_t)HALF * g.ldb * 2;
    const size_t tstepA = 2 * hstepA, tstepB = 2 * hstepB, pnstepA = (size_t)g.a_pn_step * 2, khstep = (size_t)K * 2;
    const unsigned ldsw = (unsigned)wid * 1024u;
    const int aoff = lds_byte(wr * 64 + fr, fq * 8), boff = lds_byte(wc * 32 + fr, fq * 8);
#define PG8_SA(b, h) (((b) * 2 + (h)) * HTB)
#define PG8_SB(b, h) ((4 + (b) * 2 + (h)) * HTB)
#define PG8_STAGE(bufoff, gbase, voff) do { _Pragma("unroll") for (int _i = 0; _i < 2; ++_i) \
        __builtin_amdgcn_global_load_lds((const unsigned*)((const char*)(gbase) + (voff)[_i]), (PG8_LAS unsigned*)(lds + (bufoff) + ldsw + _i * 8192), 16, 0, 0); } while (0)
#define PG8_LDA(dst, b, h) do { _Pragma("unroll") for (int m = 0; m < 4; ++m) _Pragma("unroll") for (int k = 0; k < 2; ++k) dst[m][k] = *(const PG8_LAS bf16x8*)(lds + PG8_SA(b, h) + aoff + m * 2048 + k * 1024); } while (0)
#define PG8_LDB(dst, b, h) do { _Pragma("unroll") for (int n = 0; n < 2; ++n) _Pragma("unroll") for (int k = 0; k < 2; ++k) dst[n][k] = *(const PG8_LAS bf16x8*)(lds + PG8_SB(b, h) + boff + n * 2048 + k * 1024); } while (0)
#define PG8_MMA(ai, bj, At, Bt) do { __builtin_amdgcn_s_setprio(1); _Pragma("unroll") for (int m = 0; m < 4; ++m) _Pragma("unroll") for (int n = 0; n < 2; ++n) _Pragma("unroll") for (int k = 0; k < 2; ++k) \
        acc[ai][bj][m][n] = __builtin_amdgcn_mfma_f32_16x16x32_bf16(Bt[n][k], At[m][k], acc[ai][bj][m][n], 0, 0, 0); __builtin_amdgcn_s_setprio(0); } while (0)
#define PG8_WAIT_V(n) asm volatile("s_waitcnt vmcnt(" #n ")" ::: "memory")
#define PG8_WAIT_L(n) asm volatile("s_waitcnt lgkmcnt(" #n ")" ::: "memory")
#define PG8_BAR __builtin_amdgcn_s_barrier()
#define PG8_SCHED __builtin_amdgcn_sched_barrier(0)
    Unit cur, nxt; int ui = 0;
    if (!S.next(0, cur)) return;
    f32x4 acc[2][2][4][2];
#pragma unroll
    for (int a = 0; a < 2; ++a)
#pragma unroll
        for (int b = 0; b < 2; ++b)
#pragma unroll
            for (int m = 0; m < 4; ++m)
#pragma unroll
                for (int n = 0; n < 2; ++n) acc[a][b][m][n] = (f32x4){0.f, 0.f, 0.f, 0.f};
    bf16x8 At[4][2], B0[2][2], B1[2][2];
    const char* cA = (const char*)g.A + (size_t)cur.pm * tstepA + (size_t)cur.pn * pnstepA + (size_t)cur.kh * khstep; const char* cB = (const char*)g.Bt + (size_t)cur.pn * tstepB + (size_t)cur.kh * khstep;
    S.a_ready(cur);
    if constexpr (SP2) {
        PG8_STAGE(PG8_SB(0, 0), cB, voffB); PG8_STAGE(PG8_SB(0, 1), cB + hstepB, voffB); PG8_STAGE(PG8_SA(0, 0), cA, voffA); PG8_STAGE(PG8_SA(0, 1), cA + hstepA, voffA);
        if (wr == 1) PG8_BAR;
        PG8_WAIT_V(2); PG8_BAR;
        PG8_STAGE(PG8_SB(1, 0), cB + kstep, voffB); PG8_STAGE(PG8_SA(1, 0), cA + kstep, voffA); PG8_STAGE(PG8_SB(1, 1), cB + hstepB + kstep, voffB);
        PG8_WAIT_V(6); PG8_BAR;
    } else {
        PG8_STAGE(PG8_SB(0, 0), cB, voffB); PG8_STAGE(PG8_SA(0, 0), cA, voffA); PG8_STAGE(PG8_SB(0, 1), cB + hstepB, voffB); PG8_STAGE(PG8_SA(0, 1), cA + hstepA, voffA);
        if (wr == 1) PG8_BAR;
        PG8_WAIT_V(4); PG8_BAR;
        PG8_STAGE(PG8_SB(1, 0), cB + kstep, voffB); PG8_STAGE(PG8_SA(1, 0), cA + kstep, voffA); PG8_STAGE(PG8_SB(1, 1), cB + hstepB + kstep, voffB);
        PG8_WAIT_V(6); PG8_BAR;
    }
    for (;;) {
        const bool has_next = S.next(ui + 1, nxt);
        const char* nA = has_next ? (const char*)g.A + (size_t)nxt.pm * tstepA + (size_t)nxt.pn * pnstepA + (size_t)nxt.kh * khstep : cA; const char* nB = has_next ? (const char*)g.Bt + (size_t)nxt.pn * tstepB + (size_t)nxt.kh * khstep : cB;
        for (int t = 0; t < nt; t += 2) {
            const bool last = (t == nt - 2);
            const char* a1 = cA + (size_t)(t + 1) * kstep;
            const char* a2 = last ? nA : cA + (size_t)(t + 2) * kstep; const char* b2 = last ? nB : cB + (size_t)(t + 2) * kstep;
            const char* a3 = a2 + kstep; const char* b3 = b2 + kstep;
            if (last && has_next) S.a_ready(nxt);
            if constexpr (SP2) {
            PG8_LDB(B0, 0, 0); PG8_LDB(B1, 0, 1); PG8_SCHED; PG8_LDA(At, 0, 0); PG8_STAGE(PG8_SA(1, 1), a1 + hstepA, voffA);
            PG8_WAIT_V(8); PG8_WAIT_L(0); PG8_BAR; PG8_MMA(0, 0, At, B0); PG8_MMA(0, 1, At, B1); PG8_BAR; PG8_SCHED;
            PG8_LDA(At, 0, 1); PG8_STAGE(PG8_SB(0, 0), b2, voffB); PG8_STAGE(PG8_SB(0, 1), b2 + hstepB, voffB); PG8_STAGE(PG8_SA(0, 0), a2, voffA);
            PG8_WAIT_V(8); PG8_WAIT_L(0); PG8_BAR; PG8_MMA(1, 0, At, B0); PG8_MMA(1, 1, At, B1); PG8_BAR; PG8_SCHED;
            PG8_LDB(B0, 1, 0); PG8_LDB(B1, 1, 1); PG8_SCHED; PG8_LDA(At, 1, 0); PG8_STAGE(PG8_SA(0, 1), a2 + hstepA, voffA);
            PG8_WAIT_V(8); PG8_WAIT_L(0); PG8_BAR; PG8_MMA(0, 0, At, B0); PG8_MMA(0, 1, At, B1); PG8_BAR; PG8_SCHED;
            PG8_LDA(At, 1, 1); PG8_STAGE(PG8_SB(1, 0), b3, voffB); PG8_STAGE(PG8_SB(1, 1), b3 + hstepB, voffB); PG8_STAGE(PG8_SA(1, 0), a3, voffA);
            PG8_WAIT_V(8); PG8_WAIT_L(0); PG8_BAR; PG8_MMA(1, 0, At, B0); PG8_MMA(1, 1, At, B1); PG8_BAR; PG8_SCHED;
            } else {
            PG8_LDB(B0, 0, 0); PG8_SCHED; PG8_LDA(At, 0, 0); PG8_STAGE(PG8_SA(1, 1), a1 + hstepA, voffA);
            PG8_WAIT_L(8); PG8_BAR; PG8_WAIT_L(0); PG8_MMA(0, 0, At, B0); PG8_BAR; PG8_SCHED;
            PG8_LDB(B1, 0, 1); PG8_STAGE(PG8_SB(0, 0), b2, voffB);
            PG8_BAR; PG8_WAIT_L(0); PG8_MMA(0, 1, At, B1); PG8_BAR;
            PG8_LDA(At, 0, 1); PG8_STAGE(PG8_SA(0, 0), a2, voffA);
            PG8_BAR; PG8_WAIT_L(0); PG8_MMA(1, 0, At, B0); PG8_BAR; PG8_SCHED;
            PG8_STAGE(PG8_SB(0, 1), b2 + hstepB, voffB);
            PG8_WAIT_V(6); PG8_BAR; PG8_MMA(1, 1, At, B1); PG8_BAR;
            PG8_LDB(B0, 1, 0); PG8_SCHED; PG8_LDA(At, 1, 0); PG8_STAGE(PG8_SA(0, 1), a2 + hstepA, voffA);
            PG8_WAIT_L(8); PG8_BAR; PG8_WAIT_L(0); PG8_MMA(0, 0, At, B0); PG8_BAR; PG8_SCHED;
            PG8_LDB(B1, 1, 1); PG8_STAGE(PG8_SB(1, 0), b3, voffB);
            PG8_BAR; PG8_WAIT_L(0); PG8_MMA(0, 1, At, B1); PG8_BAR;
            PG8_LDA(At, 1, 1); PG8_STAGE(PG8_SA(1, 0), a3, voffA);
            PG8_BAR; PG8_WAIT_L(0); PG8_MMA(1, 0, At, B0); PG8_BAR; PG8_SCHED;
            PG8_STAGE(PG8_SB(1, 1), b3 + hstepB, voffB);
            PG8_WAIT_V(6); PG8_BAR; PG8_MMA(1, 1, At, B1); PG8_BAR;
            }
        }
        if constexpr (ALIGN_EPI) { if (wr == 0) PG8_BAR; }
        if constexpr (!Epi::AFTER_DRAIN) { E(acc, cur, wr, wc, fr, fq); S.done(cur); }
        if (!has_next) break;
#pragma unroll
        for (int a = 0; a < 2; ++a)
#pragma unroll
            for (int b = 0; b < 2; ++b)
#pragma unroll
                for (int m = 0; m < 4; ++m)
#pragma unroll
                    for (int n = 0; n < 2; ++n) acc[a][b][m][n] = (f32x4){0.f, 0.f, 0.f, 0.f};
        cur = nxt; cA = nA; cB = nB; ++ui;
        if constexpr (ALIGN_EPI) { if (wr == 1) PG8_BAR; }
    }
    PG8_WAIT_V(0);
    if constexpr (!ALIGN_EPI) { if (wr == 0) PG8_BAR; }
    PG8_BAR;
    if constexpr (Epi::AFTER_DRAIN) { E.fused(acc, cur, wr, wc, fr, fq, lds, wid, lane); S.done(cur); }
#undef PG8_SA
#undef PG8_SB
#undef PG8_STAGE
#undef PG8_LDA
#undef PG8_LDB
#undef PG8_MMA
#undef PG8_WAIT_V
#undef PG8_WAIT_L
#undef PG8_BAR
#undef PG8_SCHED
}
}
#endif

enum { I_XP, I_XS, I_CGK, I_CGV, I_CDK, I_CDV, I_CWK, I_CWV, I_C, I_CCTX, I_N1G, I_N2G, I_WMOD, I_BMOD, I_FWIN, I_FCW, I_FCB, I_FWOUT,
       I_POOLW, I_POOLS, I_GQKV, I_GQN, I_GKN, I_GWO, I_DQKV, I_DQN, I_DKN, I_DLQ1, I_DLK1, I_DLQ2, I_DLK2, I_DSUB, I_DWO,
       I_WQKV, I_WQN, I_WKN, I_WSINK, I_WWO, N_IN };
struct Params { const float* in[N_IN]; float* out; unsigned char* ws; };
#ifdef HOST_EMU
static inline const float* pin(const Params& P, int i) { return P.in[i]; }
#else
__device__ __forceinline__ const float* pin(const Params& P, int i) { asm volatile("" : "+s"(i)); return P.in[i]; }
#endif

constexpr size_t MiB = (size_t)1 << 20;
constexpr size_t WS_CTL = 1 * MiB + 576 * 1024, CTL_ZERO_BYTES = 16384;
constexpr size_t WS_EDGE = 1 * MiB + 640 * 1024;
constexpr size_t WS_MOD = 0, WS_RSTD = 1 * MiB, WS_ROPE = 1 * MiB + 256 * 1024;
constexpr size_t WS_WIN = 3 * MiB;
constexpr size_t WS_WOUT = WS_WIN + (size_t)4 * DFF2 * D * 2;
constexpr size_t WS_GQKV = WS_WOUT + (size_t)4 * D * DFF * 2;
constexpr size_t WS_GWO = WS_GQKV + (size_t)1536 * D * 2, WS_DQKV = WS_GWO + (size_t)D * D * 2, WS_DWO = WS_DQKV + (size_t)3072 * D * 2;
constexpr size_t WS_WQKV = WS_DWO + (size_t)D * D * 2, WS_WWO = WS_WQKV + (size_t)1536 * D * 2, WS_POOL = WS_WWO + (size_t)D * D * 2;
constexpr size_t WS_HB = WS_POOL + (size_t)1024 * 256 * 2;
constexpr size_t WS_UB = WS_HB + (size_t)T * D * 2;
constexpr size_t WS_QKV = WS_UB, WS_OB = WS_QKV + (size_t)T * 3072 * 2, WS_PD = WS_QKV;
constexpr size_t UB_BYTES = ((size_t)T * DFF2 * 2 > (size_t)T * 4096 * 2) ? (size_t)T * DFF2 * 2 : (size_t)T * 4096 * 2;
constexpr size_t WS_GB = WS_UB + UB_BYTES;
constexpr size_t WS_SA = WS_GB + (size_t)T * DFF * 2, WS_SB = WS_SA + (size_t)T * D * 4;
constexpr size_t WS_END = WS_SB + (size_t)T * D * 4;
static_assert(WS_END <= 256 * MiB, "d_ws map");

constexpr int STEPS_PER_LAYER = 13, N_PRE = 3, N_STEPS = N_PRE + 4 * STEPS_PER_LAYER;

struct Ctx {
  float* out_; unsigned char* ws_;
#ifdef HOST_EMU
  float* out_p() const { return out_; } unsigned char* ws_p() const { return ws_; }
#else
  __device__ __forceinline__ float* out_p() const { float* p = out_; asm volatile("" : "+s"(p)); return p; }
  __device__ __forceinline__ unsigned char* ws_p() const { unsigned char* p = ws_; asm volatile("" : "+s"(p)); return p; }
#endif
  __device__ __forceinline__ float* X() const { return out_p(); }
  __device__ __forceinline__ float* o_gk() const { return out_p() + (size_t)T * D; }
  __device__ __forceinline__ float* o_gv() const { return o_gk() + (size_t)TCTX * 256; }
  __device__ __forceinline__ float* o_dk() const { return o_gv() + (size_t)TCTX * 256; }
  __device__ __forceinline__ float* o_dv() const { return o_dk() + (size_t)TCTX * 1024; }
  __device__ __forceinline__ float* o_wk() const { return o_dv() + (size_t)TCTX * 1024; }
  __device__ __forceinline__ float* o_wv() const { return o_wk() + (size_t)TCTX * 256; }
  __device__ __forceinline__ float* MOD() const { return (float*)(ws_p() + WS_MOD); }
  __device__ __forceinline__ float* RSTD() const { return (float*)(ws_p() + WS_RSTD); }
  __device__ __forceinline__ float* ROPE() const { return (float*)(ws_p() + WS_ROPE); }
  __device__ __forceinline__ bf16_t* bf(size_t off) const { return (bf16_t*)(ws_p() + off); }
  __device__ __forceinline__ bf16_t* WinT() const { return bf(WS_WIN); }
  __device__ __forceinline__ bf16_t* WoutT() const { return bf(WS_WOUT); }
  __device__ __forceinline__ bf16_t* GqkvT() const { return bf(WS_GQKV); }
  __device__ __forceinline__ bf16_t* GwoT() const { return bf(WS_GWO); }
  __device__ __forceinline__ bf16_t* DqkvT() const { return bf(WS_DQKV); }
  __device__ __forceinline__ bf16_t* DwoT() const { return bf(WS_DWO); }
  __device__ __forceinline__ bf16_t* WqkvT() const { return bf(WS_WQKV); }
  __device__ __forceinline__ bf16_t* WwoT() const { return bf(WS_WWO); }
  __device__ __forceinline__ bf16_t* PoolT() const { return bf(WS_POOL); }
  __device__ __forceinline__ bf16_t* Hb() const { return bf(WS_HB); }
  __device__ __forceinline__ bf16_t* Ub() const { return bf(WS_UB); }
  __device__ __forceinline__ bf16_t* QKVb() const { return bf(WS_QKV); }
  __device__ __forceinline__ bf16_t* Ob() const { return bf(WS_OB); }
  __device__ __forceinline__ bf16_t* PDb() const { return bf(WS_PD); }
  __device__ __forceinline__ bf16_t* Gb() const { return bf(WS_GB); }
};
__device__ __forceinline__ Ctx make_ctx(const Params& P) { Ctx c; c.out_ = P.out; c.ws_ = P.ws; return c; }

#ifndef KSPLIT
#define KSPLIT 2
#endif
struct GemmDesc { const bf16_t* A; int lda, a_pn_step; const bf16_t* Bt; int ldb, N, K; bool res; bf16_t* C; int ldc; int gate_chunk; const float* colscale; int ksplit; };
__device__ __forceinline__ bool gemm_desc(int step, const Params& P, const Ctx& c, GemmDesc& g) {
  if (step < N_PRE) return false;
  const int l = (step - N_PRE) / STEPS_PER_LAYER, s = (step - N_PRE) % STEPS_PER_LAYER;
  g.a_pn_step = 0; g.colscale = nullptr; g.C = nullptr; g.ldc = 0; g.gate_chunk = 0; g.res = false; g.ksplit = 1;
  if (s == 2 && l != 0) { const int N = (l == 2) ? 3072 : 1536; g.A = c.Hb(); g.lda = D; g.Bt = c.bf(l == 1 ? WS_GQKV : (l == 2 ? WS_DQKV : WS_WQKV)); g.ldb = D; g.N = N; g.K = D; g.C = c.QKVb(); g.ldc = N; return true; }
  if (s == 7) {
    g.res = true; g.gate_chunk = 2;
    if (l == 0) { g.A = c.PDb(); g.lda = D; g.a_pn_step = 256; g.Bt = c.PoolT(); g.ldb = 256; g.N = D; g.K = 256; g.colscale = pin(P, I_POOLS); }
    else { g.A = c.Ob(); g.lda = D; g.Bt = c.bf(l == 1 ? WS_GWO : (l == 2 ? WS_DWO : WS_WWO)); g.ldb = D; g.N = D; g.K = D; g.ksplit = KSPLIT; }
    return true;
  }
  if (s == 10) { g.A = c.Hb(); g.lda = D; g.Bt = c.WinT() + (size_t)l * DFF2 * D; g.ldb = D; g.N = DFF2; g.K = D; g.C = c.Ub(); g.ldc = DFF2; return true; }
  if (s == 12) { g.res = true; g.gate_chunk = 5; g.A = c.Gb(); g.lda = DFF; g.Bt = c.WoutT() + (size_t)l * D * DFF; g.ldb = DFF; g.N = D; g.K = DFF; g.ksplit = (DFF % 256 == 0) ? KSPLIT : 1; return true; }
  return false;
}

__device__ __forceinline__ void naive_step(int step, const Params& P, const Ctx& c) {
#define IN(i) (pin(P, (i)))
  if (step == 0) { nk_copy_x(IN(I_XP), IN(I_XS), c.X()); return; }
  if (step == 1) { nk_mod(IN(I_C), IN(I_CCTX), IN(I_WMOD), IN(I_BMOD), c.MOD(), 4); nk_rope_table(c.ROPE()); return; }
  if (step == 2) {
    for (int l = 0; l < 4; ++l) { nk_wt(IN(I_FWIN) + (size_t)l * D * DFF2, D, DFF2, c.WinT() + (size_t)l * DFF2 * D); nk_wt(IN(I_FWOUT) + (size_t)l * DFF * D, DFF, D, c.WoutT() + (size_t)l * D * DFF); }
    nk_wt(IN(I_GQKV), D, 1536, c.GqkvT()); nk_wt(IN(I_GWO), D, D, c.GwoT()); nk_wt(IN(I_DQKV), D, 3072, c.DqkvT()); nk_wt(IN(I_DWO), D, D, c.DwoT());
    nk_wt(IN(I_WQKV), D, 1536, c.WqkvT()); nk_wt(IN(I_WWO), D, D, c.WwoT());
    for (int g = 0; g < 4; ++g) nk_wt(IN(I_POOLW) + g * 256 * 256, 256, 256, c.PoolT() + g * 256 * 256);
    return;
  }
  const int l = (step - N_PRE) / STEPS_PER_LAYER, s = (step - N_PRE) % STEPS_PER_LAYER;
  const float* MODl = c.MOD() + (long)l * NCOND * MODW;
  const bool gq = (l == 1 || l == 3);
  const float* qn = IN(l == 1 ? I_GQN : I_WQN); const float* kn = IN(l == 1 ? I_GKN : I_WKN);
  const float* ck = IN(l == 1 ? I_CGK : I_CWK); const float* cv = IN(l == 1 ? I_CGV : I_CWV);
  const float lam_init = 0.8f - 0.6f * expf(-0.3f * (float)l);
  GemmDesc g;
  if (gemm_desc(step, P, c, g)) {
    if (g.res) nk_gemm_res(g.A, g.lda, g.a_pn_step, g.Bt, g.ldb, c.X(), T, g.N, g.K, MODl, g.gate_chunk, g.colscale);
    else nk_gemm_bf(g.A, g.lda, g.Bt, g.ldb, g.C, g.ldc, T, g.N, g.K);
    return;
  }
  switch (s) {
    case 0: nk_rstd(c.X(), c.RSTD()); break;
    case 1: nk_normmod(c.X(), c.RSTD(), IN(I_N1G) + l * D, MODl, 0, 1, c.Hb()); break;
    case 2: if (l == 0) nk_pool(c.Hb(), c.PDb()); break;
    case 3:
      if (l == 0) break;
      if (gq) { nk_qknorm_rope(c.QKVb(), 1536, 16, 4, 1024, qn, kn, l == 1 ? c.o_gk() : c.o_wk()); nk_copy_cols_f(c.QKVb(), 1536, 1280, 256, TCTX, l == 1 ? c.o_gv() : c.o_wv()); }
      else { nk_qknorm_rope(c.QKVb(), 3072, 16, 16, 1024, IN(I_DQN), IN(I_DKN), c.o_dk()); nk_copy_cols_f(c.QKVb(), 3072, 2048, 1024, TCTX, c.o_dv()); }
      break;
    case 5:
      if (l == 0) break;
      if (l == 1) nk_attn<0>(c.QKVb(), 1536, 1024, 1280, ck, cv, 256, nullptr, nullptr, nullptr, nullptr, nullptr, 0.f, c.Ob());
      else if (l == 3) nk_attn<1>(c.QKVb(), 1536, 1024, 1280, ck, cv, 256, IN(I_WSINK), nullptr, nullptr, nullptr, nullptr, 0.f, c.Ob());
      else nk_attn<2>(c.QKVb(), 3072, 1024, 2048, IN(I_CDK), IN(I_CDV), 1024, nullptr, IN(I_DLQ1), IN(I_DLK1), IN(I_DLQ2), IN(I_DLK2), lam_init, c.Ob());
      break;
    case 6: if (l == 2) nk_subnorm(c.Ob(), IN(I_DSUB), 1.0f - lam_init); break;
    case 8: nk_rstd(c.X(), c.RSTD()); break;
    case 9: nk_normmod(c.X(), c.RSTD(), IN(I_N2G) + l * D, MODl, 3, 4, c.Hb()); break;
    case 11: nk_convgate(c.Ub(), IN(I_FCW) + (long)l * 3 * DFF2, IN(I_FCB) + (long)l * DFF2, c.Gb()); break;
    default: break;
  }
#undef IN
}
__device__ __forceinline__ bool step_is_noop(int step) {
  if (step < N_PRE) return false;
  const int l = (step - N_PRE) / STEPS_PER_LAYER, s = (step - N_PRE) % STEPS_PER_LAYER;
  if (s == 4) return true;
  if (l == 0 && (s == 3 || s == 5)) return true;
  if (l != 2 && s == 6) return true;
  return false;
}


#ifndef HOST_EMU
#define LAS __attribute__((address_space(3)))
typedef float f32x4 __attribute__((ext_vector_type(4)));
typedef float f32x2 __attribute__((ext_vector_type(2)));
typedef unsigned u32x4 __attribute__((ext_vector_type(4)));
typedef unsigned u32x2 __attribute__((ext_vector_type(2)));
typedef __bf16 bf16x2_t __attribute__((ext_vector_type(2)));
__device__ __forceinline__ unsigned pk_bf16(float lo, float hi) { f32x2 v = {lo, hi}; bf16x2_t b = __builtin_convertvector(v, bf16x2_t); return __builtin_bit_cast(unsigned, b); }
__device__ __forceinline__ float bf_lo(unsigned u) { return __uint_as_float(u << 16); }
__device__ __forceinline__ float bf_hi(unsigned u) { return __uint_as_float(u & 0xffff0000u); }
__device__ __forceinline__ int opaque_i(int v) { asm volatile("" : "+v"(v)); return v; }
__device__ __forceinline__ int opaque_block() { int b = (int)blockIdx.x; asm volatile("" : "+s"(b)); return b; }
__device__ __forceinline__ float shx(float v, int mask, int lane) { return __int_as_float(__builtin_amdgcn_ds_bpermute((lane ^ mask) << 2, __float_as_int(v))); }
__device__ __forceinline__ float wave_sum(float v, int lane) {
#pragma unroll
  for (int o = 1; o < 64; o <<= 1) v += shx(v, o, lane);
  return v;
}
struct WaveId { int lane, wave, gw, ngw; };
__device__ __forceinline__ WaveId wave_id() { WaveId w; const int tid = opaque_i((int)threadIdx.x); w.lane = tid & 63; w.wave = __builtin_amdgcn_readfirstlane(tid >> 6); w.gw = opaque_block() * 8 + w.wave; w.ngw = (int)gridDim.x * 8; return w; }

__device__ __forceinline__ void ph_norm(const float* Xc, const float* Xl, const bf16_t* pend, const float* g, const float* MODl, int sh_chunk, int sc_chunk, bf16_t* Hb) {
  const WaveId w = wave_id();
  for (int t = w.gw; t < T; t += w.ngw) {
    const f32x4* xr = (const f32x4*)((t < TCTX ? Xc : Xl) + (size_t)t * D) + w.lane;
    f32x4 v[4]; float ss = 0.f;
#pragma unroll
    for (int j = 0; j < 4; ++j) { v[j] = xr[64 * j]; if (pend) { const u32x2 q = ((const u32x2*)(pend + (size_t)t * D) + w.lane)[64 * j]; v[j] = v[j] + (f32x4){bf_lo(q.x), bf_hi(q.x), bf_lo(q.y), bf_hi(q.y)}; } ss += (v[j].x * v[j].x + v[j].y * v[j].y) + (v[j].z * v[j].z + v[j].w * v[j].w); }
    const float rstd = 1.0f / sqrtf(wave_sum(ss, w.lane) / (float)D + EPS);
    const float* m = MODl + (size_t)tok_cond(t) * MODW;
    u32x2* o = (u32x2*)(Hb + (size_t)t * D) + w.lane;
#pragma unroll
    for (int j = 0; j < 4; ++j) {
      const int col = 4 * w.lane + 256 * j;
      const f32x4 gg = *(const f32x4*)(g + col), sc = *(const f32x4*)(m + sc_chunk * D + col), sh = *(const f32x4*)(m + sh_chunk * D + col);
      const f32x4 y = v[j] * rstd * gg * (1.0f + sc) + sh;
      u32x2 pk; pk.x = pk_bf16(y.x, y.y); pk.y = pk_bf16(y.z, y.w); o[64 * j] = pk;
    }
  }
}

__device__ __forceinline__ void unpack8(const u32x4 r, float (&x)[8]) { x[0] = bf_lo(r.x); x[1] = bf_hi(r.x); x[2] = bf_lo(r.y); x[3] = bf_hi(r.y); x[4] = bf_lo(r.z); x[5] = bf_hi(r.z); x[6] = bf_lo(r.w); x[7] = bf_hi(r.w); }
__device__ __forceinline__ u32x4 pack8(const float (&y)[8]) { u32x4 r; r.x = pk_bf16(y[0], y[1]); r.y = pk_bf16(y[2], y[3]); r.z = pk_bf16(y[4], y[5]); r.w = pk_bf16(y[6], y[7]); return r; }

__device__ __forceinline__ void ph_pool(const bf16_t* Hb, bf16_t* PDb) {
  const int tid0 = (opaque_block() * 512 + opaque_i((int)threadIdx.x)), nth = (int)(gridDim.x * blockDim.x);
  for (int i = tid0; i < T * 128; i += nth) {
    const int t = i >> 7, c8 = i & 127, g = c8 >> 5, wdw = 2 << g; int s0, L; tok_seq(t, s0, L);
    const int pos = t - s0; int lo = pos - wdw / 2, hi = pos - wdw / 2 + wdw; lo = lo < 0 ? 0 : lo; hi = hi > L ? L : hi;
    float acc[8], x[8];
#pragma unroll
    for (int e = 0; e < 8; ++e) acc[e] = 0.f;
    for (int j = lo; j < hi; ++j) { unpack8(*(const u32x4*)(Hb + (size_t)(s0 + j) * D + 8 * c8), x);
#pragma unroll
      for (int e = 0; e < 8; ++e) acc[e] += x[e]; }
    unpack8(*(const u32x4*)(Hb + (size_t)t * D + 8 * c8), x);
    const float cnt = (float)(hi - lo); float y[8];
#pragma unroll
    for (int e = 0; e < 8; ++e) y[e] = acc[e] / cnt - x[e];
    *(u32x4*)(PDb + (size_t)t * D + 8 * c8) = pack8(y);
  }
}

__device__ __forceinline__ void ph_qkpost(bf16_t* QKV, int ld, int nq, int nk, int nv, int kcol0, int vcol0, const float* qn, const float* kn, const float* rope, float* kout, float* vout) {
  const WaveId w = wave_id(); const int NG = (nq + nk + nv) >> 3, sl = w.lane >> 3, j = w.lane & 7;
  for (int it = w.gw; it < T * NG; it += w.ngw) {
    const int t = it / NG, sg = it - t * NG, slot = sg * 8 + sl; const bool lat = t >= TCTX;
    const int kind = slot < nq ? 0 : (slot < nq + nk ? 1 : 2);
    const int col = kind == 0 ? slot * 64 : (kind == 1 ? kcol0 + (slot - nq) * 64 : vcol0 + (slot - nq - nk) * 64);
    bf16_t* p = QKV + (size_t)t * ld + col + 8 * j;
    float x[8], y[8]; unpack8(*(const u32x4*)p, x);
    float ss = 0.f;
#pragma unroll
    for (int e = 0; e < 8; ++e) ss += x[e] * x[e];
    ss += shx(ss, 1, w.lane); ss += shx(ss, 2, w.lane); ss += shx(ss, 4, w.lane);
    const float r = 1.0f / sqrtf(ss / 64.0f + EPS);
    const float* wp = (kind == 1 ? kn : qn) + 8 * j; const f32x4 w0 = *(const f32x4*)wp, w1 = *(const f32x4*)(wp + 4);
    y[0] = x[0] * r * w0.x; y[1] = x[1] * r * w0.y; y[2] = x[2] * r * w0.z; y[3] = x[3] * r * w0.w;
    y[4] = x[4] * r * w1.x; y[5] = x[5] * r * w1.y; y[6] = x[6] * r * w1.z; y[7] = x[7] * r * w1.w;
    if (lat) {
      const int pos = (t - TCTX) % DEC_SEQ, a = j >> 2; const f32x4* tb = (const f32x4*)(rope + ((size_t)(pos * 2 + a) * 16 + 8 * (j & 1)) * 2);
      const bool x2side = (j & 2) != 0;
#pragma unroll
      for (int e2 = 0; e2 < 4; ++e2) { const f32x4 cs = tb[e2];
        const float p0 = shx(y[2 * e2], 2, w.lane), p1 = shx(y[2 * e2 + 1], 2, w.lane);
        y[2 * e2] = x2side ? y[2 * e2] * cs.x + p0 * cs.y : y[2 * e2] * cs.x - p0 * cs.y;
        y[2 * e2 + 1] = x2side ? y[2 * e2 + 1] * cs.z + p1 * cs.w : y[2 * e2 + 1] * cs.z - p1 * cs.w; }
    }
    if (kind != 2) *(u32x4*)p = pack8(y);
    if (!lat) {
      if (kind == 1) { float* o = kout + (size_t)t * (nk * 64) + (slot - nq) * 64 + 8 * j; *(f32x4*)o = (f32x4){y[0], y[1], y[2], y[3]}; *(f32x4*)(o + 4) = (f32x4){y[4], y[5], y[6], y[7]}; }
      if (kind == 2) { float* o = vout + (size_t)t * (nv * 64) + (slot - nq - nk) * 64 + 8 * j; *(f32x4*)o = (f32x4){x[0], x[1], x[2], x[3]}; *(f32x4*)(o + 4) = (f32x4){x[4], x[5], x[6], x[7]}; }
    }
  }
}

__device__ __forceinline__ void ph_convgate(const bf16_t* U, const float* cw, const float* cb, bf16_t* G) {
  constexpr int NCG = DFF / 8, RC = 8;
  const int tid0 = (opaque_block() * 512 + opaque_i((int)threadIdx.x)), nth = (int)(gridDim.x * blockDim.x);
  for (int i = tid0; i < (T / RC) * NCG; i += nth) {
    const int rc = i / NCG, cg = i - rc * NCG, r0 = rc * RC; int s0, L; tok_seq(r0, s0, L); const int pos0 = r0 - s0;
    const bool has_prev = pos0 > 0, has_next = pos0 + RC < L;
    u32x4 raw[2][RC + 2];
#pragma unroll
    for (int hf = 0; hf < 2; ++hf) {
      const bf16_t* base = U + (size_t)r0 * DFF2 + hf * DFF + 8 * cg;
      raw[hf][0] = *(const u32x4*)(has_prev ? base - DFF2 : base);
#pragma unroll
      for (int k = 0; k < RC; ++k) raw[hf][k + 1] = *(const u32x4*)(base + (size_t)k * DFF2);
      raw[hf][RC + 1] = *(const u32x4*)(has_next ? base + (size_t)RC * DFF2 : base);
    }
    float w0[2][8], w1[2][8], w2[2][8], bb[2][8];
#pragma unroll
    for (int hf = 0; hf < 2; ++hf) { const int col = hf * DFF + 8 * cg;
#pragma unroll
      for (int e = 0; e < 8; e += 4) { const f32x4 a0 = *(const f32x4*)(cw + col + e), a1 = *(const f32x4*)(cw + DFF2 + col + e), a2 = *(const f32x4*)(cw + 2 * DFF2 + col + e), a3 = *(const f32x4*)(cb + col + e);
#pragma unroll
        for (int q = 0; q < 4; ++q) { w0[hf][e + q] = a0[q]; w1[hf][e + q] = a1[q]; w2[hf][e + q] = a2[q]; bb[hf][e + q] = a3[q]; } } }
    if (!has_prev) { raw[0][0] = (u32x4){0u, 0u, 0u, 0u}; raw[1][0] = (u32x4){0u, 0u, 0u, 0u}; }
    if (!has_next) { raw[0][RC + 1] = (u32x4){0u, 0u, 0u, 0u}; raw[1][RC + 1] = (u32x4){0u, 0u, 0u, 0u}; }
    float up[2][8], uc[2][8], un[2][8];
    unpack8(raw[0][0], up[0]); unpack8(raw[1][0], up[1]); unpack8(raw[0][1], uc[0]); unpack8(raw[1][1], uc[1]);
#pragma unroll
    for (int r = 0; r < RC; ++r) {
      unpack8(raw[0][r + 2], un[0]); unpack8(raw[1][r + 2], un[1]);
      float y[8];
#pragma unroll
      for (int e = 0; e < 8; ++e) {
        const float a = uc[0][e] * w1[0][e] + bb[0][e] + up[0][e] * w0[0][e] + un[0][e] * w2[0][e];
        const float b = uc[1][e] * w1[1][e] + bb[1][e] + up[1][e] * w0[1][e] + un[1][e] * w2[1][e];
        y[e] = a / (1.0f + __expf(-a)) * b;
      }
      *(u32x4*)(G + (size_t)(r0 + r) * DFF + 8 * cg) = pack8(y);
#pragma unroll
      for (int hf = 0; hf < 2; ++hf)
#pragma unroll
        for (int e = 0; e < 8; ++e) { up[hf][e] = uc[hf][e]; uc[hf][e] = un[hf][e]; }
    }
  }
}


__device__ __forceinline__ void ph_conv_fixup(const float* edgebuf, const float* cw, const float* cb, bf16_t* G) {
  const int tid0 = (opaque_block() * 512 + opaque_i((int)threadIdx.x)), nth = (int)(gridDim.x * blockDim.x);
  for (int i = tid0; i < 6 * DFF; i += nth) {
    const int sm = i / DFF, f = i - sm * DFF, tu = (sm / 3) * 4 + (sm % 3), pn = f >> 7, cc = f & 127;
    const float* eu = edgebuf + ((size_t)(tu * (DFF / 128) + pn) * 4) * 256 + cc; const float* el = edgebuf + ((size_t)((tu + 1) * (DFF / 128) + pn) * 4) * 256 + cc;
    float o[2][2];
#pragma unroll
    for (int bj = 0; bj < 2; ++bj) { const int col = bj * DFF + f; const float w0 = cw[col], w1 = cw[DFF2 + col], w2 = cw[2 * DFF2 + col], bb = cb[col];
      const float u254 = eu[2 * 256 + bj * 128], u255 = eu[3 * 256 + bj * 128], l0 = el[0 * 256 + bj * 128], l1 = el[1 * 256 + bj * 128];
      o[0][bj] = u255 * w1 + bb + u254 * w0 + l0 * w2; o[1][bj] = l0 * w1 + bb + u255 * w0 + l1 * w2; }
    const int rowU = TCTX + (tu + 1) * 256 - 1;
    G[(size_t)rowU * DFF + f] = (bf16_t)(pk_bf16(o[0][0] / (1.0f + __expf(-o[0][0])) * o[0][1], 0.f) & 0xffffu);
    G[(size_t)(rowU + 1) * DFF + f] = (bf16_t)(pk_bf16(o[1][0] / (1.0f + __expf(-o[1][0])) * o[1][1], 0.f) & 0xffffu);
  }
}

__device__ __forceinline__ void conv_fixup_unit(const float* edgebuf, const float* cw, const float* cb, bf16_t* G, int pm, int f0, int nf) {
  if (pm * 256 < TCTX) return;
  const int tl = pm - TCTX / 256, tid = opaque_i((int)threadIdx.x);
  const bool up = (tl & 3) != 0, dn = (tl & 3) != 3;
  for (int i = tid; i < nf; i += 512) {
    const int f = f0 + i, pn = f >> 7, cc = f & 127;
    const float* eo = edgebuf + ((size_t)(tl * (DFF / 128) + pn) * 4) * 256 + cc;
    float ga[2], gb[2];
#pragma unroll
    for (int bj = 0; bj < 2; ++bj) { const int col = bj * DFF + f; const float w0 = cw[col], w1 = cw[DFF2 + col], w2 = cw[2 * DFF2 + col], bb = cb[col];
      const float o0 = eo[0 * 256 + bj * 128], o1 = eo[1 * 256 + bj * 128], o254 = eo[2 * 256 + bj * 128], o255 = eo[3 * 256 + bj * 128];
      float pu = 0.f, nd = 0.f;
      if (up) pu = (eo - (size_t)(DFF / 128) * 4 * 256)[3 * 256 + bj * 128];
      if (dn) nd = (eo + (size_t)(DFF / 128) * 4 * 256)[0 * 256 + bj * 128];
      const float c0 = o0 * w1 + bb + pu * w0 + o1 * w2, c255 = o255 * w1 + bb + o254 * w0 + nd * w2;
      if (bj == 0) { ga[0] = c0; ga[1] = c255; } else { gb[0] = c0; gb[1] = c255; } }
    if (up) G[(size_t)(pm * 256) * DFF + f] = (bf16_t)(pk_bf16(ga[0] / (1.0f + __expf(-ga[0])) * gb[0], 0.f) & 0xffffu);
    if (dn) G[(size_t)(pm * 256 + 255) * DFF + f] = (bf16_t)(pk_bf16(ga[1] / (1.0f + __expf(-ga[1])) * gb[1], 0.f) & 0xffffu);
  }
}

__device__ __forceinline__ void transpose_item(const float* W, int K, int N, bf16_t* WT, LAS float* scr, int item, int lane, bool pair_ab = false) {
  const int nblk = N / 32, kb = item / nblk, nb = item % nblk, k0 = 64 * kb, n0 = 32 * nb;
  int r0 = n0; if (pair_ab) { const int half = n0 >= DFF ? 1 : 0, np = n0 - half * DFF; r0 = 256 * (np / 128) + 128 * half + np % 128; }
  { const int r8 = lane >> 3, c4 = lane & 7; f32x4 v[8];
#pragma unroll
    for (int i = 0; i < 8; ++i) v[i] = *(const f32x4*)(W + (size_t)(k0 + 8 * i + r8) * N + n0 + 4 * c4);
#pragma unroll
    for (int i = 0; i < 8; ++i) { LAS float* d = scr + (8 * i + r8) * 33 + 4 * c4; d[0] = v[i].x; d[1] = v[i].y; d[2] = v[i].z; d[3] = v[i].w; } }
  asm volatile("s_waitcnt lgkmcnt(0)" ::: "memory");
  const int c = lane & 7;
#pragma unroll
  for (int j = 0; j < 4; ++j) { const int n = (lane >> 3) + 8 * j; const LAS float* sp = scr + (8 * c) * 33 + n;
    u32x4 o; o.x = pk_bf16(sp[0 * 33], sp[1 * 33]); o.y = pk_bf16(sp[2 * 33], sp[3 * 33]); o.z = pk_bf16(sp[4 * 33], sp[5 * 33]); o.w = pk_bf16(sp[6 * 33], sp[7 * 33]);
    *(u32x4*)(WT + (size_t)(r0 + n) * K + k0 + 8 * c) = o; }
  asm volatile("s_waitcnt lgkmcnt(0)" ::: "memory");
}


constexpr int CI_IN = (D / 64) * (DFF2 / 32), CI_OUT = (DFF / 64) * (D / 32), CI_Q15 = (D / 64) * (1536 / 32), CI_Q30 = (D / 64) * (3072 / 32), CI_O = (D / 64) * (D / 32), CI_P = (256 / 64) * (256 / 32);
__device__ __forceinline__ constexpr int layer_items(int l) { return CI_IN + CI_OUT + (l == 0 ? 4 * CI_P : ((l == 2 ? CI_Q30 : CI_Q15) + CI_O)); }
__device__ __forceinline__ constexpr int bg_total_items() { return layer_items(1) + layer_items(2) + layer_items(3); }
__device__ __forceinline__ constexpr int bg_end_of_layer(int l) { return l <= 0 ? 0 : (l == 1 ? layer_items(1) : (l == 2 ? layer_items(1) + layer_items(2) : bg_total_items())); }
__device__ __forceinline__ void convert_item(const Params& P, const Ctx& c, LAS float* scr, int l, int r, int lane) {
  if (r < CI_IN) { transpose_item(pin(P, I_FWIN) + (size_t)l * D * DFF2, D, DFF2, c.WinT() + (size_t)l * DFF2 * D, scr, r, lane, FUSE_CONV != 0); return; } r -= CI_IN;
  if (r < CI_OUT) { transpose_item(pin(P, I_FWOUT) + (size_t)l * DFF * D, DFF, D, c.WoutT() + (size_t)l * D * DFF, scr, r, lane); return; } r -= CI_OUT;
  if (l == 0) { const int g = r / CI_P; transpose_item(pin(P, I_POOLW) + g * 256 * 256, 256, 256, c.PoolT() + g * 256 * 256, scr, r % CI_P, lane); return; }
  const int nq = l == 2 ? CI_Q30 : CI_Q15;
  if (r < nq) { transpose_item(pin(P, l == 1 ? I_GQKV : (l == 2 ? I_DQKV : I_WQKV)), D, l == 2 ? 3072 : 1536, c.bf(l == 1 ? WS_GQKV : (l == 2 ? WS_DQKV : WS_WQKV)), scr, r, lane); return; } r -= nq;
  transpose_item(pin(P, l == 1 ? I_GWO : (l == 2 ? I_DWO : I_WWO)), D, D, c.bf(l == 1 ? WS_GWO : (l == 2 ? WS_DWO : WS_WWO)), scr, r, lane);
}
__device__ __forceinline__ void bg_item(const Params& P, const Ctx& c, LAS float* scr, int q, int lane) {
  const int l = q < bg_end_of_layer(1) ? 1 : (q < bg_end_of_layer(2) ? 2 : 3);
  convert_item(P, c, scr, l, q - bg_end_of_layer(l - 1), lane);
}
__device__ __forceinline__ void bg_work(const Params& P, const Ctx& c, LAS unsigned char* lds, unsigned budget_ticks, int upto) {
  if (!BG_QUEUE) return;
  const WaveId w = wave_id(); LAS float* scr = (LAS float*)(lds + w.wave * 16384);
  unsigned* ctr = (unsigned*)(c.ws_p() + WS_CTL) + 3520;
  const unsigned long long t0 = __builtin_amdgcn_s_memrealtime();
  for (;;) {
    if (budget_ticks != 0xffffffffu && (unsigned)(__builtin_amdgcn_s_memrealtime() - t0) > budget_ticks) break;
    unsigned q = 0xffffffffu;
    if (w.lane == 0 && (int)__hip_atomic_load(ctr, __ATOMIC_RELAXED, __HIP_MEMORY_SCOPE_AGENT) < upto) q = __hip_atomic_fetch_add(ctr, 1u, __ATOMIC_RELAXED, __HIP_MEMORY_SCOPE_AGENT);
    q = (unsigned)__builtin_amdgcn_readfirstlane((int)q);
    if (q >= (unsigned)bg_total_items()) break;
    bg_item(P, c, scr, (int)q, w.lane);
  }
}

__device__ __forceinline__ void ph_prologue(const Params& P, const Ctx& c, LAS unsigned char* lds) {
  const WaveId w = wave_id(); const int tid = opaque_i((int)threadIdx.x);
  {
    LAS float* S = (LAS float*)lds;
    LAS float* red = (LAS float*)(lds + 12288);
    for (int i = tid; i < 3 * D; i += 512) { const int cd = i / D, k = i - cd * D; const float v = cd == 0 ? pin(P, I_CCTX)[k] : pin(P, I_C)[(cd - 1) * D + k]; S[i] = v / (1.0f + expf(-v)); }
    __syncthreads();
    for (int item = opaque_block(); item < 4 * 48; item += (int)gridDim.x) {
      const int l = item / 48, n0 = (item % 48) * 128, h = w.lane >> 5, n4 = w.lane & 31;
      const float* W = pin(P, I_WMOD) + (size_t)l * D * MODW + n0 + 4 * n4;
      f32x4 acc[3] = {{0.f, 0.f, 0.f, 0.f}, {0.f, 0.f, 0.f, 0.f}, {0.f, 0.f, 0.f, 0.f}};
#pragma unroll 8
      for (int i = 0; i < 64; ++i) { const int k = 128 * w.wave + 2 * i + h; const f32x4 wv = *(const f32x4*)(W + (size_t)k * MODW);
        acc[0] += S[k] * wv; acc[1] += S[D + k] * wv; acc[2] += S[2 * D + k] * wv; }
#pragma unroll
      for (int cd = 0; cd < 3; ++cd) { acc[cd].x += shx(acc[cd].x, 32, w.lane); acc[cd].y += shx(acc[cd].y, 32, w.lane); acc[cd].z += shx(acc[cd].z, 32, w.lane); acc[cd].w += shx(acc[cd].w, 32, w.lane); }
      if (h == 0) {
#pragma unroll
        for (int cd = 0; cd < 3; ++cd) *(LAS f32x4*)(red + (w.wave * 3 + cd) * 128 + 4 * n4) = acc[cd]; }
      __syncthreads();
      if (tid < 384) { const int cd = tid >> 7, nn = tid & 127; float sum = pin(P, I_BMOD)[(size_t)l * MODW + n0 + nn];
#pragma unroll
        for (int ww = 0; ww < 8; ++ww) sum += red[(ww * 3 + cd) * 128 + nn];
        c.MOD()[((size_t)l * NCOND + cd) * MODW + n0 + nn] = sum; }
      __syncthreads();
    }
  }
  for (int i = opaque_block() * 512 + tid; i < DEC_SEQ * 32; i += (int)gridDim.x * 512) {
    const int pos = i / 32, a = (i / 16) % 2, f = i % 16;
    const float inv = powf(10000.0f, -(float)(2 * f) / 32.0f), ang = (a == 0 ? (float)(pos / 64) : (float)(pos % 64)) * inv;
    c.ROPE()[2 * i] = cosf(ang); c.ROPE()[2 * i + 1] = sinf(ang);
  }
  __syncthreads();
  {
    LAS float* scr = (LAS float*)(lds + w.wave * 16384);
    const int nitems = BG_QUEUE ? layer_items(0) : layer_items(0) + bg_total_items();
    for (int it = w.gw; it < nitems; it += w.ngw) {
      if (it < layer_items(0)) convert_item(P, c, scr, 0, it, w.lane); else bg_item(P, c, scr, it - layer_items(0), w.lane);
    }
  }
  __syncthreads();
}
#endif


#ifndef HOST_EMU
namespace att {
typedef short bf16x8 __attribute__((ext_vector_type(8)));
typedef short s16x4 __attribute__((ext_vector_type(4)));
constexpr float SC = 0.125f * 1.4426950408889634f, LOG2E = 1.4426950408889634f, NEGBIG = -1.0e30f, REF2 = 16.0f;
constexpr int OFF_K = 0, OFF_V = 32768, OFF_COMB = 73728;
struct Args {
  const bf16_t* QKV; int ld, kcol0, vcol0; const float* ck; const float* cv; int cld; const float* sink;
  const float* lq1; const float* lk1; const float* lq2; const float* lk2; float lam_init; const float* sub_g; bf16_t* O;
  const float* qn; const float* kn; const float* rope; float* kout; float* vout;
};
__device__ __forceinline__ s16x4 tr_read(const LAS unsigned char* p) { return __builtin_bit_cast(s16x4, __builtin_amdgcn_ds_read_tr16_b64_v4i16((LAS s16x4*)p)); }

template <int MODE>
__device__ __forceinline__ void unit(const Args& A, bool lat, int b, int hh, int chunk, float lam, LAS unsigned char* lds) {
  constexpr int KW = MODE == 2 ? 128 : 64, NDB = KW / 16, KROWB = KW * 2, VROWB = KW * 2 + 32, RPU = MODE == 2 ? 64 : 32, CPR = KW / 8, NCH = CPR / 8;
  constexpr int KBUF = 16384, VBUF = 20480;
  const int tid = opaque_i((int)threadIdx.x), lane = tid & 63, wave = __builtin_amdgcn_readfirstlane(tid >> 6), c = lane & 15, g = lane >> 4;
  const int s0 = lat ? TCTX + b * DEC_SEQ : b * SEQ, L = lat ? DEC_SEQ : SEQ, p0 = chunk * RPU;
  const int qpos = p0 + (MODE == 2 ? (wave & 3) * 16 : (wave & 1) * 16) + c;
  const int map = MODE == 2 ? (wave >> 2) : 0;
  const int hcol = MODE == 2 ? hh * 128 + map * 64 : (hh * 4 + (wave >> 1)) * 64;
  const int kcol = A.kcol0 + hh * KW, vcol = A.vcol0 + hh * KW, ccol = hh * KW;
  const int ncache = lat ? PAST / 64 : 0;
  int tlo = 0, thi = L / 64 - 1;
  if (MODE == 1 && lat) { const int lo = p0 - 128 < 0 ? 0 : p0 - 128, hi = p0 + RPU - 1 + 128 > L - 1 ? L - 1 : p0 + RPU - 1 + 128; tlo = lo / 64; thi = hi / 64; }
  const int NT = ncache + (thi - tlo + 1);
  bf16x8 qf[2];
  { const bf16_t* qp = A.QKV + (size_t)(s0 + qpos) * A.ld + hcol + 8 * g; qf[0] = *(const bf16x8*)qp; qf[1] = *(const bf16x8*)(qp + 32); }
  if (FUSE_QKPOST) {
    float x[2][8]; unpack8(__builtin_bit_cast(u32x4, qf[0]), x[0]); unpack8(__builtin_bit_cast(u32x4, qf[1]), x[1]);
    float ss = 0.f;
#pragma unroll
    for (int ks = 0; ks < 2; ++ks)
#pragma unroll
      for (int e = 0; e < 8; ++e) ss += x[ks][e] * x[ks][e];
    ss += shx(ss, 16, lane); ss += shx(ss, 32, lane);
    const float r = 1.0f / sqrtf(ss / 64.0f + EPS);
#pragma unroll
    for (int ks = 0; ks < 2; ++ks) { const f32x4 w0 = *(const f32x4*)(A.qn + 32 * ks + 8 * g), w1 = *(const f32x4*)(A.qn + 32 * ks + 8 * g + 4);
      x[ks][0] *= r * w0.x; x[ks][1] *= r * w0.y; x[ks][2] *= r * w0.z; x[ks][3] *= r * w0.w; x[ks][4] *= r * w1.x; x[ks][5] *= r * w1.y; x[ks][6] *= r * w1.z; x[ks][7] *= r * w1.w; }
    if (lat) { const bool x2side = (g & 2) != 0;
#pragma unroll
      for (int ks = 0; ks < 2; ++ks) { const f32x4* tb = (const f32x4*)(A.rope + ((size_t)(qpos * 2 + ks) * 16 + 8 * (g & 1)) * 2);
#pragma unroll
        for (int e2 = 0; e2 < 4; ++e2) { const f32x4 cs = tb[e2]; const float p0 = shx(x[ks][2 * e2], 32, lane), p1 = shx(x[ks][2 * e2 + 1], 32, lane);
          x[ks][2 * e2] = x2side ? x[ks][2 * e2] * cs.x + p0 * cs.y : x[ks][2 * e2] * cs.x - p0 * cs.y;
          x[ks][2 * e2 + 1] = x2side ? x[ks][2 * e2 + 1] * cs.z + p1 * cs.w : x[ks][2 * e2 + 1] * cs.z - p1 * cs.w; } } }
    qf[0] = __builtin_bit_cast(bf16x8, pack8(x[0])); qf[1] = __builtin_bit_cast(bf16x8, pack8(x[1]));
  }
  f32x4 o[NDB];
#pragma unroll
  for (int db = 0; db < NDB; ++db) o[db] = (f32x4){0.f, 0.f, 0.f, 0.f};
  float m = NEGBIG, lsum = 0.f;
  f32x4 rkA[NCH][2], rvA[NCH][2], rkB[NCH][2], rvB[NCH][2];
  auto load_tileA = [&](int t) {
    if (t < ncache) {
#pragma unroll
      for (int i = 0; i < NCH; ++i) { const int id = tid + 512 * i, row = id / CPR, ch = id % CPR; const size_t off = (size_t)(b * PAST + t * 64 + row) * A.cld + ccol + ch * 8;
        rkA[i][0] = *(const f32x4*)(A.ck + off); rkA[i][1] = *(const f32x4*)(A.ck + off + 4); rvA[i][0] = *(const f32x4*)(A.cv + off); rvA[i][1] = *(const f32x4*)(A.cv + off + 4); }
    } else {
      const int r0 = s0 + (tlo + t - ncache) * 64;
#pragma unroll
      for (int i = 0; i < NCH; ++i) { const int id = tid + 512 * i, row = id / CPR, ch = id % CPR; const bf16_t* rp = A.QKV + (size_t)(r0 + row) * A.ld + ch * 8;
        rkA[i][0] = *(const f32x4*)(rp + kcol); rvA[i][0] = *(const f32x4*)(rp + vcol); }
    }
  };
  auto write_tileA = [&](int t, int buf) {
    LAS unsigned char* Kb = lds + OFF_K + buf * KBUF; LAS unsigned char* Vb = lds + OFF_V + buf * VBUF;
#pragma unroll
    for (int i = 0; i < NCH; ++i) { const int id = tid + 512 * i, row = id / CPR, ch = id % CPR;
      const int pch = KW == 64 ? (ch ^ ((row >> 1) & 7)) : (ch ^ (row & 15));
      u32x4 kq, vq;
      if (t < ncache) {
        kq.x = pk_bf16(rkA[i][0].x, rkA[i][0].y); kq.y = pk_bf16(rkA[i][0].z, rkA[i][0].w); kq.z = pk_bf16(rkA[i][1].x, rkA[i][1].y); kq.w = pk_bf16(rkA[i][1].z, rkA[i][1].w);
        vq.x = pk_bf16(rvA[i][0].x, rvA[i][0].y); vq.y = pk_bf16(rvA[i][0].z, rvA[i][0].w); vq.z = pk_bf16(rvA[i][1].x, rvA[i][1].y); vq.w = pk_bf16(rvA[i][1].z, rvA[i][1].w);
      } else { kq = __builtin_bit_cast(u32x4, rkA[i][0]); vq = __builtin_bit_cast(u32x4, rvA[i][0]);
        if (FUSE_QKPOST) {
          const int j = ch & 7, kpos = (tlo + t - ncache) * 64 + row;
          float x[8]; unpack8(kq, x); float ss = 0.f;
#pragma unroll
          for (int e = 0; e < 8; ++e) ss += x[e] * x[e];
          ss += shx(ss, 1, lane); ss += shx(ss, 2, lane); ss += shx(ss, 4, lane);
          const float r = 1.0f / sqrtf(ss / 64.0f + EPS);
          const f32x4 w0 = *(const f32x4*)(A.kn + 8 * j), w1 = *(const f32x4*)(A.kn + 8 * j + 4);
          x[0] *= r * w0.x; x[1] *= r * w0.y; x[2] *= r * w0.z; x[3] *= r * w0.w; x[4] *= r * w1.x; x[5] *= r * w1.y; x[6] *= r * w1.z; x[7] *= r * w1.w;
          if (lat) { const int a = j >> 2; const f32x4* tb = (const f32x4*)(A.rope + ((size_t)(kpos * 2 + a) * 16 + 8 * (j & 1)) * 2); const bool x2side = (j & 2) != 0;
#pragma unroll
            for (int e2 = 0; e2 < 4; ++e2) { const f32x4 cs = tb[e2]; const float p0 = shx(x[2 * e2], 2, lane), p1 = shx(x[2 * e2 + 1], 2, lane);
              x[2 * e2] = x2side ? x[2 * e2] * cs.x + p0 * cs.y : x[2 * e2] * cs.x - p0 * cs.y;
              x[2 * e2 + 1] = x2side ? x[2 * e2 + 1] * cs.z + p1 * cs.w : x[2 * e2 + 1] * cs.z - p1 * cs.w; } }
          kq = pack8(x);
          if (!lat && kpos >= p0 && kpos < p0 + RPU) {
            constexpr int KOW = MODE == 2 ? 1024 : 256; const size_t oo = (size_t)(s0 + kpos) * KOW + hh * KW + ch * 8;
            *(f32x4*)(A.kout + oo) = (f32x4){x[0], x[1], x[2], x[3]}; *(f32x4*)(A.kout + oo + 4) = (f32x4){x[4], x[5], x[6], x[7]};
            float v[8]; unpack8(vq, v); *(f32x4*)(A.vout + oo) = (f32x4){v[0], v[1], v[2], v[3]}; *(f32x4*)(A.vout + oo + 4) = (f32x4){v[4], v[5], v[6], v[7]}; }
        } }
      *(LAS u32x4*)(Kb + row * KROWB + pch * 16) = kq; *(LAS u32x4*)(Vb + row * VROWB + ch * 16) = vq; }
  };
  auto load_tileB = [&](int t) {
    if (t < ncache) {
#pragma unroll
      for (int i = 0; i < NCH; ++i) { const int id = tid + 512 * i, row = id / CPR, ch = id % CPR; const size_t off = (size_t)(b * PAST + t * 64 + row) * A.cld + ccol + ch * 8;
        rkB[i][0] = *(const f32x4*)(A.ck + off); rkB[i][1] = *(const f32x4*)(A.ck + off + 4); rvB[i][0] = *(const f32x4*)(A.cv + off); rvB[i][1] = *(const f32x4*)(A.cv + off + 4); }
    } else {
      const int r0 = s0 + (tlo + t - ncache) * 64;
#pragma unroll
      for (int i = 0; i < NCH; ++i) { const int id = tid + 512 * i, row = id / CPR, ch = id % CPR; const bf16_t* rp = A.QKV + (size_t)(r0 + row) * A.ld + ch * 8;
        rkB[i][0] = *(const f32x4*)(rp + kcol); rvB[i][0] = *(const f32x4*)(rp + vcol); }
    }
  };
  auto write_tileB = [&](int t, int buf) {
    LAS unsigned char* Kb = lds + OFF_K + buf * KBUF; LAS unsigned char* Vb = lds + OFF_V + buf * VBUF;
#pragma unroll
    for (int i = 0; i < NCH; ++i) { const int id = tid + 512 * i, row = id / CPR, ch = id % CPR;
      const int pch = KW == 64 ? (ch ^ ((row >> 1) & 7)) : (ch ^ (row & 15));
      u32x4 kq, vq;
      if (t < ncache) {
        kq.x = pk_bf16(rkB[i][0].x, rkB[i][0].y); kq.y = pk_bf16(rkB[i][0].z, rkB[i][0].w); kq.z = pk_bf16(rkB[i][1].x, rkB[i][1].y); kq.w = pk_bf16(rkB[i][1].z, rkB[i][1].w);
        vq.x = pk_bf16(rvB[i][0].x, rvB[i][0].y); vq.y = pk_bf16(rvB[i][0].z, rvB[i][0].w); vq.z = pk_bf16(rvB[i][1].x, rvB[i][1].y); vq.w = pk_bf16(rvB[i][1].z, rvB[i][1].w);
      } else { kq = __builtin_bit_cast(u32x4, rkB[i][0]); vq = __builtin_bit_cast(u32x4, rvB[i][0]);
        if (FUSE_QKPOST) {
          const int j = ch & 7, kpos = (tlo + t - ncache) * 64 + row;
          float x[8]; unpack8(kq, x); float ss = 0.f;
#pragma unroll
          for (int e = 0; e < 8; ++e) ss += x[e] * x[e];
          ss += shx(ss, 1, lane); ss += shx(ss, 2, lane); ss += shx(ss, 4, lane);
          const float r = 1.0f / sqrtf(ss / 64.0f + EPS);
          const f32x4 w0 = *(const f32x4*)(A.kn + 8 * j), w1 = *(const f32x4*)(A.kn + 8 * j + 4);
          x[0] *= r * w0.x; x[1] *= r * w0.y; x[2] *= r * w0.z; x[3] *= r * w0.w; x[4] *= r * w1.x; x[5] *= r * w1.y; x[6] *= r * w1.z; x[7] *= r * w1.w;
          if (lat) { const int a = j >> 2; const f32x4* tb = (const f32x4*)(A.rope + ((size_t)(kpos * 2 + a) * 16 + 8 * (j & 1)) * 2); const bool x2side = (j & 2) != 0;
#pragma unroll
            for (int e2 = 0; e2 < 4; ++e2) { const f32x4 cs = tb[e2]; const float p0 = shx(x[2 * e2], 2, lane), p1 = shx(x[2 * e2 + 1], 2, lane);
              x[2 * e2] = x2side ? x[2 * e2] * cs.x + p0 * cs.y : x[2 * e2] * cs.x - p0 * cs.y;
              x[2 * e2 + 1] = x2side ? x[2 * e2 + 1] * cs.z + p1 * cs.w : x[2 * e2 + 1] * cs.z - p1 * cs.w; } }
          kq = pack8(x);
          if (!lat && kpos >= p0 && kpos < p0 + RPU) {
            constexpr int KOW = MODE == 2 ? 1024 : 256; const size_t oo = (size_t)(s0 + kpos) * KOW + hh * KW + ch * 8;
            *(f32x4*)(A.kout + oo) = (f32x4){x[0], x[1], x[2], x[3]}; *(f32x4*)(A.kout + oo + 4) = (f32x4){x[4], x[5], x[6], x[7]};
            float v[8]; unpack8(vq, v); *(f32x4*)(A.vout + oo) = (f32x4){v[0], v[1], v[2], v[3]}; *(f32x4*)(A.vout + oo + 4) = (f32x4){v[4], v[5], v[6], v[7]}; }
        } }
      *(LAS u32x4*)(Kb + row * KROWB + pch * 16) = kq; *(LAS u32x4*)(Vb + row * VROWB + ch * 16) = vq; }
  };
#define ATT_BAR() do { asm volatile("s_waitcnt lgkmcnt(0)" ::: "memory"); __builtin_amdgcn_s_barrier(); asm volatile("" ::: "memory"); } while (0)
  auto compute = [&](int t, int cur) {
    const LAS unsigned char* Kb = lds + OFF_K + cur * KBUF; const LAS unsigned char* Vb = lds + OFF_V + cur * VBUF;
    f32x4 s[4];
#pragma unroll
    for (int kb = 0; kb < 4; ++kb) { s[kb] = (f32x4){0.f, 0.f, 0.f, 0.f};
#pragma unroll
      for (int ks = 0; ks < 2; ++ks) { const int row = 16 * kb + c, ch = map * 8 + 4 * ks + g, pch = KW == 64 ? (ch ^ ((row >> 1) & 7)) : (ch ^ (row & 15));
        const bf16x8 kf = *(const LAS bf16x8*)(Kb + row * KROWB + pch * 16);
        s[kb] = __builtin_amdgcn_mfma_f32_16x16x32_bf16(kf, qf[ks], s[kb], 0, 0, 0); } }
    const bool band = (MODE == 1) && lat && (t >= ncache); const int tb = (tlo + t - ncache) * 64;
    float ps = 0.f;
    if (ATT_FIXED_REF) {
#pragma unroll
      for (int kb = 0; kb < 4; ++kb)
#pragma unroll
        for (int r = 0; r < 4; ++r) { float p = __builtin_amdgcn_exp2f(s[kb][r] * SC - REF2);
          if (band) { const int dlt = qpos - (tb + 16 * kb + 4 * g + r); if (dlt > 128 || dlt < -128) p = 0.f; }
          s[kb][r] = p; ps += p; }
      lsum += ps;
    } else {
    float mx = NEGBIG;
#pragma unroll
    for (int kb = 0; kb < 4; ++kb)
#pragma unroll
      for (int r = 0; r < 4; ++r) { float v = s[kb][r] * SC;
        if (band) { const int dlt = qpos - (tb + 16 * kb + 4 * g + r); if (dlt > 128 || dlt < -128) v = NEGBIG; }
        s[kb][r] = v; mx = fmaxf(mx, v); }
    mx = fmaxf(mx, shx(mx, 16, lane)); mx = fmaxf(mx, shx(mx, 32, lane));
    const float mn = fmaxf(m, mx), alpha = __builtin_amdgcn_exp2f(m - mn); m = mn;
#pragma unroll
    for (int kb = 0; kb < 4; ++kb)
#pragma unroll
      for (int r = 0; r < 4; ++r) { const float p = __builtin_amdgcn_exp2f(s[kb][r] - mn); s[kb][r] = p; ps += p; }
    lsum = lsum * alpha + ps;
#pragma unroll
    for (int db = 0; db < NDB; ++db) o[db] = o[db] * alpha;
    }
    bf16x8 pf[2];
#pragma unroll
    for (int ks = 0; ks < 2; ++ks) { u32x4 pk; pk.x = pk_bf16(s[2 * ks][0], s[2 * ks][1]); pk.y = pk_bf16(s[2 * ks][2], s[2 * ks][3]); pk.z = pk_bf16(s[2 * ks + 1][0], s[2 * ks + 1][1]); pk.w = pk_bf16(s[2 * ks + 1][2], s[2 * ks + 1][3]);
      pf[ks] = __builtin_bit_cast(bf16x8, pk); }
#pragma unroll
    for (int db = 0; db < NDB; ++db)
#pragma unroll
      for (int ks = 0; ks < 2; ++ks) { const LAS unsigned char* vp = Vb + (32 * ks + 4 * g + (c >> 2)) * VROWB + 32 * db + 8 * (c & 3);
        const s16x4 lo = tr_read(vp), hi = tr_read(vp + 16 * VROWB);
        const bf16x8 vt = (bf16x8){lo[0], lo[1], lo[2], lo[3], hi[0], hi[1], hi[2], hi[3]};
        o[db] = __builtin_amdgcn_mfma_f32_16x16x32_bf16(vt, pf[ks], o[db], 0, 0, 0); }
  };
  load_tileA(0); if (NT > 1) load_tileB(1);
  write_tileA(0, 0); ATT_BAR();
  for (int t = 0; t < NT; t += 2) {
    if (t + 2 < NT) load_tileA(t + 2);
    compute(t, 0);
    if (t + 1 < NT) write_tileB(t + 1, 1);
    ATT_BAR();
    if (t + 1 >= NT) break;
    if (t + 3 < NT) load_tileB(t + 3);
    compute(t + 1, 1);
    if (t + 2 < NT) write_tileA(t + 2, 0);
    ATT_BAR();
  }
  lsum += shx(lsum, 16, lane); lsum += shx(lsum, 32, lane);
  if (MODE == 1) lsum += __builtin_amdgcn_exp2f(A.sink[hh * 4 + (wave >> 1)] * LOG2E - (ATT_FIXED_REF ? REF2 : m));
  const float rl = 1.0f / lsum;
  if (MODE != 2) {
    bf16_t* op = A.O + (size_t)(s0 + qpos) * D + hcol + 4 * g;
#pragma unroll
    for (int db = 0; db < NDB; ++db) { u32x2 pk; pk.x = pk_bf16(o[db][0] * rl, o[db][1] * rl); pk.y = pk_bf16(o[db][2] * rl, o[db][3] * rl); *(u32x2*)(op + 16 * db) = pk; }
  } else {
    LAS float* comb = (LAS float*)(lds + OFF_COMB);
    const int row = (wave & 3) * 16 + c;
    if (map == 1) {
#pragma unroll
      for (int db = 0; db < NDB; ++db) *(LAS f32x4*)(comb + row * 132 + 16 * db + 4 * g) = o[db] * rl;
    }
    __syncthreads();
    if (map == 0) {
      float ss = 0.f;
#pragma unroll
      for (int db = 0; db < NDB; ++db) { const f32x4 o2 = *(const LAS f32x4*)(comb + row * 132 + 16 * db + 4 * g); o[db] = o[db] * rl - lam * o2;
        ss += (o[db][0] * o[db][0] + o[db][1] * o[db][1]) + (o[db][2] * o[db][2] + o[db][3] * o[db][3]); }
      ss += shx(ss, 16, lane); ss += shx(ss, 32, lane);
      const float rs = (1.0f - A.lam_init) / sqrtf(ss / 128.0f + EPS);
      bf16_t* op = A.O + (size_t)(s0 + qpos) * D + hh * 128 + 4 * g;
#pragma unroll
      for (int db = 0; db < NDB; ++db) { const f32x4 sg = *(const f32x4*)(A.sub_g + 16 * db + 4 * g); u32x2 pk; pk.x = pk_bf16(o[db][0] * rs * sg.x, o[db][1] * rs * sg.y); pk.y = pk_bf16(o[db][2] * rs * sg.z, o[db][3] * rs * sg.w);
        *(u32x2*)(op + 16 * db) = pk; }
    }
    __syncthreads();
  }
}

template <int MODE>
__device__ __forceinline__ void phase(const Args& A, LAS unsigned char* lds) {
  constexpr int NH = MODE == 2 ? 8 : 4, RPU = MODE == 2 ? 64 : 32, CPS_L = DEC_SEQ / RPU, CPS_C = SEQ / RPU, NLAT = DEC_BATCH * NH * CPS_L, NCTX = BATCH * NH * CPS_C;
  float lam = 0.f;
  if (MODE == 2) { const int lane = opaque_i((int)threadIdx.x) & 63; const float d1 = wave_sum(A.lq1[lane] * A.lk1[lane], lane), d2 = wave_sum(A.lq2[lane] * A.lk2[lane], lane); lam = expf(d1) - expf(d2) + A.lam_init; }
  for (int u = opaque_block(); u < NLAT; u += (int)gridDim.x) unit<MODE>(A, true, u / (NH * CPS_L), (u / CPS_L) % NH, u % CPS_L, lam, lds);
  for (int u = opaque_block(); u < NCTX; u += (int)gridDim.x) unit<MODE>(A, false, u / (NH * CPS_C), (u / CPS_C) % NH, u % CPS_C, lam, lds);
}
}
#endif


#ifndef HOST_EMU
#define XB_TMO      128
#define XB_XCNT(j)  (256  + 64 * (j))
#define XB_XSUB(j)  (1280 + 64 * (j))
#define XB_XGEN(j)  (2304 + 64 * (j))
#define XB_TOP      3328
#define XB_TOPGEN   3392
#define XCD_BAR_WORDS 3456
#define XB_SPIN_CAP (1u << 18)

__device__ __forceinline__ unsigned xb_ld(unsigned* p)              { return __hip_atomic_load(p, __ATOMIC_RELAXED, __HIP_MEMORY_SCOPE_AGENT); }
__device__ __forceinline__ unsigned xb_add(unsigned* p, unsigned v) { return __hip_atomic_fetch_add(p, v, __ATOMIC_RELAXED, __HIP_MEMORY_SCOPE_AGENT); }
__device__ __forceinline__ unsigned xb_xcc_id() { return (unsigned)__builtin_amdgcn_s_getreg((3 << 11) | 20) & 0xFu; }
#define XB_SPIN(cond, bar) do { unsigned _sp = 0; while (cond) { __builtin_amdgcn_s_sleep(1); \
    if ((++_sp & 255u) == 0u) { if (xb_ld(&(bar)[XB_TMO])) break; if (_sp > XB_SPIN_CAP) { atomicAdd(&(bar)[XB_TMO], 1u); break; } } } } while (0)

struct XcdBarrier {
    unsigned* bar; unsigned x;
    volatile LAS unsigned* st;
};

__device__ __forceinline__ XcdBarrier xcd_barrier_post(unsigned* bar, volatile LAS unsigned* st) {
    XcdBarrier b; b.bar = bar; b.x = xb_xcc_id(); b.st = st;
    if (threadIdx.x == 0) (void)xb_add(&bar[XB_XCNT(b.x)], 1u);
    return b;
}
__device__ __forceinline__ void xcd_barrier_complete(unsigned* bar, unsigned x, unsigned& nloc, unsigned& nx) {
    const unsigned G = gridDim.x * gridDim.y * gridDim.z;
    unsigned sum, cnt, mine, sp = 0u;
    for (;;) {
        sum = 0u; cnt = 0u; mine = 0u;
#pragma unroll
        for (unsigned j = 0; j < 16; ++j) { const unsigned c = xb_ld(&bar[XB_XCNT(j)]); sum += c; cnt += (c > 0u) ? 1u : 0u; mine = (j == x) ? c : mine; }
        if (sum == G) break;
        __builtin_amdgcn_s_sleep(1);
        if ((++sp & 255u) == 0u) { if (xb_ld(&bar[XB_TMO])) break; if (sp > XB_SPIN_CAP) { atomicAdd(&bar[XB_TMO], 1u); break; } }
    }
    nloc = mine > 0u ? mine : 1u; nx = cnt > 0u ? cnt : 1u;
}

__device__ __forceinline__ void xcd_barrier(const XcdBarrier& b) {
    asm volatile("s_waitcnt vmcnt(0)" ::: "memory");
    __syncthreads();
    if (threadIdx.x == 0) {
        unsigned* bar = b.bar;
        __builtin_amdgcn_s_waitcnt(0);
        unsigned nloc = b.st[0], nx = b.st[1];
        if (nloc == 0u) { xcd_barrier_complete(bar, b.x, nloc, nx); b.st[0] = nloc; b.st[1] = nx; }
        const unsigned old = xb_add(&bar[XB_XSUB(b.x)], 1u);
        const unsigned gen = old / nloc;
        if (old + 1u == (gen + 1u) * nloc) {
            __builtin_amdgcn_fence(__ATOMIC_RELEASE, "agent");
            asm volatile("s_waitcnt vmcnt(0)" ::: "memory");
            const unsigned og = xb_add(&bar[XB_TOP], 1u);
            const unsigned tg = og / nx;
            if (og + 1u == (tg + 1u) * nx) xb_add(&bar[XB_TOPGEN], 1u);
            else XB_SPIN(xb_ld(&bar[XB_TOPGEN]) == tg, bar);
            __builtin_amdgcn_fence(__ATOMIC_ACQUIRE, "agent");
            xb_add(&bar[XB_XGEN(b.x)], 1u);
            asm volatile("s_waitcnt vmcnt(0)" ::: "memory");
        } else {
            XB_SPIN(xb_ld(&bar[XB_XGEN(b.x)]) == gen, bar);
            __builtin_amdgcn_fence(__ATOMIC_ACQUIRE, "agent");
            asm volatile("s_waitcnt vmcnt(0)" ::: "memory");
        }
    }
    __syncthreads();
}
#endif

#ifndef HOST_EMU
constexpr int LDS_BYTES = 147456;
#ifndef FAST_PRO
#define FAST_PRO 1
#endif
#ifndef FAST_NORM
#define FAST_NORM 1
#endif
#ifndef FAST_POOL
#define FAST_POOL 1
#endif
#ifndef FAST_QKPOST
#define FAST_QKPOST 1
#endif
#ifndef FAST_CONV
#define FAST_CONV 1
#endif
#ifndef FAST_ATTN
#define FAST_ATTN 1
#endif
#ifndef REP_GEMM
#define REP_GEMM 0
#endif
#ifndef REP_ATTN
#define REP_ATTN 0
#endif
#ifndef REP_ELEM
#define REP_ELEM 0
#endif
#ifndef REP_PRO
#define REP_PRO 0
#endif
#ifndef REP_SYNC
#define REP_SYNC 0
#endif
#ifndef USE_CG_SYNC
#define USE_CG_SYNC 0
#endif
__global__ void __launch_bounds__(512, 2) mega(Params P) {
  extern __shared__ __attribute__((aligned(16))) unsigned char lds_raw[];
  cg::grid_group grid = cg::this_grid();
  PG8_LAS unsigned char* lds = (PG8_LAS unsigned char*)lds_raw;
  const Ctx c = make_ctx(P);
  volatile LAS unsigned* MISC = (volatile LAS unsigned*)((LAS unsigned char*)lds_raw + 131072 + 320);
  if (threadIdx.x < 32) MISC[threadIdx.x] = 0u;
  __syncthreads();
  { unsigned* b0_ = (unsigned*)(P.ws + WS_CTL); asm volatile("" : "+s"(b0_)); (void)xcd_barrier_post(b0_, MISC + 8); }
#define BAR_NOW() do { XcdBarrier bar_; { unsigned* b0_ = (unsigned*)(P.ws + WS_CTL); asm volatile("" : "+s"(b0_)); bar_.bar = b0_; } bar_.x = xb_xcc_id(); bar_.st = (volatile LAS unsigned*)((LAS unsigned char*)lds_raw + 131072 + 320) + 8; xcd_barrier(bar_); } while (0)
#define GSYNC() do { if (USE_CG_SYNC) grid.sync(); else BAR_NOW(); if (REP_SYNC) { if (USE_CG_SYNC) grid.sync(); else BAR_NOW(); } } while (0)
#define NAIVE(step) do { naive_step((step), P, c); } while (0)
#define GEMM_RUN(step, rep_) do { GemmDesc g; gemm_desc((step), P, c, g); \
    pg8::Gemm gg{g.A, g.Bt, T, g.N, g.K, g.lda, g.ldb, g.a_pn_step, g.ksplit}; pg8::StaticOrder S; S.init(T, g.N, (int)gridDim.x, opaque_block(), g.ksplit); \
    if (g.res) { bf16_t* slab_ = (bf16_t*)(c.ws_p() + (pend == (const bf16_t*)(c.ws_p() + WS_SA) ? WS_SB : WS_SA)); \
      float* xw_ = (rep_) == 0 ? c.X() : (float*)(g.K == DFF ? c.Ub() : c.Gb()); const bool first_ = ((step) == N_PRE + 7); \
      pg8::EpiRes E{xw_, first_ ? pin(P, I_XP) : (const float*)xw_, first_ ? pin(P, I_XS) - (size_t)TCTX * D : (const float*)xw_, MODl, g.gate_chunk, g.colscale, pend, slab_}; pg8::gemm_phase<pg8::EpiRes, pg8::StaticOrder, true, true>(lds, gg, S, E); \
      if ((rep_) == 0) pend = g.ksplit > 1 ? (const bf16_t*)slab_ : nullptr; } \
    else { pg8::EpiBf16<0> E{g.C, g.ldc, nullptr, 0, 0, 1.f}; pg8::gemm_phase<pg8::EpiBf16<0>, pg8::StaticOrder, true, true>(lds, gg, S, E); } } while (0)
#define GEMM_STEP(step) do { GEMM_RUN(step, 0); if (REP_GEMM) { __syncthreads(); GEMM_RUN(step, 1); } } while (0)
  const bf16_t* pend = nullptr;
#define BG_AFTER_GEMM(nunits, ticks) do { const int G_ = (int)gridDim.x, b_ = opaque_block(), r_ = ((nunits) + G_ - 1) / G_, full_ = (nunits) - (r_ - 1) * G_; \
    if (b_ >= full_) bg_work(P, c, (LAS unsigned char*)lds_raw, (ticks), bg_total_items()); } while (0)
  if (FAST_PRO) { for (int rep_ = 0; rep_ < 1 + REP_PRO; ++rep_) ph_prologue(P, c, (LAS unsigned char*)lds_raw); GSYNC(); }
  else { NAIVE(0); GSYNC(); NAIVE(1); GSYNC(); NAIVE(2); GSYNC(); }
#pragma unroll 1
  for (int l = 0; l < 4; ++l) {
    const int s0 = N_PRE + l * STEPS_PER_LAYER;
    const float* MODl = c.MOD() + (size_t)l * NCOND * MODW;
    if (l > 0) bg_work(P, c, (LAS unsigned char*)lds_raw, 0xffffffffu, bg_end_of_layer(l));
    if (FAST_NORM) { for (int rep_ = 0; rep_ < 1 + REP_ELEM; ++rep_) ph_norm(l == 0 ? pin(P, I_XP) : (const float*)c.X(), l == 0 ? pin(P, I_XS) - (size_t)TCTX * D : (const float*)c.X(), pend, pin(P, I_N1G) + l * D, MODl, 0, 1, c.Hb()); GSYNC(); }
    else { NAIVE(s0 + 0); GSYNC(); NAIVE(s0 + 1); GSYNC(); }
    if (l == 0) {
      if (FAST_POOL) { for (int rep_ = 0; rep_ < 1 + REP_ELEM; ++rep_) ph_pool(c.Hb(), c.PDb()); } else NAIVE(s0 + 2);
      GSYNC();
    } else {
      if (FUSE_QKEPI) {
        GemmDesc g; gemm_desc(s0 + 2, P, c, g);
        pg8::Gemm gg{g.A, g.Bt, T, g.N, g.K, g.lda, g.ldb, g.a_pn_step, 1}; pg8::StaticOrder S; S.init(T, g.N, (int)gridDim.x, opaque_block(), 1);
        pg8::EpiQK E{c.QKVb(), g.N, 1024, l == 2 ? 2048 : 1280, pin(P, l == 1 ? I_GQN : (l == 2 ? I_DQN : I_WQN)), pin(P, l == 1 ? I_GKN : (l == 2 ? I_DKN : I_WKN)), c.ROPE(),
                     l == 1 ? c.o_gk() : (l == 2 ? c.o_dk() : c.o_wk()), l == 1 ? c.o_gv() : (l == 2 ? c.o_dv() : c.o_wv()), l == 2 ? 1024 : 256, (PG8_LAS float*)(lds + 131072 + 1024)};
        pg8::gemm_phase<pg8::EpiQK, pg8::StaticOrder, true, true>(lds, gg, S, E);
      } else GEMM_STEP(s0 + 2);
      GSYNC();
      if (FUSE_QKPOST || FUSE_QKEPI) {   }
      else if (FAST_QKPOST) {
        if (l == 2) ph_qkpost(c.QKVb(), 3072, 16, 16, 16, 1024, 2048, pin(P, I_DQN), pin(P, I_DKN), c.ROPE(), c.o_dk(), c.o_dv());
        else ph_qkpost(c.QKVb(), 1536, 16, 4, 4, 1024, 1280, pin(P, l == 1 ? I_GQN : I_WQN), pin(P, l == 1 ? I_GKN : I_WKN), c.ROPE(), l == 1 ? c.o_gk() : c.o_wk(), l == 1 ? c.o_gv() : c.o_wv());
      } else NAIVE(s0 + 3);
      if (!FUSE_QKPOST && !FUSE_QKEPI) GSYNC();
      if (FAST_ATTN) {
        const float lam_init = 0.8f - 0.6f * expf(-0.3f * (float)l);
        for (int rep_ = 0; rep_ < 1 + REP_ATTN; ++rep_) {
        if (l == 2) { const att::Args A{c.QKVb(), 3072, 1024, 2048, pin(P, I_CDK), pin(P, I_CDV), 1024, nullptr, pin(P, I_DLQ1), pin(P, I_DLK1), pin(P, I_DLQ2), pin(P, I_DLK2), lam_init, pin(P, I_DSUB), c.Ob(), pin(P, I_DQN), pin(P, I_DKN), c.ROPE(), c.o_dk(), c.o_dv()};
          att::phase<2>(A, (LAS unsigned char*)lds_raw); }
        else if (l == 1) { const att::Args A{c.QKVb(), 1536, 1024, 1280, pin(P, I_CGK), pin(P, I_CGV), 256, nullptr, nullptr, nullptr, nullptr, nullptr, 0.f, nullptr, c.Ob(), pin(P, I_GQN), pin(P, I_GKN), c.ROPE(), c.o_gk(), c.o_gv()};
          att::phase<0>(A, (LAS unsigned char*)lds_raw); }
        else { const att::Args A{c.QKVb(), 1536, 1024, 1280, pin(P, I_CWK), pin(P, I_CWV), 256, pin(P, I_WSINK), nullptr, nullptr, nullptr, nullptr, 0.f, nullptr, c.Ob(), pin(P, I_WQN), pin(P, I_WKN), c.ROPE(), c.o_wk(), c.o_wv()};
          att::phase<1>(A, (LAS unsigned char*)lds_raw); }
        }
        GSYNC();
      } else {
        NAIVE(s0 + 5); GSYNC();
        if (l == 2) { NAIVE(s0 + 6); GSYNC(); }
      }
    }
    GEMM_STEP(s0 + 7); BG_AFTER_GEMM((T / 256) * (D / 256) * (l == 0 ? 1 : KSPLIT), l == 0 ? 400u : 800u); GSYNC();
    if (FAST_NORM) { for (int rep_ = 0; rep_ < 1 + REP_ELEM; ++rep_) ph_norm(c.X(), c.X(), pend, pin(P, I_N2G) + l * D, MODl, 3, 4, c.Hb()); GSYNC(); }
    else { NAIVE(s0 + 8); GSYNC(); NAIVE(s0 + 9); GSYNC(); }
    if (FUSE_CONV) {
      GemmDesc g; gemm_desc(s0 + 10, P, c, g);
      pg8::Gemm gg{g.A, g.Bt, T, g.N, g.K, g.lda, g.ldb, g.a_pn_step, 1}; pg8::StaticOrder S; S.init(T, g.N, (int)gridDim.x, opaque_block(), 1);
      pg8::EpiConv E{c.Gb(), pin(P, I_FCW) + (size_t)l * 3 * DFF2, pin(P, I_FCB) + (size_t)l * DFF2, (float*)(c.ws_p() + WS_EDGE), (PG8_LAS unsigned*)(lds + 131072 + 1024)};
      pg8::gemm_phase<pg8::EpiConv, pg8::StaticOrder, true, true>(lds, gg, S, E);
      BG_AFTER_GEMM((T / 256) * (DFF2 / 256), 1500u);
    } else {
    GEMM_STEP(s0 + 10); GSYNC();
    if (FAST_CONV) { for (int rep_ = 0; rep_ < 1 + REP_ELEM; ++rep_) ph_convgate(c.Ub(), pin(P, I_FCW) + (size_t)l * 3 * DFF2, pin(P, I_FCB) + (size_t)l * DFF2, c.Gb()); } else NAIVE(s0 + 11);
    }
    GSYNC();
    if (FUSE_CONV) {
      GemmDesc g; gemm_desc(s0 + 12, P, c, g); pg8::StaticOrder S; S.init(T, g.N, (int)gridDim.x, opaque_block(), g.ksplit); pg8::Unit u;
      for (int i = 0; S.next(i, u); ++i) conv_fixup_unit((const float*)(c.ws_p() + WS_EDGE), pin(P, I_FCW) + (size_t)l * 3 * DFF2, pin(P, I_FCB) + (size_t)l * DFF2, c.Gb(), u.pm, u.kh * (DFF / g.ksplit), DFF / g.ksplit);
      asm volatile("s_waitcnt vmcnt(0)" ::: "memory"); __syncthreads();
    }
    GEMM_STEP(s0 + 12); BG_AFTER_GEMM((T / 256) * (D / 256) * ((DFF % 256 == 0) ? KSPLIT : 1), 2800u);
    if (l < 3) GSYNC();
  }
  if (pend) {
    GSYNC();
    const WaveId w = wave_id();
    for (int t = w.gw; t < T; t += w.ngw) { f32x4* xr = (f32x4*)(c.X() + (size_t)t * D) + w.lane; const u32x2* pr = (const u32x2*)(pend + (size_t)t * D) + w.lane;
#pragma unroll
      for (int j = 0; j < 4; ++j) { const u32x2 q = pr[64 * j]; xr[64 * j] = xr[64 * j] + (f32x4){bf_lo(q.x), bf_hi(q.x), bf_lo(q.y), bf_hi(q.y)}; } }
  }
}
#endif

extern "C" void kernel_launch(void* const* d_in, const int* in_sizes, int n_in, void* d_out, int out_size, void* d_ws, size_t ws_size,
                              hipStream_t stream) {
  (void)in_sizes; (void)n_in; (void)out_size;
  Params P{};
  for (int i = 0; i < N_IN; ++i) P.in[i] = (const float*)d_in[i];
  P.out = (float*)d_out; P.ws = (unsigned char*)d_ws;
#ifdef HOST_EMU
  for (int step = 0; step < N_STEPS; ++step) { if (step_is_noop(step)) continue; emu_launch(256, 8, [&] { const Ctx c = make_ctx(P); naive_step(step, P, c); }); }
#else
  static int grid_blocks = 0;
  if (!grid_blocks) {
    if (ws_size < WS_END) { fprintf(stderr, "kernel_launch: workspace too small (%zu < %zu)\n", ws_size, (size_t)WS_END); grid_blocks = -1; return; }
    int dev = 0, cus = 0, per_cu = 0;
    (void)hipGetDevice(&dev);
    (void)hipDeviceGetAttribute(&cus, hipDeviceAttributeMultiprocessorCount, dev);
    (void)hipFuncSetAttribute((const void*)mega, hipFuncAttributeMaxDynamicSharedMemorySize, LDS_BYTES);
    (void)hipOccupancyMaxActiveBlocksPerMultiprocessor(&per_cu, mega, 512, LDS_BYTES);
    if (per_cu < 1) { fprintf(stderr, "kernel_launch: occupancy query says %d blocks per CU\n", per_cu); per_cu = 1; }
    if (per_cu > 1) per_cu = 1;
    grid_blocks = cus * per_cu;
  }
  if (grid_blocks < 0) return;
  if (hipMemsetAsync((char*)d_ws + WS_CTL, 0, CTL_ZERO_BYTES, stream) != hipSuccess) { fprintf(stderr, "kernel_launch: hipMemsetAsync of the control words failed\n"); return; }
  void* args[] = {&P};
  hipError_t e = hipLaunchCooperativeKernel((void*)mega, dim3(grid_blocks), dim3(512), args, LDS_BYTES, stream);
  if (e != hipSuccess) fprintf(stderr, "cooperative launch failed: %s (grid %d)\n", hipGetErrorString(e), grid_blocks);
#endif
}
```

```cpp
#ifndef HOST_EMU
#include <hip/hip_runtime.h>
#include <hip/hip_cooperative_groups.h>
#include <cstdio>
#include <cstdint>
#include <cmath>
namespace cg = cooperative_groups;
#endif

#ifndef CFG_BATCH
#define CFG_BATCH 16
#endif
#ifndef ATT_FIXED_REF
#define ATT_FIXED_REF 1
#endif
#ifndef BG_QUEUE
#define BG_QUEUE 0
#endif
#ifndef WIN_TAIL
#define WIN_TAIL 1
#endif
#ifndef FUSE_QKEPI
#define FUSE_QKEPI 0
#endif
#ifndef FUSE_QKPOST
#define FUSE_QKPOST 0
#endif
#ifndef FUSE_CONV
#define FUSE_CONV 1
#endif
#ifndef CFG_DFF
#define CFG_DFF 2816
#endif

namespace cfg {
constexpr int D = 1024, BATCH = CFG_BATCH, SEQ = 256, DEC_BATCH = 2, DEC_SEQ = 1024, PAST = 256;
constexpr int TCTX = BATCH * SEQ, TLAT = DEC_BATCH * DEC_SEQ, T = TCTX + TLAT;
constexpr int DFF = CFG_DFF, DFF2 = 2 * DFF;
constexpr int NCOND = 3, MODW = 6 * D;
constexpr float EPS = 1e-6f;
}
using namespace cfg;

typedef unsigned short bf16_t;
#ifdef HOST_EMU
static inline float bf2f(bf16_t v) { unsigned u = (unsigned)v << 16; float f; memcpy(&f, &u, 4); return f; }
static inline bf16_t f2bf(float f) { unsigned u; memcpy(&u, &f, 4); return (bf16_t)((u + 0x7fffu + ((u >> 16) & 1u)) >> 16); }
#else
__device__ __forceinline__ float bf2f(bf16_t v) { return __uint_as_float((unsigned)v << 16); }
__device__ __forceinline__ bf16_t f2bf(float f) { unsigned u = __float_as_uint(f); return (bf16_t)((u + 0x7fffu + ((u >> 16) & 1u)) >> 16); }
#endif

__device__ __forceinline__ int tok_cond(int t) { return t < TCTX ? 0 : 1 + (t - TCTX) / DEC_SEQ; }
__device__ __forceinline__ void tok_seq(int t, int& s0, int& L) {
  if (t < TCTX) { s0 = (t / SEQ) * SEQ; L = SEQ; } else { s0 = TCTX + ((t - TCTX) / DEC_SEQ) * DEC_SEQ; L = DEC_SEQ; }
}
__device__ __forceinline__ float silu_f(float x) { return x / (1.0f + expf(-x)); }

#ifdef HOST_EMU
static inline long opaque_tid() { return (long)blockIdx.x * blockDim.x + threadIdx.x; }
#else
__device__ __forceinline__ long opaque_tid() { int t = (int)(blockIdx.x * blockDim.x + threadIdx.x); asm volatile("" : "+v"(t)); return (long)t; }
#endif
#define GRID_STRIDE(idx, total) \
  for (long idx = opaque_tid(), _gs = (long)gridDim.x * blockDim.x; idx < (long)(total); idx += _gs)

__device__ void nk_copy_x(const float* xp, const float* xs, float* X) {
  GRID_STRIDE(i, (long)T * D) X[i] = i < (long)TCTX * D ? xp[i] : xs[i - (long)TCTX * D];
}

__device__ void nk_mod(const float* c, const float* c_ctx, const float* w_mod, const float* b_mod, float* MOD, int nlayer) {
  GRID_STRIDE(i, (long)nlayer * NCOND * MODW) {
    const int n = (int)(i % MODW), cd = (int)((i / MODW) % NCOND), l = (int)(i / ((long)MODW * NCOND));
    const float* cv = cd == 0 ? c_ctx : c + (cd - 1) * D;
    const float* w = w_mod + (long)l * D * MODW + n;
    float acc = 0.f;
    for (int k = 0; k < D; ++k) acc += silu_f(cv[k]) * w[(long)k * MODW];
    MOD[i] = acc + b_mod[(long)l * MODW + n];
  }
}

__device__ void nk_rope_table(float* ROPE) {
  GRID_STRIDE(i, (long)DEC_SEQ * 32) {
    const int pos = (int)(i / 32), a = (int)((i / 16) % 2), f = (int)(i % 16);
    const float inv = powf(10000.0f, -(float)(2 * f) / 32.0f), ang = (a == 0 ? (float)(pos / 64) : (float)(pos % 64)) * inv;
    ROPE[2 * i] = cosf(ang); ROPE[2 * i + 1] = sinf(ang);
  }
}

__device__ void nk_wt(const float* W, int K, int N, bf16_t* WT) {
  GRID_STRIDE(i, (long)K * N) { const int n = (int)(i / K), k = (int)(i % K); WT[i] = f2bf(W[(long)k * N + n]); }
}

__device__ void nk_rstd(const float* X, float* RSTD) {
  GRID_STRIDE(t, T) {
    const float* x = X + t * D; float ss = 0.f;
    for (int d = 0; d < D; ++d) ss += x[d] * x[d];
    RSTD[t] = 1.0f / sqrtf(ss / (float)D + EPS);
  }
}

__device__ void nk_normmod(const float* X, const float* RSTD, const float* g, const float* MODl, int sh_chunk, int sc_chunk, bf16_t* Hb) {
  GRID_STRIDE(i, (long)T * D) {
    const int t = (int)(i / D), d = (int)(i % D); const float* m = MODl + (long)tok_cond(t) * MODW;
    Hb[i] = f2bf(X[i] * RSTD[t] * g[d] * (1.0f + m[sc_chunk * D + d]) + m[sh_chunk * D + d]);
  }
}

__device__ void nk_gemm_bf(const bf16_t* A, int lda, const bf16_t* Bt, int ldb, bf16_t* C, int ldc, int M, int N, int K) {
  GRID_STRIDE(i, (long)M * N) {
    const int t = (int)(i / N), n = (int)(i % N); const bf16_t* a = A + (long)t * lda; const bf16_t* b = Bt + (long)n * ldb;
    float acc = 0.f;
    for (int k = 0; k < K; ++k) acc += bf2f(a[k]) * bf2f(b[k]);
    C[(long)t * ldc + n] = f2bf(acc);
  }
}

__device__ void nk_gemm_res(const bf16_t* A, int lda, int a_pn_step, const bf16_t* Bt, int ldb, float* X, int M, int N, int K,
                            const float* MODl, int gate_chunk, const float* colscale) {
  GRID_STRIDE(i, (long)M * N) {
    const int t = (int)(i / N), n = (int)(i % N); const bf16_t* a = A + (long)t * lda + (n / 256) * a_pn_step; const bf16_t* b = Bt + (long)n * ldb;
    float acc = 0.f;
    for (int k = 0; k < K; ++k) acc += bf2f(a[k]) * bf2f(b[k]);
    if (colscale) acc *= colscale[n];
    X[(long)t * D + n] += MODl[(long)tok_cond(t) * MODW + gate_chunk * D + n] * acc;
  }
}

__device__ void nk_pool(const bf16_t* Hb, bf16_t* PDb) {
  GRID_STRIDE(i, (long)T * D) {
    const int t = (int)(i / D), d = (int)(i % D), g = d / 256, w = 2 << g; int s0, L; tok_seq(t, s0, L);
    const int pos = t - s0; int lo = pos - w / 2, hi = pos - w / 2 + w; lo = lo < 0 ? 0 : lo; hi = hi > L ? L : hi;
    float s = 0.f;
    for (int j = lo; j < hi; ++j) s += bf2f(Hb[(long)(s0 + j) * D + d]);
    PDb[i] = f2bf(s / (float)(hi - lo) - bf2f(Hb[i]));
  }
}

__device__ void nk_qknorm_rope(bf16_t* QKV, int ld, int nq, int nk, int kcol0, const float* qn, const float* kn, float* kout) {
  GRID_STRIDE(i, (long)T * (nq + nk)) {
    const int t = (int)(i / (nq + nk)), s = (int)(i % (nq + nk));
    bf16_t* v = QKV + (long)t * ld + (s < nq ? s * 64 : kcol0 + (s - nq) * 64); const float* w = s < nq ? qn : kn;
    float ss = 0.f;
    for (int d = 0; d < 64; ++d) ss += bf2f(v[d]) * bf2f(v[d]);
    const float r = 1.0f / sqrtf(ss / 64.0f + EPS);
    if (t < TCTX) {
      for (int d = 0; d < 64; ++d) { const float y = bf2f(v[d]) * r * w[d]; v[d] = f2bf(y); if (s >= nq) kout[(long)t * (nk * 64) + (s - nq) * 64 + d] = y; }
    } else {
      const int pos = (t - TCTX) % DEC_SEQ; const float prow = (float)(pos / 64), pcol = (float)(pos % 64);
      for (int a = 0; a < 2; ++a)
        for (int f = 0; f < 16; ++f) {
          const float inv = powf(10000.0f, -(float)(2 * f) / 32.0f), ang = (a == 0 ? prow : pcol) * inv, cs = cosf(ang), sn = sinf(ang);
          const int i1 = a * 32 + f, i2 = a * 32 + 16 + f; const float x1 = bf2f(v[i1]) * r * w[i1], x2 = bf2f(v[i2]) * r * w[i2];
          v[i1] = f2bf(x1 * cs - x2 * sn); v[i2] = f2bf(x2 * cs + x1 * sn);
        }
    }
  }
}

__device__ void nk_copy_cols_f(const bf16_t* S, int ld, int col0, int width, int rows, float* out) {
  GRID_STRIDE(i, (long)rows * width) { const int t = (int)(i / width), j = (int)(i % width); out[i] = bf2f(S[(long)t * ld + col0 + j]); }
}

__device__ __forceinline__ float dot64_bb(const bf16_t* a, const bf16_t* b) {
  float s = 0.f;
  for (int d = 0; d < 64; ++d) s += bf2f(a[d]) * bf2f(b[d]);
  return s;
}
__device__ __forceinline__ float dot64_bf(const bf16_t* a, const float* b) {
  float s = 0.f;
  for (int d = 0; d < 64; ++d) s += bf2f(a[d]) * bf2f(f2bf(b[d]));
  return s;
}

template <int MODE>
__device__ void nk_attn(const bf16_t* QKV, int ld, int kcol0, int vcol0, const float* ck, const float* cv, int cld,
                        const float* sink, const float* lq1, const float* lk1, const float* lq2, const float* lk2, float lam_init, bf16_t* O) {
  GRID_STRIDE(i, (long)T * 64) {
    const int t = (int)(i / 64), r = (int)(i % 64); const bool lat = t >= TCTX; int s0, L; tok_seq(t, s0, L);
    const int b = lat ? (t - TCTX) / DEC_SEQ : 0, ncache = lat ? PAST : 0;
    int jlo = 0, jhi = L - 1;
    if (MODE == 1 && lat) { const int pos = t - s0; jlo = pos - 128 < 0 ? 0 : pos - 128; jhi = pos + 128 > L - 1 ? L - 1 : pos + 128; }
    if (MODE != 2) {
      const int h = r / 4, ch = r % 4, koff = (h / 4) * 64, voff = (h / 4) * 64 + ch * 16; const bf16_t* q = QKV + (long)t * ld + h * 64;
      float m = -3.0e38f;
      for (int p = 0; p < ncache; ++p) m = fmaxf(m, dot64_bf(q, ck + (long)(b * PAST + p) * cld + koff) * 0.125f);
      for (int j = jlo; j <= jhi; ++j) m = fmaxf(m, dot64_bb(q, QKV + (long)(s0 + j) * ld + kcol0 + koff) * 0.125f);
      if (MODE == 1) m = fmaxf(m, sink[h]);
      float sum = 0.f, o[16];
#pragma unroll
      for (int e = 0; e < 16; ++e) o[e] = 0.f;
      for (int p = 0; p < ncache; ++p) {
        const float pr = expf(dot64_bf(q, ck + (long)(b * PAST + p) * cld + koff) * 0.125f - m); sum += pr; const float* v = cv + (long)(b * PAST + p) * cld + voff;
#pragma unroll
        for (int e = 0; e < 16; ++e) o[e] += pr * v[e];
      }
      for (int j = jlo; j <= jhi; ++j) {
        const float pr = expf(dot64_bb(q, QKV + (long)(s0 + j) * ld + kcol0 + koff) * 0.125f - m); sum += pr; const bf16_t* v = QKV + (long)(s0 + j) * ld + vcol0 + voff;
#pragma unroll
        for (int e = 0; e < 16; ++e) o[e] += pr * bf2f(v[e]);
      }
      if (MODE == 1) sum += expf(sink[h] - m);
#pragma unroll
      for (int e = 0; e < 16; ++e) O[(long)t * D + h * 64 + ch * 16 + e] = f2bf(o[e] / sum);
    } else {
      float d1 = 0.f, d2 = 0.f;
      for (int d = 0; d < 64; ++d) { d1 += lq1[d] * lk1[d]; d2 += lq2[d] * lk2[d]; }
      const float lam = expf(d1) - expf(d2) + lam_init;
      const int hd = r / 8, ch = r % 8, voff = hd * 128 + ch * 16; float res[16];
#pragma unroll
      for (int e = 0; e < 16; ++e) res[e] = 0.f;
      for (int c = 0; c < 2; ++c) {
        const int koff = hd * 128 + c * 64; const bf16_t* q = QKV + (long)t * ld + koff;
        float m = -3.0e38f;
        for (int p = 0; p < ncache; ++p) m = fmaxf(m, dot64_bf(q, ck + (long)(b * PAST + p) * cld + koff) * 0.125f);
        for (int j = jlo; j <= jhi; ++j) m = fmaxf(m, dot64_bb(q, QKV + (long)(s0 + j) * ld + kcol0 + koff) * 0.125f);
        float sum = 0.f, o[16];
#pragma unroll
        for (int e = 0; e < 16; ++e) o[e] = 0.f;
        for (int p = 0; p < ncache; ++p) {
          const float pr = expf(dot64_bf(q, ck + (long)(b * PAST + p) * cld + koff) * 0.125f - m); sum += pr; const float* v = cv + (long)(b * PAST + p) * cld + voff;
#pragma unroll
          for (int e = 0; e < 16; ++e) o[e] += pr * v[e];
        }
        for (int j = jlo; j <= jhi; ++j) {
          const float pr = expf(dot64_bb(q, QKV + (long)(s0 + j) * ld + kcol0 + koff) * 0.125f - m); sum += pr; const bf16_t* v = QKV + (long)(s0 + j) * ld + vcol0 + voff;
#pragma unroll
          for (int e = 0; e < 16; ++e) o[e] += pr * bf2f(v[e]);
        }
        const float f = (c == 0 ? 1.0f : -lam) / sum;
#pragma unroll
        for (int e = 0; e < 16; ++e) res[e] += f * o[e];
      }
#pragma unroll
      for (int e = 0; e < 16; ++e) O[(long)t * D + voff + e] = f2bf(res[e]);
    }
  }
}

__device__ void nk_subnorm(bf16_t* O, const float* sub_g, float factor) {
  GRID_STRIDE(i, (long)T * 8) {
    bf16_t* o = O + i * 128; float ss = 0.f;
    for (int e = 0; e < 128; ++e) ss += bf2f(o[e]) * bf2f(o[e]);
    const float r = factor / sqrtf(ss / 128.0f + EPS);
    for (int e = 0; e < 128; ++e) o[e] = f2bf(bf2f(o[e]) * r * sub_g[e]);
  }
}

__device__ void nk_convgate(const bf16_t* U, const float* cw, const float* cb, bf16_t* G) {
  GRID_STRIDE(i, (long)T * DFF) {
    const int t = (int)(i / DFF), f = (int)(i % DFF); int s0, L; tok_seq(t, s0, L); const int pos = t - s0; float uc[2];
#pragma unroll
    for (int hf = 0; hf < 2; ++hf) {
      const int col = hf * DFF + f; const bf16_t* u = U + (long)t * DFF2 + col;
      float a = bf2f(u[0]) * cw[DFF2 + col] + cb[col];
      if (pos > 0) a += bf2f(u[-DFF2]) * cw[col];
      if (pos < L - 1) a += bf2f(u[DFF2]) * cw[2 * DFF2 + col];
      uc[hf] = a;
    }
    G[i] = f2bf(silu_f(uc[0]) * uc[1]);
  }
}

#ifndef HOST_EMU
#ifndef USE_ENGINE
#define USE_ENGINE 1
#endif
namespace pg8 {
#define PG8_LAS __attribute__((address_space(3)))
typedef unsigned short bf16_t;
typedef short bf16x8 __attribute__((ext_vector_type(8)));
typedef float f32x4 __attribute__((ext_vector_type(4)));
typedef unsigned u32x4 __attribute__((ext_vector_type(4)));
typedef unsigned u32x2v __attribute__((ext_vector_type(2)));
constexpr int BM = 256, BK = 64, HALF = 128, HTB = HALF * BK * 2  , STAGE_BYTES = 8 * HTB, NXCD = 8, WGM = 8;

__host__ __device__ __forceinline__ int lds_byte(int r, int c) { const int st = (r >> 4) * 2 + (c >> 5), rr = r & 15, cc = c & 31, ob = rr * 64 + cc * 2; return st * 1024 + (ob ^ (((ob >> 9) & 1) << 5)); }
__host__ __device__ __forceinline__ void stage_rc(int b, int& R, int& C) { const int st = b / 1024, sb = b % 1024, swz = sb ^ (((sb >> 9) & 1) << 5); R = (st >> 1) * 16 + swz / 64; C = (st & 1) * 32 + (swz % 64) / 2; }
__host__ __device__ __forceinline__ int perm32(int rho) { const int n = rho >> 4, i = rho & 15; return 8 * (i >> 2) + 4 * n + (i & 3); }

struct Unit { int pm, pn, kh; };
struct Gemm { const bf16_t* A; const bf16_t* Bt; int M, N, K, lda, ldb, a_pn_step, ksplit; };

struct StaticOrder {
    int nM, nN, nwg, G, c, ks;
    __host__ __device__ __forceinline__ void init(int M, int N, int G_, int c_, int ks_ = 1) { nM = M / BM; nN = (N / BM) * ks_; nwg = nM * nN; G = G_; c = c_; ks = ks_; }
    __host__ __device__ __forceinline__ bool next(int i, Unit& u) const {
        const long L = (long)i * G + c; if (L >= nwg) return false;
        int wgid = (int)L; { const int q = nwg / NXCD, r = nwg % NXCD, xcd = wgid % NXCD, off = wgid / NXCD; wgid = (xcd < r ? xcd * (q + 1) : r * (q + 1) + (xcd - r) * q) + off; }
        const int nig = WGM * nN, gid = wgid / nig, fm = gid * WGM, gsz = (nM - fm) < WGM ? (nM - fm) : WGM;
        u.pm = fm + ((wgid % nig) % gsz); const int pv = (wgid % nig) / gsz; u.kh = pv % ks; u.pn = pv / ks; return true;
    }
    __device__ __forceinline__ void a_ready(const Unit&) const {}
    __device__ __forceinline__ void done(const Unit&) const {}
};

struct LimitedOrder : StaticOrder {
    int maxr;
    __host__ __device__ __forceinline__ bool next(int i, Unit& u) const { return i < maxr && StaticOrder::next(i, u); }
};

__device__ __forceinline__ unsigned cvt_pk_bf16(float lo, float hi) { unsigned r; asm volatile("v_cvt_pk_bf16_f32 %0, %1, %2" : "=v"(r) : "v"(lo), "v"(hi)); return r; }
typedef float f32x2 __attribute__((ext_vector_type(2)));
__device__ __forceinline__ f32x2 gelu_pk(f32x2 v) {
    const f32x2 av = __builtin_elementwise_abs(v), d = av * 0.2316418882f + 1.0f;
    f32x2 t; t.x = __builtin_amdgcn_rcpf(d.x); t.y = __builtin_amdgcn_rcpf(d.y);
    f32x2 q = t * 0.5307027145f + (-0.7265760135f); q = q * t + 0.7107068705f; q = q * t + (-0.142248368f); q = q * t + 0.127414796f; q = q * t;
    const f32x2 s = (v * v) * (-0.72134752044f);
    f32x2 e; e.x = __builtin_amdgcn_exp2f(s.x); e.y = __builtin_amdgcn_exp2f(s.y);
    const f32x2 m = v * (q * e), r = v - m;
    f32x2 o; o.x = v.x < 0.f ? m.x : r.x; o.y = v.y < 0.f ? m.y : r.y; return o;
}

template <int ACT  > struct EpiBf16 {
    static constexpr bool PERM = true, AFTER_DRAIN = false; static_assert(ACT == 0 || ACT == 1, "EpiBf16: ACT is 0 (none) or 1 (gelu_pk)");
    bf16_t* O; int ldc; const float* bias; int split_cols; size_t split_stride; float scale0;
    __device__ __forceinline__ void operator()(const f32x4 (&acc)[2][2][4][2], const Unit& u, int wr, int wc, int fr, int fq) const {
        const int row0 = u.pm * BM + wr * 64 + fr; int colt = u.pn * BM; bf16_t* base = O;
        float sc = 1.f; if (split_cols) { const int t = colt / split_cols; base += (size_t)t * split_stride; colt -= t * split_cols; if (t == 0) sc = scale0; }
        const int col0 = colt + wc * 32 + 8 * fq, bcol0 = u.pn * BM + wc * 32 + 8 * fq;
        f32x4 bv[2][2];
#pragma unroll
        for (int bj = 0; bj < 2; ++bj)
#pragma unroll
            for (int n = 0; n < 2; ++n) bv[bj][n] = bias ? *(const f32x4*)(bias + bcol0 + bj * HALF + 4 * n) : (f32x4){0.f, 0.f, 0.f, 0.f};
#pragma unroll
        for (int ai = 0; ai < 2; ++ai)
#pragma unroll
            for (int m = 0; m < 4; ++m) { bf16_t* rowp = base + (size_t)(row0 + ai * HALF + m * 16) * ldc + col0;
#pragma unroll
                for (int bj = 0; bj < 2; ++bj) { f32x4 v0 = acc[ai][bj][m][0] + bv[bj][0], v1 = acc[ai][bj][m][1] + bv[bj][1];
                    if (ACT == 1) { f32x2 a = gelu_pk((f32x2){v0[0], v0[1]}), b = gelu_pk((f32x2){v0[2], v0[3]}), c = gelu_pk((f32x2){v1[0], v1[1]}), d = gelu_pk((f32x2){v1[2], v1[3]});
                        v0 = (f32x4){a.x, a.y, b.x, b.y}; v1 = (f32x4){c.x, c.y, d.x, d.y}; }
                    v0 = v0 * sc; v1 = v1 * sc; u32x4 w; w.x = cvt_pk_bf16(v0[0], v0[1]); w.y = cvt_pk_bf16(v0[2], v0[3]); w.z = cvt_pk_bf16(v1[0], v1[1]); w.w = cvt_pk_bf16(v1[2], v1[3]);
                    *(u32x4*)(rowp + bj * HALF) = w; } }
    }
};

struct EpiRes {
    static constexpr bool PERM = false, AFTER_DRAIN = false;
    float* X; const float* Xin_c; const float* Xin_l; const float* MODl; int gate_chunk; const float* colscale; const bf16_t* pend; bf16_t* slab;
    __device__ __forceinline__ void operator()(const f32x4 (&acc)[2][2][4][2], const Unit& u, int wr, int wc, int fr, int fq) const {
        const int row0 = u.pm * BM + wr * 64 + fr, col0 = u.pn * BM + wc * 32 + 4 * fq;
        const int trow = u.pm * BM; const int cond = trow < TCTX ? 0 : 1 + (trow - TCTX) / DEC_SEQ;
        const float* gate = MODl + (size_t)cond * MODW + gate_chunk * D;
        f32x4 gv[2][2];
#pragma unroll
        for (int bj = 0; bj < 2; ++bj)
#pragma unroll
            for (int n = 0; n < 2; ++n) { gv[bj][n] = *(const f32x4*)(gate + col0 + bj * HALF + n * 16); if (colscale) gv[bj][n] = gv[bj][n] * *(const f32x4*)(colscale + col0 + bj * HALF + n * 16); }
        if (u.kh == 0) {
#pragma unroll
          for (int ai = 0; ai < 2; ++ai)
#pragma unroll
            for (int m = 0; m < 4; ++m) { const size_t off = (size_t)(row0 + ai * HALF + m * 16) * D + col0;
#pragma unroll
                for (int bj = 0; bj < 2; ++bj)
#pragma unroll
                    for (int n = 0; n < 2; ++n) { f32x4* p = (f32x4*)(X + off + bj * HALF + n * 16); f32x4 v = *(const f32x4*)((trow < TCTX ? Xin_c : Xin_l) + off + bj * HALF + n * 16) + gv[bj][n] * acc[ai][bj][m][n];
                        if (pend) { const u32x2v q = *(const u32x2v*)(pend + off + bj * HALF + n * 16); v = v + (f32x4){__uint_as_float(q.x << 16), __uint_as_float(q.x & 0xffff0000u), __uint_as_float(q.y << 16), __uint_as_float(q.y & 0xffff0000u)}; }
                        *p = v; }
                asm volatile("" ::: "memory"); }
        } else {
#pragma unroll
          for (int ai = 0; ai < 2; ++ai)
#pragma unroll
            for (int m = 0; m < 4; ++m) { const size_t off = (size_t)(row0 + ai * HALF + m * 16) * D + col0;
#pragma unroll
                for (int bj = 0; bj < 2; ++bj)
#pragma unroll
                    for (int n = 0; n < 2; ++n) { const f32x4 v = gv[bj][n] * acc[ai][bj][m][n]; u32x2v q; q.x = cvt_pk_bf16(v[0], v[1]); q.y = cvt_pk_bf16(v[2], v[3]); *(u32x2v*)(slab + off + bj * HALF + n * 16) = q; } }
        }
    }
};

struct EpiConv {
    static constexpr bool PERM = true, AFTER_DRAIN = false;
    bf16_t* G; const float* cw; const float* cb; float* edgebuf; PG8_LAS unsigned* E;
    __device__ __forceinline__ static unsigned perm(unsigned v, int src4) { return (unsigned)__builtin_amdgcn_ds_bpermute(src4, (int)v); }
    __device__ __forceinline__ static float lo(unsigned u) { return __uint_as_float(u << 16); }
    __device__ __forceinline__ static float hi(unsigned u) { return __uint_as_float(u & 0xffff0000u); }
    __device__ __forceinline__ void operator()(const f32x4 (&acc)[2][2][4][2], const Unit& u, int wr, int wc, int fr_in, int fq_in) const {
        int fr = fr_in, fq = fq_in; asm volatile("" : "+v"(fr), "+v"(fq));
        const int lane = fq * 16 + fr, srcP4 = ((lane & 48) | ((fr + 15) & 15)) << 2, srcN4 = ((lane & 48) | ((fr + 1) & 15)) << 2;
        const int lc = wc * 32 + 8 * fq;
        unsigned pk[2][2][4][4];
#pragma unroll
        for (int ai = 0; ai < 2; ++ai)
#pragma unroll
          for (int bj = 0; bj < 2; ++bj)
#pragma unroll
            for (int m = 0; m < 4; ++m)
#pragma unroll
              for (int n = 0; n < 2; ++n) { const f32x4 v = acc[ai][bj][m][n]; pk[ai][bj][m][2 * n] = cvt_pk_bf16(v[0], v[1]); pk[ai][bj][m][2 * n + 1] = cvt_pk_bf16(v[2], v[3]); }
        if (fr == 0 || fr == 15) { const int which = fr == 0 ? 0 : 1;
#pragma unroll
          for (int ai = 0; ai < 2; ++ai)
#pragma unroll
            for (int bj = 0; bj < 2; ++bj) { u32x4 w;
              if (fr == 0) { w.x = pk[ai][bj][0][0]; w.y = pk[ai][bj][0][1]; w.z = pk[ai][bj][0][2]; w.w = pk[ai][bj][0][3]; } else { w.x = pk[ai][bj][3][0]; w.y = pk[ai][bj][3][1]; w.z = pk[ai][bj][3][2]; w.w = pk[ai][bj][3][3]; }
              *(PG8_LAS u32x4*)(E + (((ai * 2 + wr) * 2 + which) * 2 + bj) * 64 + (lc >> 1)) = w; } }
        if (u.pm * BM >= TCTX) { const bool top = (wr == 0 && fr < 2), bot = (wr == 1 && fr >= 14);
          if (top || bot) { const int r4 = top ? fr : fr - 12; float* eb = edgebuf + ((size_t)((u.pm - TCTX / BM) * (DFF / 128) + u.pn) * 4 + r4) * 256 + lc;
#pragma unroll
            for (int bj = 0; bj < 2; ++bj) { unsigned q0, q1, q2, q3;
              if (top) { q0 = pk[0][bj][0][0]; q1 = pk[0][bj][0][1]; q2 = pk[0][bj][0][2]; q3 = pk[0][bj][0][3]; } else { q0 = pk[1][bj][3][0]; q1 = pk[1][bj][3][1]; q2 = pk[1][bj][3][2]; q3 = pk[1][bj][3][3]; }
              *(f32x4*)(eb + bj * 128) = (f32x4){lo(q0), hi(q0), lo(q1), hi(q1)}; *(f32x4*)(eb + bj * 128 + 4) = (f32x4){lo(q2), hi(q2), lo(q3), hi(q3)}; } } }
        asm volatile("s_waitcnt lgkmcnt(0)" ::: "memory"); __builtin_amdgcn_s_barrier(); asm volatile("" ::: "memory");
        const int gcol = u.pn * 128 + lc;
#pragma unroll
        for (int ai = 0; ai < 2; ++ai) {
          float ca[4][8];
#pragma unroll
          for (int bj = 0; bj < 2; ++bj) {
            const int col = bj * DFF + gcol;
            float w0[8], w1[8], w2[8], bb[8];
#pragma unroll
            for (int e = 0; e < 8; e += 4) { const f32x4 a0 = *(const f32x4*)(cw + col + e), a1 = *(const f32x4*)(cw + DFF2 + col + e), a2 = *(const f32x4*)(cw + 2 * DFF2 + col + e), a3 = *(const f32x4*)(cb + col + e);
#pragma unroll
              for (int q = 0; q < 4; ++q) { w0[e + q] = a0[q]; w1[e + q] = a1[q]; w2[e + q] = a2[q]; bb[e + q] = a3[q]; } }
            u32x4 eP = (u32x4){0u, 0u, 0u, 0u}, eN = (u32x4){0u, 0u, 0u, 0u};
            if (wr == 1) eP = *(const PG8_LAS u32x4*)(E + (((ai * 2 + 0) * 2 + 1) * 2 + bj) * 64 + (lc >> 1));
            else if (ai == 1) eP = *(const PG8_LAS u32x4*)(E + (((0 * 2 + 1) * 2 + 1) * 2 + bj) * 64 + (lc >> 1));
            if (wr == 0) eN = *(const PG8_LAS u32x4*)(E + (((ai * 2 + 1) * 2 + 0) * 2 + bj) * 64 + (lc >> 1));
            else if (ai == 0) eN = *(const PG8_LAS u32x4*)(E + (((1 * 2 + 0) * 2 + 0) * 2 + bj) * 64 + (lc >> 1));
            unsigned spm1[4] = {eP.x, eP.y, eP.z, eP.w}, sn0[4];
#pragma unroll
            for (int h = 0; h < 4; ++h) sn0[h] = perm(pk[ai][bj][0][h], srcN4);
#pragma unroll
            for (int m = 0; m < 4; ++m) {
              unsigned sp[4], sn1[4] = {eN.x, eN.y, eN.z, eN.w};
#pragma unroll
              for (int h = 0; h < 4; ++h) { sp[h] = perm(pk[ai][bj][m][h], srcP4); if (m < 3) sn1[h] = perm(pk[ai][bj][m < 3 ? m + 1 : 3][h], srcN4); }
#pragma unroll
              for (int h = 0; h < 4; ++h) {
                const unsigned pv = fr == 0 ? spm1[h] : sp[h], nx = fr == 15 ? sn1[h] : sn0[h], cu = pk[ai][bj][m][h];
                const float c0 = lo(cu) * w1[2 * h] + bb[2 * h] + lo(pv) * w0[2 * h] + lo(nx) * w2[2 * h];
                const float c1 = hi(cu) * w1[2 * h + 1] + bb[2 * h + 1] + hi(pv) * w0[2 * h + 1] + hi(nx) * w2[2 * h + 1];
                if (bj == 0) { ca[m][2 * h] = c0; ca[m][2 * h + 1] = c1; }
                else { ca[m][2 * h] = ca[m][2 * h] / (1.0f + __expf(-ca[m][2 * h])) * c0; ca[m][2 * h + 1] = ca[m][2 * h + 1] / (1.0f + __expf(-ca[m][2 * h + 1])) * c1; }
                spm1[h] = sp[h]; sn0[h] = sn1[h];
              }
              if (bj == 1) { u32x4 w; w.x = cvt_pk_bf16(ca[m][0], ca[m][1]); w.y = cvt_pk_bf16(ca[m][2], ca[m][3]); w.z = cvt_pk_bf16(ca[m][4], ca[m][5]); w.w = cvt_pk_bf16(ca[m][6], ca[m][7]);
                *(u32x4*)(G + (size_t)(u.pm * BM + ai * HALF + wr * 64 + m * 16 + fr) * DFF + gcol) = w; }
            }
            asm volatile("" ::: "memory");
          }
        }
    }
};

struct EpiQK {
    static constexpr bool PERM = true, AFTER_DRAIN = false;
    bf16_t* O; int ldc, kcol0, vcol0; const float* qn; const float* kn; const float* rope; float* kout; float* vout; int kow; PG8_LAS float* SS;
    __device__ __forceinline__ static float perm(float v, int src4) { return __int_as_float(__builtin_amdgcn_ds_bpermute(src4, __float_as_int(v))); }
    __device__ __forceinline__ void operator()(const f32x4 (&acc)[2][2][4][2], const Unit& u, int wr, int wc, int fr_in, int fq_in) const {
        int fr = fr_in, fq = fq_in; asm volatile("" : "+v"(fr), "+v"(fq));
        const int lane = fq * 16 + fr, x16 = (lane ^ 16) << 2, x32 = (lane ^ 32) << 2;
        const int colt = u.pn * BM, kind = colt < kcol0 ? 0 : (colt < vcol0 ? 1 : 2);
        const bool lat = u.pm * BM >= TCTX;
        float ss[2][2][4];
        if (kind != 2) {
#pragma unroll
          for (int ai = 0; ai < 2; ++ai)
#pragma unroll
            for (int bj = 0; bj < 2; ++bj)
#pragma unroll
              for (int m = 0; m < 4; ++m) { const f32x4 a0 = acc[ai][bj][m][0], a1 = acc[ai][bj][m][1];
                float t = (a0[0] * a0[0] + a0[1] * a0[1]) + (a0[2] * a0[2] + a0[3] * a0[3]) + (a1[0] * a1[0] + a1[1] * a1[1]) + (a1[2] * a1[2] + a1[3] * a1[3]);
                t += perm(t, x16); t += perm(t, x32); ss[ai][bj][m] = t;
                if (fq == 0) SS[(((wr * 4 + wc) * 2 + ai) * 2 + bj) * 64 + m * 16 + fr] = t; }
        }
        asm volatile("s_waitcnt lgkmcnt(0)" ::: "memory"); __builtin_amdgcn_s_barrier(); asm volatile("" ::: "memory");
        const int dh = 32 * (wc & 1) + 8 * fq;
        f32x4 w0 = (f32x4){1.f, 1.f, 1.f, 1.f}, w1 = w0;
        if (kind != 2) { const float* wp = (kind == 0 ? qn : kn) + dh; w0 = *(const f32x4*)wp; w1 = *(const f32x4*)(wp + 4); }
        const bool x2side = (fq & 2) != 0;
#pragma unroll
        for (int ai = 0; ai < 2; ++ai)
#pragma unroll
          for (int m = 0; m < 4; ++m) {
            const int row = u.pm * BM + ai * HALF + wr * 64 + m * 16 + fr;
#pragma unroll
            for (int bj = 0; bj < 2; ++bj) {
              float y[8]; { const f32x4 a0 = acc[ai][bj][m][0], a1 = acc[ai][bj][m][1]; y[0] = a0[0]; y[1] = a0[1]; y[2] = a0[2]; y[3] = a0[3]; y[4] = a1[0]; y[5] = a1[1]; y[6] = a1[2]; y[7] = a1[3]; }
              if (kind != 2) {
                const float tot = ss[ai][bj][m] + SS[(((wr * 4 + (wc ^ 1)) * 2 + ai) * 2 + bj) * 64 + m * 16 + fr];
                const float r = 1.0f / sqrtf(tot / 64.0f + EPS);
                y[0] *= r * w0[0]; y[1] *= r * w0[1]; y[2] *= r * w0[2]; y[3] *= r * w0[3]; y[4] *= r * w1[0]; y[5] *= r * w1[1]; y[6] *= r * w1[2]; y[7] *= r * w1[3];
                if (lat) { const int pos = (row - TCTX) % DEC_SEQ; const f32x4* tb = (const f32x4*)(rope + ((size_t)(pos * 2 + (wc & 1)) * 16 + 8 * (fq & 1)) * 2);
#pragma unroll
                  for (int e2 = 0; e2 < 4; ++e2) { const f32x4 cs = tb[e2]; const float p0 = perm(y[2 * e2], x32), p1 = perm(y[2 * e2 + 1], x32);
                    y[2 * e2] = x2side ? y[2 * e2] * cs[0] + p0 * cs[1] : y[2 * e2] * cs[0] - p0 * cs[1];
                    y[2 * e2 + 1] = x2side ? y[2 * e2 + 1] * cs[2] + p1 * cs[3] : y[2 * e2 + 1] * cs[2] - p1 * cs[3]; } }
              }
              const int cl = bj * HALF + wc * 32 + 8 * fq;
              u32x4 w; w.x = cvt_pk_bf16(y[0], y[1]); w.y = cvt_pk_bf16(y[2], y[3]); w.z = cvt_pk_bf16(y[4], y[5]); w.w = cvt_pk_bf16(y[6], y[7]);
              *(u32x4*)(O + (size_t)row * ldc + colt + cl) = w;
              if (!lat && kind != 0) { float* op = (kind == 1 ? kout + (size_t)row * kow + (colt - kcol0) : vout + (size_t)row * kow + (colt - vcol0)) + cl;
                *(f32x4*)op = (f32x4){y[0], y[1], y[2], y[3]}; *(f32x4*)(op + 4) = (f32x4){y[4], y[5], y[6], y[7]}; }
            }
            asm volatile("" ::: "memory");
          }
    }
};

template <class Epi, class Sched, bool ALIGN_EPI = false, bool SP2 = false>
__device__ __forceinline__ void gemm_phase(PG8_LAS unsigned char* lds, const Gemm g, const Sched& S, const Epi& E) {
    int tid_ = threadIdx.x; asm volatile("" : "+v"(tid_));
    const int tid = tid_, wid = __builtin_amdgcn_readfirstlane(tid >> 6), lane = tid & 63, wr = wid >> 2, wc = wid & 3, fr = lane & 15, fq = lane >> 4;
    const int K = g.K / g.ksplit, nt = K / BK;
    unsigned voffA[2], voffB[2];
#pragma unroll
    for (int i = 0; i < 2; ++i) { int R, C; stage_rc(tid * 16 + i * 8192, R, C); const int Rb = Epi::PERM ? ((R & ~31) + perm32(R & 31)) : R;
        voffA[i] = (unsigned)(R * g.lda + C) * 2u; voffB[i] = (unsigned)(Rb * g.ldb + C) * 2u; }
    const size_t kstep = (size_t)(BK * 2);
    const size_t hstepA = (size_t)HALF * g.lda * 2, hstepB = (size_t)HALF * g.ldb * 2;
    const size_t tstepA = 2 * hstepA, tstepB = 2 * hstepB, pnstepA = (size_t)g.a_pn_step * 2, khstep = (size_t)K * 2;
    const unsigned ldsw = (unsigned)wid * 1024u;
    const int aoff = lds_byte(wr * 64 + fr, fq * 8), boff = lds_byte(wc * 32 + fr, fq * 8);
#define PG8_SA(b, h) (((b) * 2 + (h)) * HTB)
#define PG8_SB(b, h) ((4 + (b) * 2 + (h)) * HTB)
#define PG8_STAGE(bufoff, gbase, voff) do { _Pragma("unroll") for (int _i = 0; _i < 2; ++_i) \
        __builtin_amdgcn_global_load_lds((const unsigned*)((const char*)(gbase) + (voff)[_i]), (PG8_LAS unsigned*)(lds + (bufoff) + ldsw + _i * 8192), 16, 0, 0); } while (0)
#define PG8_LDA(dst, b, h) do { _Pragma("unroll") for (int m = 0; m < 4; ++m) _Pragma("unroll") for (int k = 0; k < 2; ++k) dst[m][k] = *(const PG8_LAS bf16x8*)(lds + PG8_SA(b, h) + aoff + m * 2048 + k * 1024); } while (0)
#define PG8_LDB(dst, b, h) do { _Pragma("unroll") for (int n = 0; n < 2; ++n) _Pragma("unroll") for (int k = 0; k < 2; ++k) dst[n][k] = *(const PG8_LAS bf16x8*)(lds + PG8_SB(b, h) + boff + n * 2048 + k * 1024); } while (0)
#define PG8_MMA(ai, bj, At, Bt) do { __builtin_amdgcn_s_setprio(1); _Pragma("unroll") for (int m = 0; m < 4; ++m) _Pragma("unroll") for (int n = 0; n < 2; ++n) _Pragma("unroll") for (int k = 0; k < 2; ++k) \
        acc[ai][bj][m][n] = __builtin_amdgcn_mfma_f32_16x16x32_bf16(Bt[n][k], At[m][k], acc[ai][bj][m][n], 0, 0, 0); __builtin_amdgcn_s_setprio(0); } while (0)
#define PG8_WAIT_V(n) asm volatile("s_waitcnt vmcnt(" #n ")" ::: "memory")
#define PG8_WAIT_L(n) asm volatile("s_waitcnt lgkmcnt(" #n ")" ::: "memory")
#define PG8_BAR __builtin_amdgcn_s_barrier()
#define PG8_SCHED __builtin_amdgcn_sched_barrier(0)
    Unit cur, nxt; int ui = 0;
    if (!S.next(0, cur)) return;
    f32x4 acc[2][2][4][2];
#pragma unroll
    for (int a = 0; a < 2; ++a)
#pragma unroll
        for (int b = 0; b < 2; ++b)
#pragma unroll
            for (int m = 0; m < 4; ++m)
#pragma unroll
                for (int n = 0; n < 2; ++n) acc[a][b][m][n] = (f32x4){0.f, 0.f, 0.f, 0.f};
    bf16x8 At[4][2], B0[2][2], B1[2][2];
    const char* cA = (const char*)g.A + (size_t)cur.pm * tstepA + (size_t)cur.pn * pnstepA + (size_t)cur.kh * khstep; const char* cB = (const char*)g.Bt + (size_t)cur.pn * tstepB + (size_t)cur.kh * khstep;
    S.a_ready(cur);
    if constexpr (SP2) {
        PG8_STAGE(PG8_SB(0, 0), cB, voffB); PG8_STAGE(PG8_SB(0, 1), cB + hstepB, voffB); PG8_STAGE(PG8_SA(0, 0), cA, voffA); PG8_STAGE(PG8_SA(0, 1), cA + hstepA, voffA);
        if (wr == 1) PG8_BAR;
        PG8_WAIT_V(2); PG8_BAR;
        PG8_STAGE(PG8_SB(1, 0), cB + kstep, voffB); PG8_STAGE(PG8_SA(1, 0), cA + kstep, voffA); PG8_STAGE(PG8_SB(1, 1), cB + hstepB + kstep, voffB);
        PG8_WAIT_V(6); PG8_BAR;
    } else {
        PG8_STAGE(PG8_SB(0, 0), cB, voffB); PG8_STAGE(PG8_SA(0, 0), cA, voffA); PG8_STAGE(PG8_SB(0, 1), cB + hstepB, voffB); PG8_STAGE(PG8_SA(0, 1), cA + hstepA, voffA);
        if (wr == 1) PG8_BAR;
        PG8_WAIT_V(4); PG8_BAR;
        PG8_STAGE(PG8_SB(1, 0), cB + kstep, voffB); PG8_STAGE(PG8_SA(1, 0), cA + kstep, voffA); PG8_STAGE(PG8_SB(1, 1), cB + hstepB + kstep, voffB);
        PG8_WAIT_V(6); PG8_BAR;
    }
    for (;;) {
        const bool has_next = S.next(ui + 1, nxt);
        const char* nA = has_next ? (const char*)g.A + (size_t)nxt.pm * tstepA + (size_t)nxt.pn * pnstepA + (size_t)nxt.kh * khstep : cA; const char* nB = has_next ? (const char*)g.Bt + (size_t)nxt.pn * tstepB + (size_t)nxt.kh * khstep : cB;
        for (int t = 0; t < nt; t += 2) {
            const bool last = (t == nt - 2);
            const char* a1 = cA + (size_t)(t + 1) * kstep;
            const char* a2 = last ? nA : cA + (size_t)(t + 2) * kstep; const char* b2 = last ? nB : cB + (size_t)(t + 2) * kstep;
            const char* a3 = a2 + kstep; const char* b3 = b2 + kstep;
            if (last && has_next) S.a_ready(nxt);
            if constexpr (SP2) {
            PG8_LDB(B0, 0, 0); PG8_LDB(B1, 0, 1); PG8_SCHED; PG8_LDA(At, 0, 0); PG8_STAGE(PG8_SA(1, 1), a1 + hstepA, voffA);
            PG8_WAIT_V(8); PG8_WAIT_L(0); PG8_BAR; PG8_MMA(0, 0, At, B0); PG8_MMA(0, 1, At, B1); PG8_BAR; PG8_SCHED;
            PG8_LDA(At, 0, 1); PG8_STAGE(PG8_SB(0, 0), b2, voffB); PG8_STAGE(PG8_SB(0, 1), b2 + hstepB, voffB); PG8_STAGE(PG8_SA(0, 0), a2, voffA);
            PG8_WAIT_V(8); PG8_WAIT_L(0); PG8_BAR; PG8_MMA(1, 0, At, B0); PG8_MMA(1, 1, At, B1); PG8_BAR; PG8_SCHED;
            PG8_LDB(B0, 1, 0); PG8_LDB(B1, 1, 1); PG8_SCHED; PG8_LDA(At, 1, 0); PG8_STAGE(PG8_SA(0, 1), a2 + hstepA, voffA);
            PG8_WAIT_V(8); PG8_WAIT_L(0); PG8_BAR; PG8_MMA(0, 0, At, B0); PG8_MMA(0, 1, At, B1); PG8_BAR; PG8_SCHED;
            PG8_LDA(At, 1, 1); PG8_STAGE(PG8_SB(1, 0), b3, voffB); PG8_STAGE(PG8_SB(1, 1), b3 + hstepB, voffB); PG8_STAGE(PG8_SA(1, 0), a3, voffA);
            PG8_WAIT_V(8); PG8_WAIT_L(0); PG8_BAR; PG8_MMA(1, 0, At, B0); PG8_MMA(1, 1, At, B1); PG8_BAR; PG8_SCHED;
            } else {
            PG8_LDB(B0, 0, 0); PG8_SCHED; PG8_LDA(At, 0, 0); PG8_STAGE(PG8_SA(1, 1), a1 + hstepA, voffA);
            PG8_WAIT_L(8); PG8_BAR; PG8_WAIT_L(0); PG8_MMA(0, 0, At, B0); PG8_BAR; PG8_SCHED;
            PG8_LDB(B1, 0, 1); PG8_STAGE(PG8_SB(0, 0), b2, voffB);
            PG8_BAR; PG8_WAIT_L(0); PG8_MMA(0, 1, At, B1); PG8_BAR;
            PG8_LDA(At, 0, 1); PG8_STAGE(PG8_SA(0, 0), a2, voffA);
            PG8_BAR; PG8_WAIT_L(0); PG8_MMA(1, 0, At, B0); PG8_BAR; PG8_SCHED;
            PG8_STAGE(PG8_SB(0, 1), b2 + hstepB, voffB);
            PG8_WAIT_V(6); PG8_BAR; PG8_MMA(1, 1, At, B1); PG8_BAR;
            PG8_LDB(B0, 1, 0); PG8_SCHED; PG8_LDA(At, 1, 0); PG8_STAGE(PG8_SA(0, 1), a2 + hstepA, voffA);
            PG8_WAIT_L(8); PG8_BAR; PG8_WAIT_L(0); PG8_MMA(0, 0, At, B0); PG8_BAR; PG8_SCHED;
            PG8_LDB(B1, 1, 1); PG8_STAGE(PG8_SB(1, 0), b3, voffB);
            PG8_BAR; PG8_WAIT_L(0); PG8_MMA(0, 1, At, B1); PG8_BAR;
            PG8_LDA(At, 1, 1); PG8_STAGE(PG8_SA(1, 0), a3, voffA);
            PG8_BAR; PG8_WAIT_L(0); PG8_MMA(1, 0, At, B0); PG8_BAR; PG8_SCHED;
            PG8_STAGE(PG8_SB(1, 1), b3 + hstepB, voffB);
            PG8_WAIT_V(6); PG8_BAR; PG8_MMA(1, 1, At, B1); PG8_BAR;
            }
        }
        if constexpr (ALIGN_EPI) { if (wr == 0) PG8_BAR; }
        if constexpr (!Epi::AFTER_DRAIN) { E(acc, cur, wr, wc, fr, fq); S.done(cur); }
        if (!has_next) break;
#pragma unroll
        for (int a = 0; a < 2; ++a)
#pragma unroll
            for (int b = 0; b < 2; ++b)
#pragma unroll
                for (int m = 0; m < 4; ++m)
#pragma unroll
                    for (int n = 0; n < 2; ++n) acc[a][b][m][n] = (f32x4){0.f, 0.f, 0.f, 0.f};
        cur = nxt; cA = nA; cB = nB; ++ui;
        if constexpr (ALIGN_EPI) { if (wr == 1) PG8_BAR; }
    }
    PG8_WAIT_V(0);
    if constexpr (!ALIGN_EPI) { if (wr == 0) PG8_BAR; }
    PG8_BAR;
    if constexpr (Epi::AFTER_DRAIN) { E.fused(acc, cur, wr, wc, fr, fq, lds, wid, lane); S.done(cur); }
#undef PG8_SA
#undef PG8_SB
#undef PG8_STAGE
#undef PG8_LDA
#undef PG8_LDB
#undef PG8_MMA
#undef PG8_WAIT_V
#undef PG8_WAIT_L
#undef PG8_BAR
#undef PG8_SCHED
}
}
#endif

enum { I_XP, I_XS, I_CGK, I_CGV, I_CDK, I_CDV, I_CWK, I_CWV, I_C, I_CCTX, I_N1G, I_N2G, I_WMOD, I_BMOD, I_FWIN, I_FCW, I_FCB, I_FWOUT,
       I_POOLW, I_POOLS, I_GQKV, I_GQN, I_GKN, I_GWO, I_DQKV, I_DQN, I_DKN, I_DLQ1, I_DLK1, I_DLQ2, I_DLK2, I_DSUB, I_DWO,
       I_WQKV, I_WQN, I_WKN, I_WSINK, I_WWO, N_IN };
struct Params { const float* in[N_IN]; float* out; unsigned char* ws; };
#ifdef HOST_EMU
static inline const float* pin(const Params& P, int i) { return P.in[i]; }
#else
__device__ __forceinline__ const float* pin(const Params& P, int i) { asm volatile("" : "+s"(i)); return P.in[i]; }
#endif

constexpr size_t MiB = (size_t)1 << 20;
constexpr size_t WS_CTL = 1 * MiB + 576 * 1024, CTL_ZERO_BYTES = 16384;
constexpr size_t WS_EDGE = 1 * MiB + 640 * 1024;
constexpr size_t WS_MOD = 0, WS_RSTD = 1 * MiB, WS_ROPE = 1 * MiB + 256 * 1024;
constexpr size_t WS_WIN = 3 * MiB;
constexpr size_t WS_WOUT = WS_WIN + (size_t)4 * DFF2 * D * 2;
constexpr size_t WS_GQKV = WS_WOUT + (size_t)4 * D * DFF * 2;
constexpr size_t WS_GWO = WS_GQKV + (size_t)1536 * D * 2, WS_DQKV = WS_GWO + (size_t)D * D * 2, WS_DWO = WS_DQKV + (size_t)3072 * D * 2;
constexpr size_t WS_WQKV = WS_DWO + (size_t)D * D * 2, WS_WWO = WS_WQKV + (size_t)1536 * D * 2, WS_POOL = WS_WWO + (size_t)D * D * 2;
constexpr size_t WS_HB = WS_POOL + (size_t)1024 * 256 * 2;
constexpr size_t WS_UB = WS_HB + (size_t)T * D * 2;
constexpr size_t WS_QKV = WS_UB, WS_OB = WS_QKV + (size_t)T * 3072 * 2, WS_PD = WS_QKV;
constexpr size_t UB_BYTES = ((size_t)T * DFF2 * 2 > (size_t)T * 4096 * 2) ? (size_t)T * DFF2 * 2 : (size_t)T * 4096 * 2;
constexpr size_t WS_GB = WS_UB + UB_BYTES;
constexpr size_t WS_SA = WS_GB + (size_t)T * DFF * 2, WS_SB = WS_SA + (size_t)T * D * 4;
constexpr size_t WS_END = WS_SB + (size_t)T * D * 4;
static_assert(WS_END <= 256 * MiB, "d_ws map");

constexpr int STEPS_PER_LAYER = 13, N_PRE = 3, N_STEPS = N_PRE + 4 * STEPS_PER_LAYER;

struct Ctx {
  float* out_; unsigned char* ws_;
#ifdef HOST_EMU
  float* out_p() const { return out_; } unsigned char* ws_p() const { return ws_; }
#else
  __device__ __forceinline__ float* out_p() const { float* p = out_; asm volatile("" : "+s"(p)); return p; }
  __device__ __forceinline__ unsigned char* ws_p() const { unsigned char* p = ws_; asm volatile("" : "+s"(p)); return p; }
#endif
  __device__ __forceinline__ float* X() const { return out_p(); }
  __device__ __forceinline__ float* o_gk() const { return out_p() + (size_t)T * D; }
  __device__ __forceinline__ float* o_gv() const { return o_gk() + (size_t)TCTX * 256; }
  __device__ __forceinline__ float* o_dk() const { return o_gv() + (size_t)TCTX * 256; }
  __device__ __forceinline__ float* o_dv() const { return o_dk() + (size_t)TCTX * 1024; }
  __device__ __forceinline__ float* o_wk() const { return o_dv() + (size_t)TCTX * 1024; }
  __device__ __forceinline__ float* o_wv() const { return o_wk() + (size_t)TCTX * 256; }
  __device__ __forceinline__ float* MOD() const { return (float*)(ws_p() + WS_MOD); }
  __device__ __forceinline__ float* RSTD() const { return (float*)(ws_p() + WS_RSTD); }
  __device__ __forceinline__ float* ROPE() const { return (float*)(ws_p() + WS_ROPE); }
  __device__ __forceinline__ bf16_t* bf(size_t off) const { return (bf16_t*)(ws_p() + off); }
  __device__ __forceinline__ bf16_t* WinT() const { return bf(WS_WIN); }
  __device__ __forceinline__ bf16_t* WoutT() const { return bf(WS_WOUT); }
  __device__ __forceinline__ bf16_t* GqkvT() const { return bf(WS_GQKV); }
  __device__ __forceinline__ bf16_t* GwoT() const { return bf(WS_GWO); }
  __device__ __forceinline__ bf16_t* DqkvT() const { return bf(WS_DQKV); }
  __device__ __forceinline__ bf16_t* DwoT() const { return bf(WS_DWO); }
  __device__ __forceinline__ bf16_t* WqkvT() const { return bf(WS_WQKV); }
  __device__ __forceinline__ bf16_t* WwoT() const { return bf(WS_WWO); }
  __device__ __forceinline__ bf16_t* PoolT() const { return bf(WS_POOL); }
  __device__ __forceinline__ bf16_t* Hb() const { return bf(WS_HB); }
  __device__ __forceinline__ bf16_t* Ub() const { return bf(WS_UB); }
  __device__ __forceinline__ bf16_t* QKVb() const { return bf(WS_QKV); }
  __device__ __forceinline__ bf16_t* Ob() const { return bf(WS_OB); }
  __device__ __forceinline__ bf16_t* PDb() const { return bf(WS_PD); }
  __device__ __forceinline__ bf16_t* Gb() const { return bf(WS_GB); }
};
__device__ __forceinline__ Ctx make_ctx(const Params& P) { Ctx c; c.out_ = P.out; c.ws_ = P.ws; return c; }

#ifndef KSPLIT
#define KSPLIT 2
#endif
struct GemmDesc { const bf16_t* A; int lda, a_pn_step; const bf16_t* Bt; int ldb, N, K; bool res; bf16_t* C; int ldc; int gate_chunk; const float* colscale; int ksplit; };
__device__ __forceinline__ bool gemm_desc(int step, const Params& P, const Ctx& c, GemmDesc& g) {
  if (step < N_PRE) return false;
  const int l = (step - N_PRE) / STEPS_PER_LAYER, s = (step - N_PRE) % STEPS_PER_LAYER;
  g.a_pn_step = 0; g.colscale = nullptr; g.C = nullptr; g.ldc = 0; g.gate_chunk = 0; g.res = false; g.ksplit = 1;
  if (s == 2 && l != 0) { const int N = (l == 2) ? 3072 : 1536; g.A = c.Hb(); g.lda = D; g.Bt = c.bf(l == 1 ? WS_GQKV : (l == 2 ? WS_DQKV : WS_WQKV)); g.ldb = D; g.N = N; g.K = D; g.C = c.QKVb(); g.ldc = N; return true; }
  if (s == 7) {
    g.res = true; g.gate_chunk = 2;
    if (l == 0) { g.A = c.PDb(); g.lda = D; g.a_pn_step = 256; g.Bt = c.PoolT(); g.ldb = 256; g.N = D; g.K = 256; g.colscale = pin(P, I_POOLS); }
    else { g.A = c.Ob(); g.lda = D; g.Bt = c.bf(l == 1 ? WS_GWO : (l == 2 ? WS_DWO : WS_WWO)); g.ldb = D; g.N = D; g.K = D; g.ksplit = KSPLIT; }
    return true;
  }
  if (s == 10) { g.A = c.Hb(); g.lda = D; g.Bt = c.WinT() + (size_t)l * DFF2 * D; g.ldb = D; g.N = DFF2; g.K = D; g.C = c.Ub(); g.ldc = DFF2; return true; }
  if (s == 12) { g.res = true; g.gate_chunk = 5; g.A = c.Gb(); g.lda = DFF; g.Bt = c.WoutT() + (size_t)l * D * DFF; g.ldb = DFF; g.N = D; g.K = DFF; g.ksplit = (DFF % 256 == 0) ? KSPLIT : 1; return true; }
  return false;
}

__device__ __forceinline__ void naive_step(int step, const Params& P, const Ctx& c) {
#define IN(i) (pin(P, (i)))
  if (step == 0) { nk_copy_x(IN(I_XP), IN(I_XS), c.X()); return; }
  if (step == 1) { nk_mod(IN(I_C), IN(I_CCTX), IN(I_WMOD), IN(I_BMOD), c.MOD(), 4); nk_rope_table(c.ROPE()); return; }
  if (step == 2) {
    for (int l = 0; l < 4; ++l) { nk_wt(IN(I_FWIN) + (size_t)l * D * DFF2, D, DFF2, c.WinT() + (size_t)l * DFF2 * D); nk_wt(IN(I_FWOUT) + (size_t)l * DFF * D, DFF, D, c.WoutT() + (size_t)l * D * DFF); }
    nk_wt(IN(I_GQKV), D, 1536, c.GqkvT()); nk_wt(IN(I_GWO), D, D, c.GwoT()); nk_wt(IN(I_DQKV), D, 3072, c.DqkvT()); nk_wt(IN(I_DWO), D, D, c.DwoT());
    nk_wt(IN(I_WQKV), D, 1536, c.WqkvT()); nk_wt(IN(I_WWO), D, D, c.WwoT());
    for (int g = 0; g < 4; ++g) nk_wt(IN(I_POOLW) + g * 256 * 256, 256, 256, c.PoolT() + g * 256 * 256);
    return;
  }
  const int l = (step - N_PRE) / STEPS_PER_LAYER, s = (step - N_PRE) % STEPS_PER_LAYER;
  const float* MODl = c.MOD() + (long)l * NCOND * MODW;
  const bool gq = (l == 1 || l == 3);
  const float* qn = IN(l == 1 ? I_GQN : I_WQN); const float* kn = IN(l == 1 ? I_GKN : I_WKN);
  const float* ck = IN(l == 1 ? I_CGK : I_CWK); const float* cv = IN(l == 1 ? I_CGV : I_CWV);
  const float lam_init = 0.8f - 0.6f * expf(-0.3f * (float)l);
  GemmDesc g;
  if (gemm_desc(step, P, c, g)) {
    if (g.res) nk_gemm_res(g.A, g.lda, g.a_pn_step, g.Bt, g.ldb, c.X(), T, g.N, g.K, MODl, g.gate_chunk, g.colscale);
    else nk_gemm_bf(g.A, g.lda, g.Bt, g.ldb, g.C, g.ldc, T, g.N, g.K);
    return;
  }
  switch (s) {
    case 0: nk_rstd(c.X(), c.RSTD()); break;
    case 1: nk_normmod(c.X(), c.RSTD(), IN(I_N1G) + l * D, MODl, 0, 1, c.Hb()); break;
    case 2: if (l == 0) nk_pool(c.Hb(), c.PDb()); break;
    case 3:
      if (l == 0) break;
      if (gq) { nk_qknorm_rope(c.QKVb(), 1536, 16, 4, 1024, qn, kn, l == 1 ? c.o_gk() : c.o_wk()); nk_copy_cols_f(c.QKVb(), 1536, 1280, 256, TCTX, l == 1 ? c.o_gv() : c.o_wv()); }
      else { nk_qknorm_rope(c.QKVb(), 3072, 16, 16, 1024, IN(I_DQN), IN(I_DKN), c.o_dk()); nk_copy_cols_f(c.QKVb(), 3072, 2048, 1024, TCTX, c.o_dv()); }
      break;
    case 5:
      if (l == 0) break;
      if (l == 1) nk_attn<0>(c.QKVb(), 1536, 1024, 1280, ck, cv, 256, nullptr, nullptr, nullptr, nullptr, nullptr, 0.f, c.Ob());
      else if (l == 3) nk_attn<1>(c.QKVb(), 1536, 1024, 1280, ck, cv, 256, IN(I_WSINK), nullptr, nullptr, nullptr, nullptr, 0.f, c.Ob());
      else nk_attn<2>(c.QKVb(), 3072, 1024, 2048, IN(I_CDK), IN(I_CDV), 1024, nullptr, IN(I_DLQ1), IN(I_DLK1), IN(I_DLQ2), IN(I_DLK2), lam_init, c.Ob());
      break;
    case 6: if (l == 2) nk_subnorm(c.Ob(), IN(I_DSUB), 1.0f - lam_init); break;
    case 8: nk_rstd(c.X(), c.RSTD()); break;
    case 9: nk_normmod(c.X(), c.RSTD(), IN(I_N2G) + l * D, MODl, 3, 4, c.Hb()); break;
    case 11: nk_convgate(c.Ub(), IN(I_FCW) + (long)l * 3 * DFF2, IN(I_FCB) + (long)l * DFF2, c.Gb()); break;
    default: break;
  }
#undef IN
}
__device__ __forceinline__ bool step_is_noop(int step) {
  if (step < N_PRE) return false;
  const int l = (step - N_PRE) / STEPS_PER_LAYER, s = (step - N_PRE) % STEPS_PER_LAYER;
  if (s == 4) return true;
  if (l == 0 && (s == 3 || s == 5)) return true;
  if (l != 2 && s == 6) return true;
  return false;
}


#ifndef HOST_EMU
#define LAS __attribute__((address_space(3)))
typedef float f32x4 __attribute__((ext_vector_type(4)));
typedef float f32x2 __attribute__((ext_vector_type(2)));
typedef unsigned u32x4 __attribute__((ext_vector_type(4)));
typedef unsigned u32x2 __attribute__((ext_vector_type(2)));
typedef __bf16 bf16x2_t __attribute__((ext_vector_type(2)));
__device__ __forceinline__ unsigned pk_bf16(float lo, float hi) { f32x2 v = {lo, hi}; bf16x2_t b = __builtin_convertvector(v, bf16x2_t); return __builtin_bit_cast(unsigned, b); }
__device__ __forceinline__ float bf_lo(unsigned u) { return __uint_as_float(u << 16); }
__device__ __forceinline__ float bf_hi(unsigned u) { return __uint_as_float(u & 0xffff0000u); }
__device__ __forceinline__ int opaque_i(int v) { asm volatile("" : "+v"(v)); return v; }
__device__ __forceinline__ int opaque_block() { int b = (int)blockIdx.x; asm volatile("" : "+s"(b)); return b; }
__device__ __forceinline__ float shx(float v, int mask, int lane) { return __int_as_float(__builtin_amdgcn_ds_bpermute((lane ^ mask) << 2, __float_as_int(v))); }
__device__ __forceinline__ float wave_sum(float v, int lane) {
#pragma unroll
  for (int o = 1; o < 64; o <<= 1) v += shx(v, o, lane);
  return v;
}
struct WaveId { int lane, wave, gw, ngw; };
__device__ __forceinline__ WaveId wave_id() { WaveId w; const int tid = opaque_i((int)threadIdx.x); w.lane = tid & 63; w.wave = __builtin_amdgcn_readfirstlane(tid >> 6); w.gw = opaque_block() * 8 + w.wave; w.ngw = (int)gridDim.x * 8; return w; }

__device__ __forceinline__ void ph_norm(const float* Xc, const float* Xl, const bf16_t* pend, const float* g, const float* MODl, int sh_chunk, int sc_chunk, bf16_t* Hb) {
  const WaveId w = wave_id();
  for (int t = w.gw; t < T; t += w.ngw) {
    const f32x4* xr = (const f32x4*)((t < TCTX ? Xc : Xl) + (size_t)t * D) + w.lane;
    f32x4 v[4]; float ss = 0.f;
#pragma unroll
    for (int j = 0; j < 4; ++j) { v[j] = xr[64 * j]; if (pend) { const u32x2 q = ((const u32x2*)(pend + (size_t)t * D) + w.lane)[64 * j]; v[j] = v[j] + (f32x4){bf_lo(q.x), bf_hi(q.x), bf_lo(q.y), bf_hi(q.y)}; } ss += (v[j].x * v[j].x + v[j].y * v[j].y) + (v[j].z * v[j].z + v[j].w * v[j].w); }
    const float rstd = 1.0f / sqrtf(wave_sum(ss, w.lane) / (float)D + EPS);
    const float* m = MODl + (size_t)tok_cond(t) * MODW;
    u32x2* o = (u32x2*)(Hb + (size_t)t * D) + w.lane;
#pragma unroll
    for (int j = 0; j < 4; ++j) {
      const int col = 4 * w.lane + 256 * j;
      const f32x4 gg = *(const f32x4*)(g + col), sc = *(const f32x4*)(m + sc_chunk * D + col), sh = *(const f32x4*)(m + sh_chunk * D + col);
      const f32x4 y = v[j] * rstd * gg * (1.0f + sc) + sh;
      u32x2 pk; pk.x = pk_bf16(y.x, y.y); pk.y = pk_bf16(y.z, y.w); o[64 * j] = pk;
    }
  }
}

__device__ __forceinline__ void unpack8(const u32x4 r, float (&x)[8]) { x[0] = bf_lo(r.x); x[1] = bf_hi(r.x); x[2] = bf_lo(r.y); x[3] = bf_hi(r.y); x[4] = bf_lo(r.z); x[5] = bf_hi(r.z); x[6] = bf_lo(r.w); x[7] = bf_hi(r.w); }
__device__ __forceinline__ u32x4 pack8(const float (&y)[8]) { u32x4 r; r.x = pk_bf16(y[0], y[1]); r.y = pk_bf16(y[2], y[3]); r.z = pk_bf16(y[4], y[5]); r.w = pk_bf16(y[6], y[7]); return r; }

__device__ __forceinline__ void ph_pool(const bf16_t* Hb, bf16_t* PDb) {
  const int tid0 = (opaque_block() * 512 + opaque_i((int)threadIdx.x)), nth = (int)(gridDim.x * blockDim.x);
  for (int i = tid0; i < T * 128; i += nth) {
    const int t = i >> 7, c8 = i & 127, g = c8 >> 5, wdw = 2 << g; int s0, L; tok_seq(t, s0, L);
    const int pos = t - s0; int lo = pos - wdw / 2, hi = pos - wdw / 2 + wdw; lo = lo < 0 ? 0 : lo; hi = hi > L ? L : hi;
    float acc[8], x[8];
#pragma unroll
    for (int e = 0; e < 8; ++e) acc[e] = 0.f;
    for (int j = lo; j < hi; ++j) { unpack8(*(const u32x4*)(Hb + (size_t)(s0 + j) * D + 8 * c8), x);
#pragma unroll
      for (int e = 0; e < 8; ++e) acc[e] += x[e]; }
    unpack8(*(const u32x4*)(Hb + (size_t)t * D + 8 * c8), x);
    const float cnt = (float)(hi - lo); float y[8];
#pragma unroll
    for (int e = 0; e < 8; ++e) y[e] = acc[e] / cnt - x[e];
    *(u32x4*)(PDb + (size_t)t * D + 8 * c8) = pack8(y);
  }
}

__device__ __forceinline__ void ph_qkpost(bf16_t* QKV, int ld, int nq, int nk, int nv, int kcol0, int vcol0, const float* qn, const float* kn, const float* rope, float* kout, float* vout) {
  const WaveId w = wave_id(); const int NG = (nq + nk + nv) >> 3, sl = w.lane >> 3, j = w.lane & 7;
  for (int it = w.gw; it < T * NG; it += w.ngw) {
    const int t = it / NG, sg = it - t * NG, slot = sg * 8 + sl; const bool lat = t >= TCTX;
    const int kind = slot < nq ? 0 : (slot < nq + nk ? 1 : 2);
    const int col = kind == 0 ? slot * 64 : (kind == 1 ? kcol0 + (slot - nq) * 64 : vcol0 + (slot - nq - nk) * 64);
    bf16_t* p = QKV + (size_t)t * ld + col + 8 * j;
    float x[8], y[8]; unpack8(*(const u32x4*)p, x);
    float ss = 0.f;
#pragma unroll
    for (int e = 0; e < 8; ++e) ss += x[e] * x[e];
    ss += shx(ss, 1, w.lane); ss += shx(ss, 2, w.lane); ss += shx(ss, 4, w.lane);
    const float r = 1.0f / sqrtf(ss / 64.0f + EPS);
    const float* wp = (kind == 1 ? kn : qn) + 8 * j; const f32x4 w0 = *(const f32x4*)wp, w1 = *(const f32x4*)(wp + 4);
    y[0] = x[0] * r * w0.x; y[1] = x[1] * r * w0.y; y[2] = x[2] * r * w0.z; y[3] = x[3] * r * w0.w;
    y[4] = x[4] * r * w1.x; y[5] = x[5] * r * w1.y; y[6] = x[6] * r * w1.z; y[7] = x[7] * r * w1.w;
    if (lat) {
      const int pos = (t - TCTX) % DEC_SEQ, a = j >> 2; const f32x4* tb = (const f32x4*)(rope + ((size_t)(pos * 2 + a) * 16 + 8 * (j & 1)) * 2);
      const bool x2side = (j & 2) != 0;
#pragma unroll
      for (int e2 = 0; e2 < 4; ++e2) { const f32x4 cs = tb[e2];
        const float p0 = shx(y[2 * e2], 2, w.lane), p1 = shx(y[2 * e2 + 1], 2, w.lane);
        y[2 * e2] = x2side ? y[2 * e2] * cs.x + p0 * cs.y : y[2 * e2] * cs.x - p0 * cs.y;
        y[2 * e2 + 1] = x2side ? y[2 * e2 + 1] * cs.z + p1 * cs.w : y[2 * e2 + 1] * cs.z - p1 * cs.w; }
    }
    if (kind != 2) *(u32x4*)p = pack8(y);
    if (!lat) {
      if (kind == 1) { float* o = kout + (size_t)t * (nk * 64) + (slot - nq) * 64 + 8 * j; *(f32x4*)o = (f32x4){y[0], y[1], y[2], y[3]}; *(f32x4*)(o + 4) = (f32x4){y[4], y[5], y[6], y[7]}; }
      if (kind == 2) { float* o = vout + (size_t)t * (nv * 64) + (slot - nq - nk) * 64 + 8 * j; *(f32x4*)o = (f32x4){x[0], x[1], x[2], x[3]}; *(f32x4*)(o + 4) = (f32x4){x[4], x[5], x[6], x[7]}; }
    }
  }
}

__device__ __forceinline__ void ph_convgate(const bf16_t* U, const float* cw, const float* cb, bf16_t* G) {
  constexpr int NCG = DFF / 8, RC = 8;
  const int tid0 = (opaque_block() * 512 + opaque_i((int)threadIdx.x)), nth = (int)(gridDim.x * blockDim.x);
  for (int i = tid0; i < (T / RC) * NCG; i += nth) {
    const int rc = i / NCG, cg = i - rc * NCG, r0 = rc * RC; int s0, L; tok_seq(r0, s0, L); const int pos0 = r0 - s0;
    const bool has_prev = pos0 > 0, has_next = pos0 + RC < L;
    u32x4 raw[2][RC + 2];
#pragma unroll
    for (int hf = 0; hf < 2; ++hf) {
      const bf16_t* base = U + (size_t)r0 * DFF2 + hf * DFF + 8 * cg;
      raw[hf][0] = *(const u32x4*)(has_prev ? base - DFF2 : base);
#pragma unroll
      for (int k = 0; k < RC; ++k) raw[hf][k + 1] = *(const u32x4*)(base + (size_t)k * DFF2);
      raw[hf][RC + 1] = *(const u32x4*)(has_next ? base + (size_t)RC * DFF2 : base);
    }
    float w0[2][8], w1[2][8], w2[2][8], bb[2][8];
#pragma unroll
    for (int hf = 0; hf < 2; ++hf) { const int col = hf * DFF + 8 * cg;
#pragma unroll
      for (int e = 0; e < 8; e += 4) { const f32x4 a0 = *(const f32x4*)(cw + col + e), a1 = *(const f32x4*)(cw + DFF2 + col + e), a2 = *(const f32x4*)(cw + 2 * DFF2 + col + e), a3 = *(const f32x4*)(cb + col + e);
#pragma unroll
        for (int q = 0; q < 4; ++q) { w0[hf][e + q] = a0[q]; w1[hf][e + q] = a1[q]; w2[hf][e + q] = a2[q]; bb[hf][e + q] = a3[q]; } } }
    if (!has_prev) { raw[0][0] = (u32x4){0u, 0u, 0u, 0u}; raw[1][0] = (u32x4){0u, 0u, 0u, 0u}; }
    if (!has_next) { raw[0][RC + 1] = (u32x4){0u, 0u, 0u, 0u}; raw[1][RC + 1] = (u32x4){0u, 0u, 0u, 0u}; }
    float up[2][8], uc[2][8], un[2][8];
    unpack8(raw[0][0], up[0]); unpack8(raw[1][0], up[1]); unpack8(raw[0][1], uc[0]); unpack8(raw[1][1], uc[1]);
#pragma unroll
    for (int r = 0; r < RC; ++r) {
      unpack8(raw[0][r + 2], un[0]); unpack8(raw[1][r + 2], un[1]);
      float y[8];
#pragma unroll
      for (int e = 0; e < 8; ++e) {
        const float a = uc[0][e] * w1[0][e] + bb[0][e] + up[0][e] * w0[0][e] + un[0][e] * w2[0][e];
        const float b = uc[1][e] * w1[1][e] + bb[1][e] + up[1][e] * w0[1][e] + un[1][e] * w2[1][e];
        y[e] = a / (1.0f + __expf(-a)) * b;
      }
      *(u32x4*)(G + (size_t)(r0 + r) * DFF + 8 * cg) = pack8(y);
#pragma unroll
      for (int hf = 0; hf < 2; ++hf)
#pragma unroll
        for (int e = 0; e < 8; ++e) { up[hf][e] = uc[hf][e]; uc[hf][e] = un[hf][e]; }
    }
  }
}


__device__ __forceinline__ void ph_conv_fixup(const float* edgebuf, const float* cw, const float* cb, bf16_t* G) {
  const int tid0 = (opaque_block() * 512 + opaque_i((int)threadIdx.x)), nth = (int)(gridDim.x * blockDim.x);
  for (int i = tid0; i < 6 * DFF; i += nth) {
    const int sm = i / DFF, f = i - sm * DFF, tu = (sm / 3) * 4 + (sm % 3), pn = f >> 7, cc = f & 127;
    const float* eu = edgebuf + ((size_t)(tu * (DFF / 128) + pn) * 4) * 256 + cc; const float* el = edgebuf + ((size_t)((tu + 1) * (DFF / 128) + pn) * 4) * 256 + cc;
    float o[2][2];
#pragma unroll
    for (int bj = 0; bj < 2; ++bj) { const int col = bj * DFF + f; const float w0 = cw[col], w1 = cw[DFF2 + col], w2 = cw[2 * DFF2 + col], bb = cb[col];
      const float u254 = eu[2 * 256 + bj * 128], u255 = eu[3 * 256 + bj * 128], l0 = el[0 * 256 + bj * 128], l1 = el[1 * 256 + bj * 128];
      o[0][bj] = u255 * w1 + bb + u254 * w0 + l0 * w2; o[1][bj] = l0 * w1 + bb + u255 * w0 + l1 * w2; }
    const int rowU = TCTX + (tu + 1) * 256 - 1;
    G[(size_t)rowU * DFF + f] = (bf16_t)(pk_bf16(o[0][0] / (1.0f + __expf(-o[0][0])) * o[0][1], 0.f) & 0xffffu);
    G[(size_t)(rowU + 1) * DFF + f] = (bf16_t)(pk_bf16(o[1][0] / (1.0f + __expf(-o[1][0])) * o[1][1], 0.f) & 0xffffu);
  }
}

__device__ __forceinline__ void conv_fixup_unit(const float* edgebuf, const float* cw, const float* cb, bf16_t* G, int pm, int f0, int nf) {
  if (pm * 256 < TCTX) return;
  const int tl = pm - TCTX / 256, tid = opaque_i((int)threadIdx.x);
  const bool up = (tl & 3) != 0, dn = (tl & 3) != 3;
  for (int i = tid; i < nf; i += 512) {
    const int f = f0 + i, pn = f >> 7, cc = f & 127;
    const float* eo = edgebuf + ((size_t)(tl * (DFF / 128) + pn) * 4) * 256 + cc;
    float ga[2], gb[2];
#pragma unroll
    for (int bj = 0; bj < 2; ++bj) { const int col = bj * DFF + f; const float w0 = cw[col], w1 = cw[DFF2 + col], w2 = cw[2 * DFF2 + col], bb = cb[col];
      const float o0 = eo[0 * 256 + bj * 128], o1 = eo[1 * 256 + bj * 128], o254 = eo[2 * 256 + bj * 128], o255 = eo[3 * 256 + bj * 128];
      float pu = 0.f, nd = 0.f;
      if (up) pu = (eo - (size_t)(DFF / 128) * 4 * 256)[3 * 256 + bj * 128];
      if (dn) nd = (eo + (size_t)(DFF / 128) * 4 * 256)[0 * 256 + bj * 128];
      const float c0 = o0 * w1 + bb + pu * w0 + o1 * w2, c255 = o255 * w1 + bb + o254 * w0 + nd * w2;
      if (bj == 0) { ga[0] = c0; ga[1] = c255; } else { gb[0] = c0; gb[1] = c255; } }
    if (up) G[(size_t)(pm * 256) * DFF + f] = (bf16_t)(pk_bf16(ga[0] / (1.0f + __expf(-ga[0])) * gb[0], 0.f) & 0xffffu);
    if (dn) G[(size_t)(pm * 256 + 255) * DFF + f] = (bf16_t)(pk_bf16(ga[1] / (1.0f + __expf(-ga[1])) * gb[1], 0.f) & 0xffffu);
  }
}

__device__ __forceinline__ void win_subunit(const bf16_t* Hb, const bf16_t* WinT, const float* cw, const float* cb, bf16_t* G, float* edgebuf, LAS unsigned char* lds, int pm, int pn, int j) {
  typedef short bf16x8 __attribute__((ext_vector_type(8)));
  const int tid = opaque_i((int)threadIdx.x), lane = tid & 63, wave = tid >> 6, c = lane & 15, g = lane >> 4;
  const bf16_t* a0p = Hb + (size_t)(pm * 256 + 32 * wave + c) * D + 8 * g; const bf16_t* a1p = a0p + (size_t)16 * D;
  const bf16_t* bp = WinT + (size_t)(pn * 256 + (c < 8 ? 8 * j + c : 128 + 8 * j + (c - 8))) * D + 8 * g;
  f32x4 acc0 = (f32x4){0.f, 0.f, 0.f, 0.f}, acc1 = acc0;
#pragma unroll 8
  for (int ks = 0; ks < D / 32; ++ks) {
    const bf16x8 a0 = *(const bf16x8*)(a0p + 32 * ks), a1 = *(const bf16x8*)(a1p + 32 * ks), b = *(const bf16x8*)(bp + 32 * ks);
    acc0 = __builtin_amdgcn_mfma_f32_16x16x32_bf16(a0, b, acc0, 0, 0, 0); acc1 = __builtin_amdgcn_mfma_f32_16x16x32_bf16(a1, b, acc1, 0, 0, 0);
  }
  LAS float* U = (LAS float*)lds;
#pragma unroll
  for (int r = 0; r < 4; ++r) { U[(32 * wave + 4 * g + r) * 16 + c] = bf_lo(pk_bf16(acc0[r], 0.f)); U[(32 * wave + 16 + 4 * g + r) * 16 + c] = bf_lo(pk_bf16(acc1[r], 0.f)); }
  __syncthreads();
  const int row = tid >> 1, q4 = (tid & 1) * 4, gcol = pn * 128 + 8 * j + q4;
  float y[4], ua[4], ub[4];
#pragma unroll
  for (int e = 0; e < 4; ++e) {
    float cv[2];
#pragma unroll
    for (int bj = 0; bj < 2; ++bj) { const int col = bj * DFF + gcol + e, lc = bj * 8 + q4 + e;
      const float uc = U[row * 16 + lc], up = row > 0 ? U[(row - 1) * 16 + lc] : 0.f, un = row < 255 ? U[(row + 1) * 16 + lc] : 0.f;
      cv[bj] = uc * cw[DFF2 + col] + cb[col] + up * cw[col] + un * cw[2 * DFF2 + col]; if (bj == 0) ua[e] = uc; else ub[e] = uc; }
    y[e] = cv[0] / (1.0f + __expf(-cv[0])) * cv[1];
  }
  u32x2 o; o.x = pk_bf16(y[0], y[1]); o.y = pk_bf16(y[2], y[3]);
  *(u32x2*)(G + (size_t)(pm * 256 + row) * DFF + gcol) = o;
  if (pm * 256 >= TCTX && (row < 2 || row >= 254)) {
    float* eb = edgebuf + ((size_t)((pm - TCTX / 256) * (DFF / 128) + pn) * 4 + (row < 2 ? row : row - 252)) * 256 + 8 * j + q4;
    *(f32x4*)eb = (f32x4){ua[0], ua[1], ua[2], ua[3]}; *(f32x4*)(eb + 128) = (f32x4){ub[0], ub[1], ub[2], ub[3]};
  }
  __syncthreads();
}

__device__ __forceinline__ void transpose_item(const float* W, int K, int N, bf16_t* WT, LAS float* scr, int item, int lane, bool pair_ab = false) {
  const int nblk = N / 32, kb = item / nblk, nb = item % nblk, k0 = 64 * kb, n0 = 32 * nb;
  int r0 = n0; if (pair_ab) { const int half = n0 >= DFF ? 1 : 0, np = n0 - half * DFF; r0 = 256 * (np / 128) + 128 * half + np % 128; }
  { const int r8 = lane >> 3, c4 = lane & 7; f32x4 v[8];
#pragma unroll
    for (int i = 0; i < 8; ++i) v[i] = *(const f32x4*)(W + (size_t)(k0 + 8 * i + r8) * N + n0 + 4 * c4);
#pragma unroll
    for (int i = 0; i < 8; ++i) { LAS float* d = scr + (8 * i + r8) * 33 + 4 * c4; d[0] = v[i].x; d[1] = v[i].y; d[2] = v[i].z; d[3] = v[i].w; } }
  asm volatile("s_waitcnt lgkmcnt(0)" ::: "memory");
  const int c = lane & 7;
#pragma unroll
  for (int j = 0; j < 4; ++j) { const int n = (lane >> 3) + 8 * j; const LAS float* sp = scr + (8 * c) * 33 + n;
    u32x4 o; o.x = pk_bf16(sp[0 * 33], sp[1 * 33]); o.y = pk_bf16(sp[2 * 33], sp[3 * 33]); o.z = pk_bf16(sp[4 * 33], sp[5 * 33]); o.w = pk_bf16(sp[6 * 33], sp[7 * 33]);
    *(u32x4*)(WT + (size_t)(r0 + n) * K + k0 + 8 * c) = o; }
  asm volatile("s_waitcnt lgkmcnt(0)" ::: "memory");
}


constexpr int CI_IN = (D / 64) * (DFF2 / 32), CI_OUT = (DFF / 64) * (D / 32), CI_Q15 = (D / 64) * (1536 / 32), CI_Q30 = (D / 64) * (3072 / 32), CI_O = (D / 64) * (D / 32), CI_P = (256 / 64) * (256 / 32);
__device__ __forceinline__ constexpr int layer_items(int l) { return CI_IN + CI_OUT + (l == 0 ? 4 * CI_P : ((l == 2 ? CI_Q30 : CI_Q15) + CI_O)); }
__device__ __forceinline__ constexpr int bg_total_items() { return layer_items(1) + layer_items(2) + layer_items(3); }
__device__ __forceinline__ constexpr int bg_end_of_layer(int l) { return l <= 0 ? 0 : (l == 1 ? layer_items(1) : (l == 2 ? layer_items(1) + layer_items(2) : bg_total_items())); }
__device__ __forceinline__ void convert_item(const Params& P, const Ctx& c, LAS float* scr, int l, int r, int lane) {
  if (r < CI_IN) { transpose_item(pin(P, I_FWIN) + (size_t)l * D * DFF2, D, DFF2, c.WinT() + (size_t)l * DFF2 * D, scr, r, lane, FUSE_CONV != 0); return; } r -= CI_IN;
  if (r < CI_OUT) { transpose_item(pin(P, I_FWOUT) + (size_t)l * DFF * D, DFF, D, c.WoutT() + (size_t)l * D * DFF, scr, r, lane); return; } r -= CI_OUT;
  if (l == 0) { const int g = r / CI_P; transpose_item(pin(P, I_POOLW) + g * 256 * 256, 256, 256, c.PoolT() + g * 256 * 256, scr, r % CI_P, lane); return; }
  const int nq = l == 2 ? CI_Q30 : CI_Q15;
  if (r < nq) { transpose_item(pin(P, l == 1 ? I_GQKV : (l == 2 ? I_DQKV : I_WQKV)), D, l == 2 ? 3072 : 1536, c.bf(l == 1 ? WS_GQKV : (l == 2 ? WS_DQKV : WS_WQKV)), scr, r, lane); return; } r -= nq;
  transpose_item(pin(P, l == 1 ? I_GWO : (l == 2 ? I_DWO : I_WWO)), D, D, c.bf(l == 1 ? WS_GWO : (l == 2 ? WS_DWO : WS_WWO)), scr, r, lane);
}
__device__ __forceinline__ void bg_item(const Params& P, const Ctx& c, LAS float* scr, int q, int lane) {
  const int l = q < bg_end_of_layer(1) ? 1 : (q < bg_end_of_layer(2) ? 2 : 3);
  convert_item(P, c, scr, l, q - bg_end_of_layer(l - 1), lane);
}
__device__ __forceinline__ void bg_work(const Params& P, const Ctx& c, LAS unsigned char* lds, unsigned budget_ticks, int upto) {
  if (!BG_QUEUE) return;
  const WaveId w = wave_id(); LAS float* scr = (LAS float*)(lds + w.wave * 16384);
  unsigned* ctr = (unsigned*)(c.ws_p() + WS_CTL) + 3520;
  const unsigned long long t0 = __builtin_amdgcn_s_memrealtime();
  for (;;) {
    if (budget_ticks != 0xffffffffu && (unsigned)(__builtin_amdgcn_s_memrealtime() - t0) > budget_ticks) break;
    unsigned q = 0xffffffffu;
    if (w.lane == 0 && (int)__hip_atomic_load(ctr, __ATOMIC_RELAXED, __HIP_MEMORY_SCOPE_AGENT) < upto) q = __hip_atomic_fetch_add(ctr, 1u, __ATOMIC_RELAXED, __HIP_MEMORY_SCOPE_AGENT);
    q = (unsigned)__builtin_amdgcn_readfirstlane((int)q);
    if (q >= (unsigned)bg_total_items()) break;
    bg_item(P, c, scr, (int)q, w.lane);
  }
}

__device__ __forceinline__ void ph_prologue(const Params& P, const Ctx& c, LAS unsigned char* lds) {
  const WaveId w = wave_id(); const int tid = opaque_i((int)threadIdx.x);
  {
    LAS float* S = (LAS float*)lds;
    LAS float* red = (LAS float*)(lds + 12288);
    for (int i = tid; i < 3 * D; i += 512) { const int cd = i / D, k = i - cd * D; const float v = cd == 0 ? pin(P, I_CCTX)[k] : pin(P, I_C)[(cd - 1) * D + k]; S[i] = v / (1.0f + expf(-v)); }
    __syncthreads();
    for (int item = opaque_block(); item < 4 * 48; item += (int)gridDim.x) {
      const int l = item / 48, n0 = (item % 48) * 128, h = w.lane >> 5, n4 = w.lane & 31;
      const float* W = pin(P, I_WMOD) + (size_t)l * D * MODW + n0 + 4 * n4;
      f32x4 acc[3] = {{0.f, 0.f, 0.f, 0.f}, {0.f, 0.f, 0.f, 0.f}, {0.f, 0.f, 0.f, 0.f}};
#pragma unroll 8
      for (int i = 0; i < 64; ++i) { const int k = 128 * w.wave + 2 * i + h; const f32x4 wv = *(const f32x4*)(W + (size_t)k * MODW);
        acc[0] += S[k] * wv; acc[1] += S[D + k] * wv; acc[2] += S[2 * D + k] * wv; }
#pragma unroll
      for (int cd = 0; cd < 3; ++cd) { acc[cd].x += shx(acc[cd].x, 32, w.lane); acc[cd].y += shx(acc[cd].y, 32, w.lane); acc[cd].z += shx(acc[cd].z, 32, w.lane); acc[cd].w += shx(acc[cd].w, 32, w.lane); }
      if (h == 0) {
#pragma unroll
        for (int cd = 0; cd < 3; ++cd) *(LAS f32x4*)(red + (w.wave * 3 + cd) * 128 + 4 * n4) = acc[cd]; }
      __syncthreads();
      if (tid < 384) { const int cd = tid >> 7, nn = tid & 127; float sum = pin(P, I_BMOD)[(size_t)l * MODW + n0 + nn];
#pragma unroll
        for (int ww = 0; ww < 8; ++ww) sum += red[(ww * 3 + cd) * 128 + nn];
        c.MOD()[((size_t)l * NCOND + cd) * MODW + n0 + nn] = sum; }
      __syncthreads();
    }
  }
  for (int i = opaque_block() * 512 + tid; i < DEC_SEQ * 32; i += (int)gridDim.x * 512) {
    const int pos = i / 32, a = (i / 16) % 2, f = i % 16;
    const float inv = powf(10000.0f, -(float)(2 * f) / 32.0f), ang = (a == 0 ? (float)(pos / 64) : (float)(pos % 64)) * inv;
    c.ROPE()[2 * i] = cosf(ang); c.ROPE()[2 * i + 1] = sinf(ang);
  }
  __syncthreads();
  {
    LAS float* scr = (LAS float*)(lds + w.wave * 16384);
    const int nitems = BG_QUEUE ? layer_items(0) : layer_items(0) + bg_total_items();
    for (int it = w.gw; it < nitems; it += w.ngw) {
      if (it < layer_items(0)) convert_item(P, c, scr, 0, it, w.lane); else bg_item(P, c, scr, it - layer_items(0), w.lane);
    }
  }
  __syncthreads();
}
#endif


#ifndef HOST_EMU
namespace att {
typedef short bf16x8 __attribute__((ext_vector_type(8)));
typedef short s16x4 __attribute__((ext_vector_type(4)));
constexpr float SC = 0.125f * 1.4426950408889634f, LOG2E = 1.4426950408889634f, NEGBIG = -1.0e30f, REF2 = 16.0f;
constexpr int OFF_K = 0, OFF_V = 32768, OFF_COMB = 73728;
struct Args {
  const bf16_t* QKV; int ld, kcol0, vcol0; const float* ck; const float* cv; int cld; const float* sink;
  const float* lq1; const float* lk1; const float* lq2; const float* lk2; float lam_init; const float* sub_g; bf16_t* O;
  const float* qn; const float* kn; const float* rope; float* kout; float* vout;
};
__device__ __forceinline__ s16x4 tr_read(const LAS unsigned char* p) { return __builtin_bit_cast(s16x4, __builtin_amdgcn_ds_read_tr16_b64_v4i16((LAS s16x4*)p)); }

template <int MODE>
__device__ __forceinline__ void unit(const Args& A, bool lat, int b, int hh, int chunk, float lam, LAS unsigned char* lds) {
  constexpr int KW = MODE == 2 ? 128 : 64, NDB = KW / 16, KROWB = KW * 2, VROWB = KW * 2 + 32, RPU = MODE == 2 ? 64 : 32, CPR = KW / 8, NCH = CPR / 8;
  constexpr int KBUF = 16384, VBUF = 20480;
  const int tid = opaque_i((int)threadIdx.x), lane = tid & 63, wave = __builtin_amdgcn_readfirstlane(tid >> 6), c = lane & 15, g = lane >> 4;
  const int s0 = lat ? TCTX + b * DEC_SEQ : b * SEQ, L = lat ? DEC_SEQ : SEQ, p0 = chunk * RPU;
  const int qpos = p0 + (MODE == 2 ? (wave & 3) * 16 : (wave & 1) * 16) + c;
  const int map = MODE == 2 ? (wave >> 2) : 0;
  const int hcol = MODE == 2 ? hh * 128 + map * 64 : (hh * 4 + (wave >> 1)) * 64;
  const int kcol = A.kcol0 + hh * KW, vcol = A.vcol0 + hh * KW, ccol = hh * KW;
  const int ncache = lat ? PAST / 64 : 0;
  int tlo = 0, thi = L / 64 - 1;
  if (MODE == 1 && lat) { const int lo = p0 - 128 < 0 ? 0 : p0 - 128, hi = p0 + RPU - 1 + 128 > L - 1 ? L - 1 : p0 + RPU - 1 + 128; tlo = lo / 64; thi = hi / 64; }
  const int NT = ncache + (thi - tlo + 1);
  bf16x8 qf[2];
  { const bf16_t* qp = A.QKV + (size_t)(s0 + qpos) * A.ld + hcol + 8 * g; qf[0] = *(const bf16x8*)qp; qf[1] = *(const bf16x8*)(qp + 32); }
  if (FUSE_QKPOST) {
    float x[2][8]; unpack8(__builtin_bit_cast(u32x4, qf[0]), x[0]); unpack8(__builtin_bit_cast(u32x4, qf[1]), x[1]);
    float ss = 0.f;
#pragma unroll
    for (int ks = 0; ks < 2; ++ks)
#pragma unroll
      for (int e = 0; e < 8; ++e) ss += x[ks][e] * x[ks][e];
    ss += shx(ss, 16, lane); ss += shx(ss, 32, lane);
    const float r = 1.0f / sqrtf(ss / 64.0f + EPS);
#pragma unroll
    for (int ks = 0; ks < 2; ++ks) { const f32x4 w0 = *(const f32x4*)(A.qn + 32 * ks + 8 * g), w1 = *(const f32x4*)(A.qn + 32 * ks + 8 * g + 4);
      x[ks][0] *= r * w0.x; x[ks][1] *= r * w0.y; x[ks][2] *= r * w0.z; x[ks][3] *= r * w0.w; x[ks][4] *= r * w1.x; x[ks][5] *= r * w1.y; x[ks][6] *= r * w1.z; x[ks][7] *= r * w1.w; }
    if (lat) { const bool x2side = (g & 2) != 0;
#pragma unroll
      for (int ks = 0; ks < 2; ++ks) { const f32x4* tb = (const f32x4*)(A.rope + ((size_t)(qpos * 2 + ks) * 16 + 8 * (g & 1)) * 2);
#pragma unroll
        for (int e2 = 0; e2 < 4; ++e2) { const f32x4 cs = tb[e2]; const float p0 = shx(x[ks][2 * e2], 32, lane), p1 = shx(x[ks][2 * e2 + 1], 32, lane);
          x[ks][2 * e2] = x2side ? x[ks][2 * e2] * cs.x + p0 * cs.y : x[ks][2 * e2] * cs.x - p0 * cs.y;
          x[ks][2 * e2 + 1] = x2side ? x[ks][2 * e2 + 1] * cs.z + p1 * cs.w : x[ks][2 * e2 + 1] * cs.z - p1 * cs.w; } } }
    qf[0] = __builtin_bit_cast(bf16x8, pack8(x[0])); qf[1] = __builtin_bit_cast(bf16x8, pack8(x[1]));
  }
  f32x4 o[NDB];
#pragma unroll
  for (int db = 0; db < NDB; ++db) o[db] = (f32x4){0.f, 0.f, 0.f, 0.f};
  float m = NEGBIG, lsum = 0.f;
  f32x4 rkA[NCH][2], rvA[NCH][2], rkB[NCH][2], rvB[NCH][2];
  auto load_tileA = [&](int t) {
    if (t < ncache) {
#pragma unroll
      for (int i = 0; i < NCH; ++i) { const int id = tid + 512 * i, row = id / CPR, ch = id % CPR; const size_t off = (size_t)(b * PAST + t * 64 + row) * A.cld + ccol + ch * 8;
        rkA[i][0] = *(const f32x4*)(A.ck + off); rkA[i][1] = *(const f32x4*)(A.ck + off + 4); rvA[i][0] = *(const f32x4*)(A.cv + off); rvA[i][1] = *(const f32x4*)(A.cv + off + 4); }
    } else {
      const int r0 = s0 + (tlo + t - ncache) * 64;
#pragma unroll
      for (int i = 0; i < NCH; ++i) { const int id = tid + 512 * i, row = id / CPR, ch = id % CPR; const bf16_t* rp = A.QKV + (size_t)(r0 + row) * A.ld + ch * 8;
        rkA[i][0] = *(const f32x4*)(rp + kcol); rvA[i][0] = *(const f32x4*)(rp + vcol); }
    }
  };
  auto write_tileA = [&](int t, int buf) {
    LAS unsigned char* Kb = lds + OFF_K + buf * KBUF; LAS unsigned char* Vb = lds + OFF_V + buf * VBUF;
#pragma unroll
    for (int i = 0; i < NCH; ++i) { const int id = tid + 512 * i, row = id / CPR, ch = id % CPR;
      const int pch = KW == 64 ? (ch ^ ((row >> 1) & 7)) : (ch ^ (row & 15));
      u32x4 kq, vq;
      if (t < ncache) {
        kq.x = pk_bf16(rkA[i][0].x, rkA[i][0].y); kq.y = pk_bf16(rkA[i][0].z, rkA[i][0].w); kq.z = pk_bf16(rkA[i][1].x, rkA[i][1].y); kq.w = pk_bf16(rkA[i][1].z, rkA[i][1].w);
        vq.x = pk_bf16(rvA[i][0].x, rvA[i][0].y); vq.y = pk_bf16(rvA[i][0].z, rvA[i][0].w); vq.z = pk_bf16(rvA[i][1].x, rvA[i][1].y); vq.w = pk_bf16(rvA[i][1].z, rvA[i][1].w);
      } else { kq = __builtin_bit_cast(u32x4, rkA[i][0]); vq = __builtin_bit_cast(u32x4, rvA[i][0]);
        if (FUSE_QKPOST) {
          const int j = ch & 7, kpos = (tlo + t - ncache) * 64 + row;
          float x[8]; unpack8(kq, x); float ss = 0.f;
#pragma unroll
          for (int e = 0; e < 8; ++e) ss += x[e] * x[e];
          ss += shx(ss, 1, lane); ss += shx(ss, 2, lane); ss += shx(ss, 4, lane);
          const float r = 1.0f / sqrtf(ss / 64.0f + EPS);
          const f32x4 w0 = *(const f32x4*)(A.kn + 8 * j), w1 = *(const f32x4*)(A.kn + 8 * j + 4);
          x[0] *= r * w0.x; x[1] *= r * w0.y; x[2] *= r * w0.z; x[3] *= r * w0.w; x[4] *= r * w1.x; x[5] *= r * w1.y; x[6] *= r * w1.z; x[7] *= r * w1.w;
          if (lat) { const int a = j >> 2; const f32x4* tb = (const f32x4*)(A.rope + ((size_t)(kpos * 2 + a) * 16 + 8 * (j & 1)) * 2); const bool x2side = (j & 2) != 0;
#pragma unroll
            for (int e2 = 0; e2 < 4; ++e2) { const f32x4 cs = tb[e2]; const float p0 = shx(x[2 * e2], 2, lane), p1 = shx(x[2 * e2 + 1], 2, lane);
              x[2 * e2] = x2side ? x[2 * e2] * cs.x + p0 * cs.y : x[2 * e2] * cs.x - p0 * cs.y;
              x[2 * e2 + 1] = x2side ? x[2 * e2 + 1] * cs.z + p1 * cs.w : x[2 * e2 + 1] * cs.z - p1 * cs.w; } }
          kq = pack8(x);
          if (!lat && kpos >= p0 && kpos < p0 + RPU) {
            constexpr int KOW = MODE == 2 ? 1024 : 256; const size_t oo = (size_t)(s0 + kpos) * KOW + hh * KW + ch * 8;
            *(f32x4*)(A.kout + oo) = (f32x4){x[0], x[1], x[2], x[3]}; *(f32x4*)(A.kout + oo + 4) = (f32x4){x[4], x[5], x[6], x[7]};
            float v[8]; unpack8(vq, v); *(f32x4*)(A.vout + oo) = (f32x4){v[0], v[1], v[2], v[3]}; *(f32x4*)(A.vout + oo + 4) = (f32x4){v[4], v[5], v[6], v[7]}; }
        } }
      *(LAS u32x4*)(Kb + row * KROWB + pch * 16) = kq; *(LAS u32x4*)(Vb + row * VROWB + ch * 16) = vq; }
  };
  auto load_tileB = [&](int t) {
    if (t < ncache) {
#pragma unroll
      for (int i = 0; i < NCH; ++i) { const int id = tid + 512 * i, row = id / CPR, ch = id % CPR; const size_t off = (size_t)(b * PAST + t * 64 + row) * A.cld + ccol + ch * 8;
        rkB[i][0] = *(const f32x4*)(A.ck + off); rkB[i][1] = *(const f32x4*)(A.ck + off + 4); rvB[i][0] = *(const f32x4*)(A.cv + off); rvB[i][1] = *(const f32x4*)(A.cv + off + 4); }
    } else {
      const int r0 = s0 + (tlo + t - ncache) * 64;
#pragma unroll
      for (int i = 0; i < NCH; ++i) { const int id = tid + 512 * i, row = id / CPR, ch = id % CPR; const bf16_t* rp = A.QKV + (size_t)(r0 + row) * A.ld + ch * 8;
        rkB[i][0] = *(const f32x4*)(rp + kcol); rvB[i][0] = *(const f32x4*)(rp + vcol); }
    }
  };
  auto write_tileB = [&](int t, int buf) {
    LAS unsigned char* Kb = lds + OFF_K + buf * KBUF; LAS unsigned char* Vb = lds + OFF_V + buf * VBUF;
#pragma unroll
    for (int i = 0; i < NCH; ++i) { const int id = tid + 512 * i, row = id / CPR, ch = id % CPR;
      const int pch = KW == 64 ? (ch ^ ((row >> 1) & 7)) : (ch ^ (row & 15));
      u32x4 kq, vq;
      if (t < ncache) {
        kq.x = pk_bf16(rkB[i][0].x, rkB[i][0].y); kq.y = pk_bf16(rkB[i][0].z, rkB[i][0].w); kq.z = pk_bf16(rkB[i][1].x, rkB[i][1].y); kq.w = pk_bf16(rkB[i][1].z, rkB[i][1].w);
        vq.x = pk_bf16(rvB[i][0].x, rvB[i][0].y); vq.y = pk_bf16(rvB[i][0].z, rvB[i][0].w); vq.z = pk_bf16(rvB[i][1].x, rvB[i][1].y); vq.w = pk_bf16(rvB[i][1].z, rvB[i][1].w);
      } else { kq = __builtin_bit_cast(u32x4, rkB[i][0]); vq = __builtin_bit_cast(u32x4, rvB[i][0]);
        if (FUSE_QKPOST) {
          const int j = ch & 7, kpos = (tlo + t - ncache) * 64 + row;
          float x[8]; unpack8(kq, x); float ss = 0.f;
#pragma unroll
          for (int e = 0; e < 8; ++e) ss += x[e] * x[e];
          ss += shx(ss, 1, lane); ss += shx(ss, 2, lane); ss += shx(ss, 4, lane);
          const float r = 1.0f / sqrtf(ss / 64.0f + EPS);
          const f32x4 w0 = *(const f32x4*)(A.kn + 8 * j), w1 = *(const f32x4*)(A.kn + 8 * j + 4);
          x[0] *= r * w0.x; x[1] *= r * w0.y; x[2] *= r * w0.z; x[3] *= r * w0.w; x[4] *= r * w1.x; x[5] *= r * w1.y; x[6] *= r * w1.z; x[7] *= r * w1.w;
          if (lat) { const int a = j >> 2; const f32x4* tb = (const f32x4*)(A.rope + ((size_t)(kpos * 2 + a) * 16 + 8 * (j & 1)) * 2); const bool x2side = (j & 2) != 0;
#pragma unroll
            for (int e2 = 0; e2 < 4; ++e2) { const f32x4 cs = tb[e2]; const float p0 = shx(x[2 * e2], 2, lane), p1 = shx(x[2 * e2 + 1], 2, lane);
              x[2 * e2] = x2side ? x[2 * e2] * cs.x + p0 * cs.y : x[2 * e2] * cs.x - p0 * cs.y;
              x[2 * e2 + 1] = x2side ? x[2 * e2 + 1] * cs.z + p1 * cs.w : x[2 * e2 + 1] * cs.z - p1 * cs.w; } }
          kq = pack8(x);
          if (!lat && kpos >= p0 && kpos < p0 + RPU) {
            constexpr int KOW = MODE == 2 ? 1024 : 256; const size_t oo = (size_t)(s0 + kpos) * KOW + hh * KW + ch * 8;
            *(f32x4*)(A.kout + oo) = (f32x4){x[0], x[1], x[2], x[3]}; *(f32x4*)(A.kout + oo + 4) = (f32x4){x[4], x[5], x[6], x[7]};
            float v[8]; unpack8(vq, v); *(f32x4*)(A.vout + oo) = (f32x4){v[0], v[1], v[2], v[3]}; *(f32x4*)(A.vout + oo + 4) = (f32x4){v[4], v[5], v[6], v[7]}; }
        } }
      *(LAS u32x4*)(Kb + row * KROWB + pch * 16) = kq; *(LAS u32x4*)(Vb + row * VROWB + ch * 16) = vq; }
  };
#define ATT_BAR() do { asm volatile("s_waitcnt lgkmcnt(0)" ::: "memory"); __builtin_amdgcn_s_barrier(); asm volatile("" ::: "memory"); } while (0)
  auto compute = [&](int t, int cur) {
    const LAS unsigned char* Kb = lds + OFF_K + cur * KBUF; const LAS unsigned char* Vb = lds + OFF_V + cur * VBUF;
    f32x4 s[4];
#pragma unroll
    for (int kb = 0; kb < 4; ++kb) { s[kb] = (f32x4){0.f, 0.f, 0.f, 0.f};
#pragma unroll
      for (int ks = 0; ks < 2; ++ks) { const int row = 16 * kb + c, ch = map * 8 + 4 * ks + g, pch = KW == 64 ? (ch ^ ((row >> 1) & 7)) : (ch ^ (row & 15));
        const bf16x8 kf = *(const LAS bf16x8*)(Kb + row * KROWB + pch * 16);
        s[kb] = __builtin_amdgcn_mfma_f32_16x16x32_bf16(kf, qf[ks], s[kb], 0, 0, 0); } }
    const bool band = (MODE == 1) && lat && (t >= ncache); const int tb = (tlo + t - ncache) * 64;
    float ps = 0.f;
    if (ATT_FIXED_REF) {
#pragma unroll
      for (int kb = 0; kb < 4; ++kb)
#pragma unroll
        for (int r = 0; r < 4; ++r) { float p = __builtin_amdgcn_exp2f(s[kb][r] * SC - REF2);
          if (band) { const int dlt = qpos - (tb + 16 * kb + 4 * g + r); if (dlt > 128 || dlt < -128) p = 0.f; }
          s[kb][r] = p; ps += p; }
      lsum += ps;
    } else {
    float mx = NEGBIG;
#pragma unroll
    for (int kb = 0; kb < 4; ++kb)
#pragma unroll
      for (int r = 0; r < 4; ++r) { float v = s[kb][r] * SC;
        if (band) { const int dlt = qpos - (tb + 16 * kb + 4 * g + r); if (dlt > 128 || dlt < -128) v = NEGBIG; }
        s[kb][r] = v; mx = fmaxf(mx, v); }
    mx = fmaxf(mx, shx(mx, 16, lane)); mx = fmaxf(mx, shx(mx, 32, lane));
    const float mn = fmaxf(m, mx), alpha = __builtin_amdgcn_exp2f(m - mn); m = mn;
#pragma unroll
    for (int kb = 0; kb < 4; ++kb)
#pragma unroll
      for (int r = 0; r < 4; ++r) { const float p = __builtin_amdgcn_exp2f(s[kb][r] - mn); s[kb][r] = p; ps += p; }
    lsum = lsum * alpha + ps;
#pragma unroll
    for (int db = 0; db < NDB; ++db) o[db] = o[db] * alpha;
    }
    bf16x8 pf[2];
#pragma unroll
    for (int ks = 0; ks < 2; ++ks) { u32x4 pk; pk.x = pk_bf16(s[2 * ks][0], s[2 * ks][1]); pk.y = pk_bf16(s[2 * ks][2], s[2 * ks][3]); pk.z = pk_bf16(s[2 * ks + 1][0], s[2 * ks + 1][1]); pk.w = pk_bf16(s[2 * ks + 1][2], s[2 * ks + 1][3]);
      pf[ks] = __builtin_bit_cast(bf16x8, pk); }
#pragma unroll
    for (int db = 0; db < NDB; ++db)
#pragma unroll
      for (int ks = 0; ks < 2; ++ks) { const LAS unsigned char* vp = Vb + (32 * ks + 4 * g + (c >> 2)) * VROWB + 32 * db + 8 * (c & 3);
        const s16x4 lo = tr_read(vp), hi = tr_read(vp + 16 * VROWB);
        const bf16x8 vt = (bf16x8){lo[0], lo[1], lo[2], lo[3], hi[0], hi[1], hi[2], hi[3]};
        o[db] = __builtin_amdgcn_mfma_f32_16x16x32_bf16(vt, pf[ks], o[db], 0, 0, 0); }
  };
  load_tileA(0); if (NT > 1) load_tileB(1);
  write_tileA(0, 0); ATT_BAR();
  for (int t = 0; t < NT; t += 2) {
    if (t + 2 < NT) load_tileA(t + 2);
    compute(t, 0);
    if (t + 1 < NT) write_tileB(t + 1, 1);
    ATT_BAR();
    if (t + 1 >= NT) break;
    if (t + 3 < NT) load_tileB(t + 3);
    compute(t + 1, 1);
    if (t + 2 < NT) write_tileA(t + 2, 0);
    ATT_BAR();
  }
  lsum += shx(lsum, 16, lane); lsum += shx(lsum, 32, lane);
  if (MODE == 1) lsum += __builtin_amdgcn_exp2f(A.sink[hh * 4 + (wave >> 1)] * LOG2E - (ATT_FIXED_REF ? REF2 : m));
  const float rl = 1.0f / lsum;
  if (MODE != 2) {
    bf16_t* op = A.O + (size_t)(s0 + qpos) * D + hcol + 4 * g;
#pragma unroll
    for (int db = 0; db < NDB; ++db) { u32x2 pk; pk.x = pk_bf16(o[db][0] * rl, o[db][1] * rl); pk.y = pk_bf16(o[db][2] * rl, o[db][3] * rl); *(u32x2*)(op + 16 * db) = pk; }
  } else {
    LAS float* comb = (LAS float*)(lds + OFF_COMB);
    const int row = (wave & 3) * 16 + c;
    if (map == 1) {
#pragma unroll
      for (int db = 0; db < NDB; ++db) *(LAS f32x4*)(comb + row * 132 + 16 * db + 4 * g) = o[db] * rl;
    }
    __syncthreads();
    if (map == 0) {
      float ss = 0.f;
#pragma unroll
      for (int db = 0; db < NDB; ++db) { const f32x4 o2 = *(const LAS f32x4*)(comb + row * 132 + 16 * db + 4 * g); o[db] = o[db] * rl - lam * o2;
        ss += (o[db][0] * o[db][0] + o[db][1] * o[db][1]) + (o[db][2] * o[db][2] + o[db][3] * o[db][3]); }
      ss += shx(ss, 16, lane); ss += shx(ss, 32, lane);
      const float rs = (1.0f - A.lam_init) / sqrtf(ss / 128.0f + EPS);
      bf16_t* op = A.O + (size_t)(s0 + qpos) * D + hh * 128 + 4 * g;
#pragma unroll
      for (int db = 0; db < NDB; ++db) { const f32x4 sg = *(const f32x4*)(A.sub_g + 16 * db + 4 * g); u32x2 pk; pk.x = pk_bf16(o[db][0] * rs * sg.x, o[db][1] * rs * sg.y); pk.y = pk_bf16(o[db][2] * rs * sg.z, o[db][3] * rs * sg.w);
        *(u32x2*)(op + 16 * db) = pk; }
    }
    __syncthreads();
  }
}

template <int MODE>
__device__ __forceinline__ void phase(const Args& A, LAS unsigned char* lds) {
  constexpr int NH = MODE == 2 ? 8 : 4, RPU = MODE == 2 ? 64 : 32, CPS_L = DEC_SEQ / RPU, CPS_C = SEQ / RPU, NLAT = DEC_BATCH * NH * CPS_L, NCTX = BATCH * NH * CPS_C;
  float lam = 0.f;
  if (MODE == 2) { const int lane = opaque_i((int)threadIdx.x) & 63; const float d1 = wave_sum(A.lq1[lane] * A.lk1[lane], lane), d2 = wave_sum(A.lq2[lane] * A.lk2[lane], lane); lam = expf(d1) - expf(d2) + A.lam_init; }
  for (int u = opaque_block(); u < NLAT; u += (int)gridDim.x) unit<MODE>(A, true, u / (NH * CPS_L), (u / CPS_L) % NH, u % CPS_L, lam, lds);
  for (int u = opaque_block(); u < NCTX; u += (int)gridDim.x) unit<MODE>(A, false, u / (NH * CPS_C), (u / CPS_C) % NH, u % CPS_C, lam, lds);
}
}
#endif


#ifndef HOST_EMU
#define XB_TMO      128
#define XB_XCNT(j)  (256  + 64 * (j))
#define XB_XSUB(j)  (1280 + 64 * (j))
#define XB_XGEN(j)  (2304 + 64 * (j))
#define XB_TOP      3328
#define XB_TOPGEN   3392
#define XCD_BAR_WORDS 3456
#define XB_SPIN_CAP (1u << 18)

__device__ __forceinline__ unsigned xb_ld(unsigned* p)              { return __hip_atomic_load(p, __ATOMIC_RELAXED, __HIP_MEMORY_SCOPE_AGENT); }
__device__ __forceinline__ unsigned xb_add(unsigned* p, unsigned v) { return __hip_atomic_fetch_add(p, v, __ATOMIC_RELAXED, __HIP_MEMORY_SCOPE_AGENT); }
__device__ __forceinline__ unsigned xb_xcc_id() { return (unsigned)__builtin_amdgcn_s_getreg((3 << 11) | 20) & 0xFu; }
#define XB_SPIN(cond, bar) do { unsigned _sp = 0; while (cond) { __builtin_amdgcn_s_sleep(1); \
    if ((++_sp & 255u) == 0u) { if (xb_ld(&(bar)[XB_TMO])) break; if (_sp > XB_SPIN_CAP) { atomicAdd(&(bar)[XB_TMO], 1u); break; } } } } while (0)

struct XcdBarrier {
    unsigned* bar; unsigned x;
    volatile LAS unsigned* st;
};

__device__ __forceinline__ XcdBarrier xcd_barrier_post(unsigned* bar, volatile LAS unsigned* st) {
    XcdBarrier b; b.bar = bar; b.x = xb_xcc_id(); b.st = st;
    if (threadIdx.x == 0) (void)xb_add(&bar[XB_XCNT(b.x)], 1u);
    return b;
}
__device__ __forceinline__ void xcd_barrier_complete(unsigned* bar, unsigned x, unsigned& nloc, unsigned& nx) {
    const unsigned G = gridDim.x * gridDim.y * gridDim.z;
    unsigned sum, cnt, mine, sp = 0u;
    for (;;) {
        sum = 0u; cnt = 0u; mine = 0u;
#pragma unroll
        for (unsigned j = 0; j < 16; ++j) { const unsigned c = xb_ld(&bar[XB_XCNT(j)]); sum += c; cnt += (c > 0u) ? 1u : 0u; mine = (j == x) ? c : mine; }
        if (sum == G) break;
        __builtin_amdgcn_s_sleep(1);
        if ((++sp & 255u) == 0u) { if (xb_ld(&bar[XB_TMO])) break; if (sp > XB_SPIN_CAP) { atomicAdd(&bar[XB_TMO], 1u); break; } }
    }
    nloc = mine > 0u ? mine : 1u; nx = cnt > 0u ? cnt : 1u;
}

__device__ __forceinline__ void xcd_barrier(const XcdBarrier& b) {
    asm volatile("s_waitcnt vmcnt(0)" ::: "memory");
    __syncthreads();
    if (threadIdx.x == 0) {
        unsigned* bar = b.bar;
        __builtin_amdgcn_s_waitcnt(0);
        unsigned nloc = b.st[0], nx = b.st[1];
        if (nloc == 0u) { xcd_barrier_complete(bar, b.x, nloc, nx); b.st[0] = nloc; b.st[1] = nx; }
        const unsigned old = xb_add(&bar[XB_XSUB(b.x)], 1u);
        const unsigned gen = old / nloc;
        if (old + 1u == (gen + 1u) * nloc) {
            __builtin_amdgcn_fence(__ATOMIC_RELEASE, "agent");
            asm volatile("s_waitcnt vmcnt(0)" ::: "memory");
            const unsigned og = xb_add(&bar[XB_TOP], 1u);
            const unsigned tg = og / nx;
            if (og + 1u == (tg + 1u) * nx) xb_add(&bar[XB_TOPGEN], 1u);
            else XB_SPIN(xb_ld(&bar[XB_TOPGEN]) == tg, bar);
            __builtin_amdgcn_fence(__ATOMIC_ACQUIRE, "agent");
            xb_add(&bar[XB_XGEN(b.x)], 1u);
            asm volatile("s_waitcnt vmcnt(0)" ::: "memory");
        } else {
            XB_SPIN(xb_ld(&bar[XB_XGEN(b.x)]) == gen, bar);
            __builtin_amdgcn_fence(__ATOMIC_ACQUIRE, "agent");
            asm volatile("s_waitcnt vmcnt(0)" ::: "memory");
        }
    }
    __syncthreads();
}
#endif

#ifndef HOST_EMU
constexpr int LDS_BYTES = 147456;
#ifndef FAST_PRO
#define FAST_PRO 1
#endif
#ifndef FAST_NORM
#define FAST_NORM 1
#endif
#ifndef FAST_POOL
#define FAST_POOL 1
#endif
#ifndef FAST_QKPOST
#define FAST_QKPOST 1
#endif
#ifndef FAST_CONV
#define FAST_CONV 1
#endif
#ifndef FAST_ATTN
#define FAST_ATTN 1
#endif
#ifndef REP_GEMM
#define REP_GEMM 0
#endif
#ifndef REP_ATTN
#define REP_ATTN 0
#endif
#ifndef REP_ELEM
#define REP_ELEM 0
#endif
#ifndef REP_PRO
#define REP_PRO 0
#endif
#ifndef REP_SYNC
#define REP_SYNC 0
#endif
#ifndef USE_CG_SYNC
#define USE_CG_SYNC 0
#endif
__global__ void __launch_bounds__(512, 2) mega(Params P) {
  extern __shared__ __attribute__((aligned(16))) unsigned char lds_raw[];
  cg::grid_group grid = cg::this_grid();
  PG8_LAS unsigned char* lds = (PG8_LAS unsigned char*)lds_raw;
  const Ctx c = make_ctx(P);
  volatile LAS unsigned* MISC = (volatile LAS unsigned*)((LAS unsigned char*)lds_raw + 131072 + 320);
  if (threadIdx.x < 32) MISC[threadIdx.x] = 0u;
  __syncthreads();
  { unsigned* b0_ = (unsigned*)(P.ws + WS_CTL); asm volatile("" : "+s"(b0_)); (void)xcd_barrier_post(b0_, MISC + 8); }
#define BAR_NOW() do { XcdBarrier bar_; { unsigned* b0_ = (unsigned*)(P.ws + WS_CTL); asm volatile("" : "+s"(b0_)); bar_.bar = b0_; } bar_.x = xb_xcc_id(); bar_.st = (volatile LAS unsigned*)((LAS unsigned char*)lds_raw + 131072 + 320) + 8; xcd_barrier(bar_); } while (0)
#define GSYNC() do { if (USE_CG_SYNC) grid.sync(); else BAR_NOW(); if (REP_SYNC) { if (USE_CG_SYNC) grid.sync(); else BAR_NOW(); } } while (0)
#define NAIVE(step) do { naive_step((step), P, c); } while (0)
#define GEMM_RUN(step, rep_) do { GemmDesc g; gemm_desc((step), P, c, g); \
    pg8::Gemm gg{g.A, g.Bt, T, g.N, g.K, g.lda, g.ldb, g.a_pn_step, g.ksplit}; pg8::StaticOrder S; S.init(T, g.N, (int)gridDim.x, opaque_block(), g.ksplit); \
    if (g.res) { bf16_t* slab_ = (bf16_t*)(c.ws_p() + (pend == (const bf16_t*)(c.ws_p() + WS_SA) ? WS_SB : WS_SA)); \
      float* xw_ = (rep_) == 0 ? c.X() : (float*)(g.K == DFF ? c.Ub() : c.Gb()); const bool first_ = ((step) == N_PRE + 7); \
      pg8::EpiRes E{xw_, first_ ? pin(P, I_XP) : (const float*)xw_, first_ ? pin(P, I_XS) - (size_t)TCTX * D : (const float*)xw_, MODl, g.gate_chunk, g.colscale, pend, slab_}; pg8::gemm_phase<pg8::EpiRes, pg8::StaticOrder, true, true>(lds, gg, S, E); \
      if ((rep_) == 0) pend = g.ksplit > 1 ? (const bf16_t*)slab_ : nullptr; } \
    else { pg8::EpiBf16<0> E{g.C, g.ldc, nullptr, 0, 0, 1.f}; pg8::gemm_phase<pg8::EpiBf16<0>, pg8::StaticOrder, true, true>(lds, gg, S, E); } } while (0)
#define GEMM_STEP(step) do { GEMM_RUN(step, 0); if (REP_GEMM) { __syncthreads(); GEMM_RUN(step, 1); } } while (0)
  const bf16_t* pend = nullptr;
#define BG_AFTER_GEMM(nunits, ticks) do { const int G_ = (int)gridDim.x, b_ = opaque_block(), r_ = ((nunits) + G_ - 1) / G_, full_ = (nunits) - (r_ - 1) * G_; \
    if (b_ >= full_) bg_work(P, c, (LAS unsigned char*)lds_raw, (ticks), bg_total_items()); } while (0)
  if (FAST_PRO) { for (int rep_ = 0; rep_ < 1 + REP_PRO; ++rep_) ph_prologue(P, c, (LAS unsigned char*)lds_raw); GSYNC(); }
  else { NAIVE(0); GSYNC(); NAIVE(1); GSYNC(); NAIVE(2); GSYNC(); }
#pragma unroll 1
  for (int l = 0; l < 4; ++l) {
    const int s0 = N_PRE + l * STEPS_PER_LAYER;
    const float* MODl = c.MOD() + (size_t)l * NCOND * MODW;
    if (l > 0) bg_work(P, c, (LAS unsigned char*)lds_raw, 0xffffffffu, bg_end_of_layer(l));
    if (FAST_NORM) { for (int rep_ = 0; rep_ < 1 + REP_ELEM; ++rep_) ph_norm(l == 0 ? pin(P, I_XP) : (const float*)c.X(), l == 0 ? pin(P, I_XS) - (size_t)TCTX * D : (const float*)c.X(), pend, pin(P, I_N1G) + l * D, MODl, 0, 1, c.Hb()); GSYNC(); }
    else { NAIVE(s0 + 0); GSYNC(); NAIVE(s0 + 1); GSYNC(); }
    if (l == 0) {
      if (FAST_POOL) { for (int rep_ = 0; rep_ < 1 + REP_ELEM; ++rep_) ph_pool(c.Hb(), c.PDb()); } else NAIVE(s0 + 2);
      GSYNC();
    } else {
      if (FUSE_QKEPI) {
        GemmDesc g; gemm_desc(s0 + 2, P, c, g);
        pg8::Gemm gg{g.A, g.Bt, T, g.N, g.K, g.lda, g.ldb, g.a_pn_step, 1}; pg8::StaticOrder S; S.init(T, g.N, (int)gridDim.x, opaque_block(), 1);
        pg8::EpiQK E{c.QKVb(), g.N, 1024, l == 2 ? 2048 : 1280, pin(P, l == 1 ? I_GQN : (l == 2 ? I_DQN : I_WQN)), pin(P, l == 1 ? I_GKN : (l == 2 ? I_DKN : I_WKN)), c.ROPE(),
                     l == 1 ? c.o_gk() : (l == 2 ? c.o_dk() : c.o_wk()), l == 1 ? c.o_gv() : (l == 2 ? c.o_dv() : c.o_wv()), l == 2 ? 1024 : 256, (PG8_LAS float*)(lds + 131072 + 1024)};
        pg8::gemm_phase<pg8::EpiQK, pg8::StaticOrder, true, true>(lds, gg, S, E);
      } else GEMM_STEP(s0 + 2);
      GSYNC();
      if (FUSE_QKPOST || FUSE_QKEPI) {   }
      else if (FAST_QKPOST) {
        if (l == 2) ph_qkpost(c.QKVb(), 3072, 16, 16, 16, 1024, 2048, pin(P, I_DQN), pin(P, I_DKN), c.ROPE(), c.o_dk(), c.o_dv());
        else ph_qkpost(c.QKVb(), 1536, 16, 4, 4, 1024, 1280, pin(P, l == 1 ? I_GQN : I_WQN), pin(P, l == 1 ? I_GKN : I_WKN), c.ROPE(), l == 1 ? c.o_gk() : c.o_wk(), l == 1 ? c.o_gv() : c.o_wv());
      } else NAIVE(s0 + 3);
      if (!FUSE_QKPOST && !FUSE_QKEPI) GSYNC();
      if (FAST_ATTN) {
        const float lam_init = 0.8f - 0.6f * expf(-0.3f * (float)l);
        for (int rep_ = 0; rep_ < 1 + REP_ATTN; ++rep_) {
        if (l == 2) { const att::Args A{c.QKVb(), 3072, 1024, 2048, pin(P, I_CDK), pin(P, I_CDV), 1024, nullptr, pin(P, I_DLQ1), pin(P, I_DLK1), pin(P, I_DLQ2), pin(P, I_DLK2), lam_init, pin(P, I_DSUB), c.Ob(), pin(P, I_DQN), pin(P, I_DKN), c.ROPE(), c.o_dk(), c.o_dv()};
          att::phase<2>(A, (LAS unsigned char*)lds_raw); }
        else if (l == 1) { const att::Args A{c.QKVb(), 1536, 1024, 1280, pin(P, I_CGK), pin(P, I_CGV), 256, nullptr, nullptr, nullptr, nullptr, nullptr, 0.f, nullptr, c.Ob(), pin(P, I_GQN), pin(P, I_GKN), c.ROPE(), c.o_gk(), c.o_gv()};
          att::phase<0>(A, (LAS unsigned char*)lds_raw); }
        else { const att::Args A{c.QKVb(), 1536, 1024, 1280, pin(P, I_CWK), pin(P, I_CWV), 256, pin(P, I_WSINK), nullptr, nullptr, nullptr, nullptr, 0.f, nullptr, c.Ob(), pin(P, I_WQN), pin(P, I_WKN), c.ROPE(), c.o_wk(), c.o_wv()};
          att::phase<1>(A, (LAS unsigned char*)lds_raw); }
        }
        GSYNC();
      } else {
        NAIVE(s0 + 5); GSYNC();
        if (l == 2) { NAIVE(s0 + 6); GSYNC(); }
      }
    }
    GEMM_STEP(s0 + 7); BG_AFTER_GEMM((T / 256) * (D / 256) * (l == 0 ? 1 : KSPLIT), l == 0 ? 400u : 800u); GSYNC();
    if (FAST_NORM) { for (int rep_ = 0; rep_ < 1 + REP_ELEM; ++rep_) ph_norm(c.X(), c.X(), pend, pin(P, I_N2G) + l * D, MODl, 3, 4, c.Hb()); GSYNC(); }
    else { NAIVE(s0 + 8); GSYNC(); NAIVE(s0 + 9); GSYNC(); }
    if (FUSE_CONV) {
      GemmDesc g; gemm_desc(s0 + 10, P, c, g);
      pg8::Gemm gg{g.A, g.Bt, T, g.N, g.K, g.lda, g.ldb, g.a_pn_step, 1}; pg8::LimitedOrder S; S.init(T, g.N, (int)gridDim.x, opaque_block(), 1);
      const int G_ = (int)gridDim.x, full_rounds = S.nwg / G_, left = S.nwg - full_rounds * G_;
      S.maxr = (WIN_TAIL && left * 4 < G_) ? full_rounds : full_rounds + 1;
      pg8::EpiConv E{c.Gb(), pin(P, I_FCW) + (size_t)l * 3 * DFF2, pin(P, I_FCB) + (size_t)l * DFF2, (float*)(c.ws_p() + WS_EDGE), (PG8_LAS unsigned*)(lds + 131072 + 1024)};
      pg8::gemm_phase<pg8::EpiConv, pg8::LimitedOrder, true, true>(lds, gg, S, E);
      if (S.maxr == full_rounds) {
        for (int su = opaque_block(); su < left * 16; su += G_) {
          pg8::StaticOrder S2; S2.init(T, g.N, G_, su >> 4, 1); pg8::Unit u; S2.next(full_rounds, u);
          win_subunit(g.A, g.Bt, pin(P, I_FCW) + (size_t)l * 3 * DFF2, pin(P, I_FCB) + (size_t)l * DFF2, c.Gb(), (float*)(c.ws_p() + WS_EDGE), (LAS unsigned char*)lds_raw, u.pm, u.pn, su & 15);
        }
      }
    } else {
    GEMM_STEP(s0 + 10); GSYNC();
    if (FAST_CONV) { for (int rep_ = 0; rep_ < 1 + REP_ELEM; ++rep_) ph_convgate(c.Ub(), pin(P, I_FCW) + (size_t)l * 3 * DFF2, pin(P, I_FCB) + (size_t)l * DFF2, c.Gb()); } else NAIVE(s0 + 11);
    }
    GSYNC();
    if (FUSE_CONV) {
      GemmDesc g; gemm_desc(s0 + 12, P, c, g); pg8::StaticOrder S; S.init(T, g.N, (int)gridDim.x, opaque_block(), g.ksplit); pg8::Unit u;
      for (int i = 0; S.next(i, u); ++i) conv_fixup_unit((const float*)(c.ws_p() + WS_EDGE), pin(P, I_FCW) + (size_t)l * 3 * DFF2, pin(P, I_FCB) + (size_t)l * DFF2, c.Gb(), u.pm, u.kh * (DFF / g.ksplit), DFF / g.ksplit);
      asm volatile("s_waitcnt vmcnt(0)" ::: "memory"); __syncthreads();
    }
    GEMM_STEP(s0 + 12); BG_AFTER_GEMM((T / 256) * (D / 256) * ((DFF % 256 == 0) ? KSPLIT : 1), 2800u);
    if (l < 3) GSYNC();
  }
  if (pend) {
    GSYNC();
    const WaveId w = wave_id();
    for (int t = w.gw; t < T; t += w.ngw) { f32x4* xr = (f32x4*)(c.X() + (size_t)t * D) + w.lane; const u32x2* pr = (const u32x2*)(pend + (size_t)t * D) + w.lane;
#pragma unroll
      for (int j = 0; j < 4; ++j) { const u32x2 q = pr[64 * j]; xr[64 * j] = xr[64 * j] + (f32x4){bf_lo(q.x), bf_hi(q.x), bf_lo(q.y), bf_hi(q.y)}; } }
  }
}
#endif

extern "C" void kernel_launch(void* const* d_in, const int* in_sizes, int n_in, void* d_out, int out_size, void* d_ws, size_t ws_size,
                              hipStream_t stream) {
  (void)in_sizes; (void)n_in; (void)out_size;
  Params P{};
  for (int i = 0; i < N_IN; ++i) P.in[i] = (const float*)d_in[i];
  P.out = (float*)d_out; P.ws = (unsigned char*)d_ws;
#ifdef HOST_EMU
  for (int step = 0; step < N_STEPS; ++step) { if (step_is_noop(step)) continue; emu_launch(256, 8, [&] { const Ctx c = make_ctx(P); naive_step(step, P, c); }); }
#else
  static int grid_blocks = 0;
  if (!grid_blocks) {
    if (ws_size < WS_END) { fprintf(stderr, "kernel_launch: workspace too small (%zu < %zu)\n", ws_size, (size_t)WS_END); grid_blocks = -1; return; }
    int dev = 0, cus = 0, per_cu = 0;
    (void)hipGetDevice(&dev);
    (void)hipDeviceGetAttribute(&cus, hipDeviceAttributeMultiprocessorCount, dev);
    (void)hipFuncSetAttribute((const void*)mega, hipFuncAttributeMaxDynamicSharedMemorySize, LDS_BYTES);
    (void)hipOccupancyMaxActiveBlocksPerMultiprocessor(&per_cu, mega, 512, LDS_BYTES);
    if (per_cu < 1) { fprintf(stderr, "kernel_launch: occupancy query says %d blocks per CU\n", per_cu); per_cu = 1; }
    if (per_cu > 1) per_cu = 1;
    grid_blocks = cus * per_cu;
  }
  if (grid_blocks < 0) return;
  if (hipMemsetAsync((char*)d_ws + WS_CTL, 0, CTL_ZERO_BYTES, stream) != hipSuccess) { fprintf(stderr, "kernel_launch: hipMemsetAsync of the control words failed\n"); return; }
  void* args[] = {&P};
  hipError_t e = hipLaunchCooperativeKernel((void*)mega, dim3(grid_blocks), dim3(512), args, LDS_BYTES, stream);
  if (e != hipSuccess) fprintf(stderr, "cooperative launch failed: %s (grid %d)\n", hipGetErrorString(e), grid_blocks);
#endif
}
```

```cpp
#ifndef HOST_EMU
#include <hip/hip_runtime.h>
#include <hip/hip_cooperative_groups.h>
#include <cstdio>
#include <cstdint>
#include <cmath>
namespace cg = cooperative_groups;
#endif

#ifndef CFG_BATCH
#define CFG_BATCH 16
#endif
#ifndef ATT_FIXED_REF
#define ATT_FIXED_REF 1
#endif
#ifndef BG_QUEUE
#define BG_QUEUE 0
#endif
#ifndef WIN_TAIL
#define WIN_TAIL 0
#endif
#ifndef FUSE_QKEPI
#define FUSE_QKEPI 0
#endif
#ifndef FUSE_QKPOST
#define FUSE_QKPOST 0
#endif
#ifndef FUSE_CONV
#define FUSE_CONV 1
#endif
#ifndef CFG_DFF
#define CFG_DFF 2816
#endif

namespace cfg {
constexpr int D = 1024, BATCH = CFG_BATCH, SEQ = 256, DEC_BATCH = 2, DEC_SEQ = 1024, PAST = 256;
constexpr int TCTX = BATCH * SEQ, TLAT = DEC_BATCH * DEC_SEQ, T = TCTX + TLAT;
constexpr int DFF = CFG_DFF, DFF2 = 2 * DFF;
constexpr int NCOND = 3, MODW = 6 * D;
constexpr float EPS = 1e-6f;
}
using namespace cfg;

typedef unsigned short bf16_t;
#ifdef HOST_EMU
static inline float bf2f(bf16_t v) { unsigned u = (unsigned)v << 16; float f; memcpy(&f, &u, 4); return f; }
static inline bf16_t f2bf(float f) { unsigned u; memcpy(&u, &f, 4); return (bf16_t)((u + 0x7fffu + ((u >> 16) & 1u)) >> 16); }
#else
__device__ __forceinline__ float bf2f(bf16_t v) { return __uint_as_float((unsigned)v << 16); }
__device__ __forceinline__ bf16_t f2bf(float f) { unsigned u = __float_as_uint(f); return (bf16_t)((u + 0x7fffu + ((u >> 16) & 1u)) >> 16); }
#endif

__device__ __forceinline__ int tok_cond(int t) { return t < TCTX ? 0 : 1 + (t - TCTX) / DEC_SEQ; }
__device__ __forceinline__ void tok_seq(int t, int& s0, int& L) {
  if (t < TCTX) { s0 = (t / SEQ) * SEQ; L = SEQ; } else { s0 = TCTX + ((t - TCTX) / DEC_SEQ) * DEC_SEQ; L = DEC_SEQ; }
}
__device__ __forceinline__ float silu_f(float x) { return x / (1.0f + expf(-x)); }

#ifdef HOST_EMU
static inline long opaque_tid() { return (long)blockIdx.x * blockDim.x + threadIdx.x; }
#else
__device__ __forceinline__ long opaque_tid() { int t = (int)(blockIdx.x * blockDim.x + threadIdx.x); asm volatile("" : "+v"(t)); return (long)t; }
#endif
#define GRID_STRIDE(idx, total) \
  for (long idx = opaque_tid(), _gs = (long)gridDim.x * blockDim.x; idx < (long)(total); idx += _gs)

__device__ void nk_copy_x(const float* xp, const float* xs, float* X) {
  GRID_STRIDE(i, (long)T * D) X[i] = i < (long)TCTX * D ? xp[i] : xs[i - (long)TCTX * D];
}

__device__ void nk_mod(const float* c, const float* c_ctx, const float* w_mod, const float* b_mod, float* MOD, int nlayer) {
  GRID_STRIDE(i, (long)nlayer * NCOND * MODW) {
    const int n = (int)(i % MODW), cd = (int)((i / MODW) % NCOND), l = (int)(i / ((long)MODW * NCOND));
    const float* cv = cd == 0 ? c_ctx : c + (cd - 1) * D;
    const float* w = w_mod + (long)l * D * MODW + n;
    float acc = 0.f;
    for (int k = 0; k < D; ++k) acc += silu_f(cv[k]) * w[(long)k * MODW];
    MOD[i] = acc + b_mod[(long)l * MODW + n];
  }
}

__device__ void nk_rope_table(float* ROPE) {
  GRID_STRIDE(i, (long)DEC_SEQ * 32) {
    const int pos = (int)(i / 32), a = (int)((i / 16) % 2), f = (int)(i % 16);
    const float inv = powf(10000.0f, -(float)(2 * f) / 32.0f), ang = (a == 0 ? (float)(pos / 64) : (float)(pos % 64)) * inv;
    ROPE[2 * i] = cosf(ang); ROPE[2 * i + 1] = sinf(ang);
  }
}

__device__ void nk_wt(const float* W, int K, int N, bf16_t* WT) {
  GRID_STRIDE(i, (long)K * N) { const int n = (int)(i / K), k = (int)(i % K); WT[i] = f2bf(W[(long)k * N + n]); }
}

__device__ void nk_rstd(const float* X, float* RSTD) {
  GRID_STRIDE(t, T) {
    const float* x = X + t * D; float ss = 0.f;
    for (int d = 0; d < D; ++d) ss += x[d] * x[d];
    RSTD[t] = 1.0f / sqrtf(ss / (float)D + EPS);
  }
}

__device__ void nk_normmod(const float* X, const float* RSTD, const float* g, const float* MODl, int sh_chunk, int sc_chunk, bf16_t* Hb) {
  GRID_STRIDE(i, (long)T * D) {
    const int t = (int)(i / D), d = (int)(i % D); const float* m = MODl + (long)tok_cond(t) * MODW;
    Hb[i] = f2bf(X[i] * RSTD[t] * g[d] * (1.0f + m[sc_chunk * D + d]) + m[sh_chunk * D + d]);
  }
}

__device__ void nk_gemm_bf(const bf16_t* A, int lda, const bf16_t* Bt, int ldb, bf16_t* C, int ldc, int M, int N, int K) {
  GRID_STRIDE(i, (long)M * N) {
    const int t = (int)(i / N), n = (int)(i % N); const bf16_t* a = A + (long)t * lda; const bf16_t* b = Bt + (long)n * ldb;
    float acc = 0.f;
    for (int k = 0; k < K; ++k) acc += bf2f(a[k]) * bf2f(b[k]);
    C[(long)t * ldc + n] = f2bf(acc);
  }
}

__device__ void nk_gemm_res(const bf16_t* A, int lda, int a_pn_step, const bf16_t* Bt, int ldb, float* X, int M, int N, int K,
                            const float* MODl, int gate_chunk, const float* colscale) {
  GRID_STRIDE(i, (long)M * N) {
    const int t = (int)(i / N), n = (int)(i % N); const bf16_t* a = A + (long)t * lda + (n / 256) * a_pn_step; const bf16_t* b = Bt + (long)n * ldb;
    float acc = 0.f;
    for (int k = 0; k < K; ++k) acc += bf2f(a[k]) * bf2f(b[k]);
    if (colscale) acc *= colscale[n];
    X[(long)t * D + n] += MODl[(long)tok_cond(t) * MODW + gate_chunk * D + n] * acc;
  }
}

__device__ void nk_pool(const bf16_t* Hb, bf16_t* PDb) {
  GRID_STRIDE(i, (long)T * D) {
    const int t = (int)(i / D), d = (int)(i % D), g = d / 256, w = 2 << g; int s0, L; tok_seq(t, s0, L);
    const int pos = t - s0; int lo = pos - w / 2, hi = pos - w / 2 + w; lo = lo < 0 ? 0 : lo; hi = hi > L ? L : hi;
    float s = 0.f;
    for (int j = lo; j < hi; ++j) s += bf2f(Hb[(long)(s0 + j) * D + d]);
    PDb[i] = f2bf(s / (float)(hi - lo) - bf2f(Hb[i]));
  }
}

__device__ void nk_qknorm_rope(bf16_t* QKV, int ld, int nq, int nk, int kcol0, const float* qn, const float* kn, float* kout) {
  GRID_STRIDE(i, (long)T * (nq + nk)) {
    const int t = (int)(i / (nq + nk)), s = (int)(i % (nq + nk));
    bf16_t* v = QKV + (long)t * ld + (s < nq ? s * 64 : kcol0 + (s - nq) * 64); const float* w = s < nq ? qn : kn;
    float ss = 0.f;
    for (int d = 0; d < 64; ++d) ss += bf2f(v[d]) * bf2f(v[d]);
    const float r = 1.0f / sqrtf(ss / 64.0f + EPS);
    if (t < TCTX) {
      for (int d = 0; d < 64; ++d) { const float y = bf2f(v[d]) * r * w[d]; v[d] = f2bf(y); if (s >= nq) kout[(long)t * (nk * 64) + (s - nq) * 64 + d] = y; }
    } else {
      const int pos = (t - TCTX) % DEC_SEQ; const float prow = (float)(pos / 64), pcol = (float)(pos % 64);
      for (int a = 0; a < 2; ++a)
        for (int f = 0; f < 16; ++f) {
          const float inv = powf(10000.0f, -(float)(2 * f) / 32.0f), ang = (a == 0 ? prow : pcol) * inv, cs = cosf(ang), sn = sinf(ang);
          const int i1 = a * 32 + f, i2 = a * 32 + 16 + f; const float x1 = bf2f(v[i1]) * r * w[i1], x2 = bf2f(v[i2]) * r * w[i2];
          v[i1] = f2bf(x1 * cs - x2 * sn); v[i2] = f2bf(x2 * cs + x1 * sn);
        }
    }
  }
}

__device__ void nk_copy_cols_f(const bf16_t* S, int ld, int col0, int width, int rows, float* out) {
  GRID_STRIDE(i, (long)rows * width) { const int t = (int)(i / width), j = (int)(i % width); out[i] = bf2f(S[(long)t * ld + col0 + j]); }
}

__device__ __forceinline__ float dot64_bb(const bf16_t* a, const bf16_t* b) {
  float s = 0.f;
  for (int d = 0; d < 64; ++d) s += bf2f(a[d]) * bf2f(b[d]);
  return s;
}
__device__ __forceinline__ float dot64_bf(const bf16_t* a, const float* b) {
  float s = 0.f;
  for (int d = 0; d < 64; ++d) s += bf2f(a[d]) * bf2f(f2bf(b[d]));
  return s;
}

template <int MODE>
__device__ void nk_attn(const bf16_t* QKV, int ld, int kcol0, int vcol0, const float* ck, const float* cv, int cld,
                        const float* sink, const float* lq1, const float* lk1, const float* lq2, const float* lk2, float lam_init, bf16_t* O) {
  GRID_STRIDE(i, (long)T * 64) {
    const int t = (int)(i / 64), r = (int)(i % 64); const bool lat = t >= TCTX; int s0, L; tok_seq(t, s0, L);
    const int b = lat ? (t - TCTX) / DEC_SEQ : 0, ncache = lat ? PAST : 0;
    int jlo = 0, jhi = L - 1;
    if (MODE == 1 && lat) { const int pos = t - s0; jlo = pos - 128 < 0 ? 0 : pos - 128; jhi = pos + 128 > L - 1 ? L - 1 : pos + 128; }
    if (MODE != 2) {
      const int h = r / 4, ch = r % 4, koff = (h / 4) * 64, voff = (h / 4) * 64 + ch * 16; const bf16_t* q = QKV + (long)t * ld + h * 64;
      float m = -3.0e38f;
      for (int p = 0; p < ncache; ++p) m = fmaxf(m, dot64_bf(q, ck + (long)(b * PAST + p) * cld + koff) * 0.125f);
      for (int j = jlo; j <= jhi; ++j) m = fmaxf(m, dot64_bb(q, QKV + (long)(s0 + j) * ld + kcol0 + koff) * 0.125f);
      if (MODE == 1) m = fmaxf(m, sink[h]);
      float sum = 0.f, o[16];
#pragma unroll
      for (int e = 0; e < 16; ++e) o[e] = 0.f;
      for (int p = 0; p < ncache; ++p) {
        const float pr = expf(dot64_bf(q, ck + (long)(b * PAST + p) * cld + koff) * 0.125f - m); sum += pr; const float* v = cv + (long)(b * PAST + p) * cld + voff;
#pragma unroll
        for (int e = 0; e < 16; ++e) o[e] += pr * v[e];
      }
      for (int j = jlo; j <= jhi; ++j) {
        const float pr = expf(dot64_bb(q, QKV + (long)(s0 + j) * ld + kcol0 + koff) * 0.125f - m); sum += pr; const bf16_t* v = QKV + (long)(s0 + j) * ld + vcol0 + voff;
#pragma unroll
        for (int e = 0; e < 16; ++e) o[e] += pr * bf2f(v[e]);
      }
      if (MODE == 1) sum += expf(sink[h] - m);
#pragma unroll
      for (int e = 0; e < 16; ++e) O[(long)t * D + h * 64 + ch * 16 + e] = f2bf(o[e] / sum);
    } else {
      float d1 = 0.f, d2 = 0.f;
      for (int d = 0; d < 64; ++d) { d1 += lq1[d] * lk1[d]; d2 += lq2[d] * lk2[d]; }
      const float lam = expf(d1) - expf(d2) + lam_init;
      const int hd = r / 8, ch = r % 8, voff = hd * 128 + ch * 16; float res[16];
#pragma unroll
      for (int e = 0; e < 16; ++e) res[e] = 0.f;
      for (int c = 0; c < 2; ++c) {
        const int koff = hd * 128 + c * 64; const bf16_t* q = QKV + (long)t * ld + koff;
        float m = -3.0e38f;
        for (int p = 0; p < ncache; ++p) m = fmaxf(m, dot64_bf(q, ck + (long)(b * PAST + p) * cld + koff) * 0.125f);
        for (int j = jlo; j <= jhi; ++j) m = fmaxf(m, dot64_bb(q, QKV + (long)(s0 + j) * ld + kcol0 + koff) * 0.125f);
        float sum = 0.f, o[16];
#pragma unroll
        for (int e = 0; e < 16; ++e) o[e] = 0.f;
        for (int p = 0; p < ncache; ++p) {
          const float pr = expf(dot64_bf(q, ck + (long)(b * PAST + p) * cld + koff) * 0.125f - m); sum += pr; const float* v = cv + (long)(b * PAST + p) * cld + voff;
#pragma unroll
          for (int e = 0; e < 16; ++e) o[e] += pr * v[e];
        }
        for (int j = jlo; j <= jhi; ++j) {
          const float pr = expf(dot64_bb(q, QKV + (long)(s0 + j) * ld + kcol0 + koff) * 0.125f - m); sum += pr; const bf16_t* v = QKV + (long)(s0 + j) * ld + vcol0 + voff;
#pragma unroll
          for (int e = 0; e < 16; ++e) o[e] += pr * bf2f(v[e]);
        }
        const float f = (c == 0 ? 1.0f : -lam) / sum;
#pragma unroll
        for (int e = 0; e < 16; ++e) res[e] += f * o[e];
      }
#pragma unroll
      for (int e = 0; e < 16; ++e) O[(long)t * D + voff + e] = f2bf(res[e]);
    }
  }
}

__device__ void nk_subnorm(bf16_t* O, const float* sub_g, float factor) {
  GRID_STRIDE(i, (long)T * 8) {
    bf16_t* o = O + i * 128; float ss = 0.f;
    for (int e = 0; e < 128; ++e) ss += bf2f(o[e]) * bf2f(o[e]);
    const float r = factor / sqrtf(ss / 128.0f + EPS);
    for (int e = 0; e < 128; ++e) o[e] = f2bf(bf2f(o[e]) * r * sub_g[e]);
  }
}

__device__ void nk_convgate(const bf16_t* U, const float* cw, const float* cb, bf16_t* G) {
  GRID_STRIDE(i, (long)T * DFF) {
    const int t = (int)(i / DFF), f = (int)(i % DFF); int s0, L; tok_seq(t, s0, L); const int pos = t - s0; float uc[2];
#pragma unroll
    for (int hf = 0; hf < 2; ++hf) {
      const int col = hf * DFF + f; const bf16_t* u = U + (long)t * DFF2 + col;
      float a = bf2f(u[0]) * cw[DFF2 + col] + cb[col];
      if (pos > 0) a += bf2f(u[-DFF2]) * cw[col];
      if (pos < L - 1) a += bf2f(u[DFF2]) * cw[2 * DFF2 + col];
      uc[hf] = a;
    }
    G[i] = f2bf(silu_f(uc[0]) * uc[1]);
  }
}

#ifndef HOST_EMU
#ifndef USE_ENGINE
#define USE_ENGINE 1
#endif
namespace pg8 {
#define PG8_LAS __attribute__((address_space(3)))
typedef unsigned short bf16_t;
typedef short bf16x8 __attribute__((ext_vector_type(8)));
typedef float f32x4 __attribute__((ext_vector_type(4)));
typedef unsigned u32x4 __attribute__((ext_vector_type(4)));
typedef unsigned u32x2v __attribute__((ext_vector_type(2)));
constexpr int BM = 256, BK = 64, HALF = 128, HTB = HALF * BK * 2  , STAGE_BYTES = 8 * HTB, NXCD = 8, WGM = 8;

__host__ __device__ __forceinline__ int lds_byte(int r, int c) { const int st = (r >> 4) * 2 + (c >> 5), rr = r & 15, cc = c & 31, ob = rr * 64 + cc * 2; return st * 1024 + (ob ^ (((ob >> 9) & 1) << 5)); }
__host__ __device__ __forceinline__ void stage_rc(int b, int& R, int& C) { const int st = b / 1024, sb = b % 1024, swz = sb ^ (((sb >> 9) & 1) << 5); R = (st >> 1) * 16 + swz / 64; C = (st & 1) * 32 + (swz % 64) / 2; }
__host__ __device__ __forceinline__ int perm32(int rho) { const int n = rho >> 4, i = rho & 15; return 8 * (i >> 2) + 4 * n + (i & 3); }

struct Unit { int pm, pn, kh; };
struct Gemm { const bf16_t* A; const bf16_t* Bt; int M, N, K, lda, ldb, a_pn_step, ksplit; };

struct StaticOrder {
    int nM, nN, nwg, G, c, ks;
    __host__ __device__ __forceinline__ void init(int M, int N, int G_, int c_, int ks_ = 1) { nM = M / BM; nN = (N / BM) * ks_; nwg = nM * nN; G = G_; c = c_; ks = ks_; }
    __host__ __device__ __forceinline__ bool next(int i, Unit& u) const {
        const long L = (long)i * G + c; if (L >= nwg) return false;
        int wgid = (int)L; { const int q = nwg / NXCD, r = nwg % NXCD, xcd = wgid % NXCD, off = wgid / NXCD; wgid = (xcd < r ? xcd * (q + 1) : r * (q + 1) + (xcd - r) * q) + off; }
        const int nig = WGM * nN, gid = wgid / nig, fm = gid * WGM, gsz = (nM - fm) < WGM ? (nM - fm) : WGM;
        u.pm = fm + ((wgid % nig) % gsz); const int pv = (wgid % nig) / gsz; u.kh = pv % ks; u.pn = pv / ks; return true;
    }
    __device__ __forceinline__ void a_ready(const Unit&) const {}
    __device__ __forceinline__ void done(const Unit&) const {}
};

struct LimitedOrder : StaticOrder {
    int maxr;
    __host__ __device__ __forceinline__ bool next(int i, Unit& u) const { return i < maxr && StaticOrder::next(i, u); }
};

__device__ __forceinline__ unsigned cvt_pk_bf16(float lo, float hi) { unsigned r; asm volatile("v_cvt_pk_bf16_f32 %0, %1, %2" : "=v"(r) : "v"(lo), "v"(hi)); return r; }
typedef float f32x2 __attribute__((ext_vector_type(2)));
__device__ __forceinline__ f32x2 gelu_pk(f32x2 v) {
    const f32x2 av = __builtin_elementwise_abs(v), d = av * 0.2316418882f + 1.0f;
    f32x2 t; t.x = __builtin_amdgcn_rcpf(d.x); t.y = __builtin_amdgcn_rcpf(d.y);
    f32x2 q = t * 0.5307027145f + (-0.7265760135f); q = q * t + 0.7107068705f; q = q * t + (-0.142248368f); q = q * t + 0.127414796f; q = q * t;
    const f32x2 s = (v * v) * (-0.72134752044f);
    f32x2 e; e.x = __builtin_amdgcn_exp2f(s.x); e.y = __builtin_amdgcn_exp2f(s.y);
    const f32x2 m = v * (q * e), r = v - m;
    f32x2 o; o.x = v.x < 0.f ? m.x : r.x; o.y = v.y < 0.f ? m.y : r.y; return o;
}

template <int ACT  > struct EpiBf16 {
    static constexpr bool PERM = true, AFTER_DRAIN = false; static_assert(ACT == 0 || ACT == 1, "EpiBf16: ACT is 0 (none) or 1 (gelu_pk)");
    bf16_t* O; int ldc; const float* bias; int split_cols; size_t split_stride; float scale0;
    __device__ __forceinline__ void operator()(const f32x4 (&acc)[2][2][4][2], const Unit& u, int wr, int wc, int fr, int fq) const {
        const int row0 = u.pm * BM + wr * 64 + fr; int colt = u.pn * BM; bf16_t* base = O;
        float sc = 1.f; if (split_cols) { const int t = colt / split_cols; base += (size_t)t * split_stride; colt -= t * split_cols; if (t == 0) sc = scale0; }
        const int col0 = colt + wc * 32 + 8 * fq, bcol0 = u.pn * BM + wc * 32 + 8 * fq;
        f32x4 bv[2][2];
#pragma unroll
        for (int bj = 0; bj < 2; ++bj)
#pragma unroll
            for (int n = 0; n < 2; ++n) bv[bj][n] = bias ? *(const f32x4*)(bias + bcol0 + bj * HALF + 4 * n) : (f32x4){0.f, 0.f, 0.f, 0.f};
#pragma unroll
        for (int ai = 0; ai < 2; ++ai)
#pragma unroll
            for (int m = 0; m < 4; ++m) { bf16_t* rowp = base + (size_t)(row0 + ai * HALF + m * 16) * ldc + col0;
#pragma unroll
                for (int bj = 0; bj < 2; ++bj) { f32x4 v0 = acc[ai][bj][m][0] + bv[bj][0], v1 = acc[ai][bj][m][1] + bv[bj][1];
                    if (ACT == 1) { f32x2 a = gelu_pk((f32x2){v0[0], v0[1]}), b = gelu_pk((f32x2){v0[2], v0[3]}), c = gelu_pk((f32x2){v1[0], v1[1]}), d = gelu_pk((f32x2){v1[2], v1[3]});
                        v0 = (f32x4){a.x, a.y, b.x, b.y}; v1 = (f32x4){c.x, c.y, d.x, d.y}; }
                    v0 = v0 * sc; v1 = v1 * sc; u32x4 w; w.x = cvt_pk_bf16(v0[0], v0[1]); w.y = cvt_pk_bf16(v0[2], v0[3]); w.z = cvt_pk_bf16(v1[0], v1[1]); w.w = cvt_pk_bf16(v1[2], v1[3]);
                    *(u32x4*)(rowp + bj * HALF) = w; } }
    }
};

struct EpiRes {
    static constexpr bool PERM = false, AFTER_DRAIN = false;
    float* X; const float* Xin_c; const float* Xin_l; const float* MODl; int gate_chunk; const float* colscale; const bf16_t* pend; bf16_t* slab;
    __device__ __forceinline__ void operator()(const f32x4 (&acc)[2][2][4][2], const Unit& u, int wr, int wc, int fr, int fq) const {
        const int row0 = u.pm * BM + wr * 64 + fr, col0 = u.pn * BM + wc * 32 + 4 * fq;
        const int trow = u.pm * BM; const int cond = trow < TCTX ? 0 : 1 + (trow - TCTX) / DEC_SEQ;
        const float* gate = MODl + (size_t)cond * MODW + gate_chunk * D;
        f32x4 gv[2][2];
#pragma unroll
        for (int bj = 0; bj < 2; ++bj)
#pragma unroll
            for (int n = 0; n < 2; ++n) { gv[bj][n] = *(const f32x4*)(gate + col0 + bj * HALF + n * 16); if (colscale) gv[bj][n] = gv[bj][n] * *(const f32x4*)(colscale + col0 + bj * HALF + n * 16); }
        if (u.kh == 0) {
#pragma unroll
          for (int ai = 0; ai < 2; ++ai)
#pragma unroll
            for (int m = 0; m < 4; ++m) { const size_t off = (size_t)(row0 + ai * HALF + m * 16) * D + col0;
#pragma unroll
                for (int bj = 0; bj < 2; ++bj)
#pragma unroll
                    for (int n = 0; n < 2; ++n) { f32x4* p = (f32x4*)(X + off + bj * HALF + n * 16); f32x4 v = *(const f32x4*)((trow < TCTX ? Xin_c : Xin_l) + off + bj * HALF + n * 16) + gv[bj][n] * acc[ai][bj][m][n];
                        if (pend) { const u32x2v q = *(const u32x2v*)(pend + off + bj * HALF + n * 16); v = v + (f32x4){__uint_as_float(q.x << 16), __uint_as_float(q.x & 0xffff0000u), __uint_as_float(q.y << 16), __uint_as_float(q.y & 0xffff0000u)}; }
                        *p = v; }
                asm volatile("" ::: "memory"); }
        } else {
#pragma unroll
          for (int ai = 0; ai < 2; ++ai)
#pragma unroll
            for (int m = 0; m < 4; ++m) { const size_t off = (size_t)(row0 + ai * HALF + m * 16) * D + col0;
#pragma unroll
                for (int bj = 0; bj < 2; ++bj)
#pragma unroll
                    for (int n = 0; n < 2; ++n) { const f32x4 v = gv[bj][n] * acc[ai][bj][m][n]; u32x2v q; q.x = cvt_pk_bf16(v[0], v[1]); q.y = cvt_pk_bf16(v[2], v[3]); *(u32x2v*)(slab + off + bj * HALF + n * 16) = q; } }
        }
    }
};

struct EpiConv {
    static constexpr bool PERM = true, AFTER_DRAIN = false;
    bf16_t* G; const float* cw; const float* cb; float* edgebuf; PG8_LAS unsigned* E;
    __device__ __forceinline__ static unsigned perm(unsigned v, int src4) { return (unsigned)__builtin_amdgcn_ds_bpermute(src4, (int)v); }
    __device__ __forceinline__ static float lo(unsigned u) { return __uint_as_float(u << 16); }
    __device__ __forceinline__ static float hi(unsigned u) { return __uint_as_float(u & 0xffff0000u); }
    __device__ __forceinline__ void operator()(const f32x4 (&acc)[2][2][4][2], const Unit& u, int wr, int wc, int fr_in, int fq_in) const {
        int fr = fr_in, fq = fq_in; asm volatile("" : "+v"(fr), "+v"(fq));
        const int lane = fq * 16 + fr, srcP4 = ((lane & 48) | ((fr + 15) & 15)) << 2, srcN4 = ((lane & 48) | ((fr + 1) & 15)) << 2;
        const int lc = wc * 32 + 8 * fq;
        unsigned pk[2][2][4][4];
#pragma unroll
        for (int ai = 0; ai < 2; ++ai)
#pragma unroll
          for (int bj = 0; bj < 2; ++bj)
#pragma unroll
            for (int m = 0; m < 4; ++m)
#pragma unroll
              for (int n = 0; n < 2; ++n) { const f32x4 v = acc[ai][bj][m][n]; pk[ai][bj][m][2 * n] = cvt_pk_bf16(v[0], v[1]); pk[ai][bj][m][2 * n + 1] = cvt_pk_bf16(v[2], v[3]); }
        if (fr == 0 || fr == 15) { const int which = fr == 0 ? 0 : 1;
#pragma unroll
          for (int ai = 0; ai < 2; ++ai)
#pragma unroll
            for (int bj = 0; bj < 2; ++bj) { u32x4 w;
              if (fr == 0) { w.x = pk[ai][bj][0][0]; w.y = pk[ai][bj][0][1]; w.z = pk[ai][bj][0][2]; w.w = pk[ai][bj][0][3]; } else { w.x = pk[ai][bj][3][0]; w.y = pk[ai][bj][3][1]; w.z = pk[ai][bj][3][2]; w.w = pk[ai][bj][3][3]; }
              *(PG8_LAS u32x4*)(E + (((ai * 2 + wr) * 2 + which) * 2 + bj) * 64 + (lc >> 1)) = w; } }
        if (u.pm * BM >= TCTX) { const bool top = (wr == 0 && fr < 2), bot = (wr == 1 && fr >= 14);
          if (top || bot) { const int r4 = top ? fr : fr - 12; float* eb = edgebuf + ((size_t)((u.pm - TCTX / BM) * (DFF / 128) + u.pn) * 4 + r4) * 256 + lc;
#pragma unroll
            for (int bj = 0; bj < 2; ++bj) { unsigned q0, q1, q2, q3;
              if (top) { q0 = pk[0][bj][0][0]; q1 = pk[0][bj][0][1]; q2 = pk[0][bj][0][2]; q3 = pk[0][bj][0][3]; } else { q0 = pk[1][bj][3][0]; q1 = pk[1][bj][3][1]; q2 = pk[1][bj][3][2]; q3 = pk[1][bj][3][3]; }
              *(f32x4*)(eb + bj * 128) = (f32x4){lo(q0), hi(q0), lo(q1), hi(q1)}; *(f32x4*)(eb + bj * 128 + 4) = (f32x4){lo(q2), hi(q2), lo(q3), hi(q3)}; } } }
        asm volatile("s_waitcnt lgkmcnt(0)" ::: "memory"); __builtin_amdgcn_s_barrier(); asm volatile("" ::: "memory");
        const int gcol = u.pn * 128 + lc;
#pragma unroll
        for (int ai = 0; ai < 2; ++ai) {
          float ca[4][8];
#pragma unroll
          for (int bj = 0; bj < 2; ++bj) {
            const int col = bj * DFF + gcol;
            float w0[8], w1[8], w2[8], bb[8];
#pragma unroll
            for (int e = 0; e < 8; e += 4) { const f32x4 a0 = *(const f32x4*)(cw + col + e), a1 = *(const f32x4*)(cw + DFF2 + col + e), a2 = *(const f32x4*)(cw + 2 * DFF2 + col + e), a3 = *(const f32x4*)(cb + col + e);
#pragma unroll
              for (int q = 0; q < 4; ++q) { w0[e + q] = a0[q]; w1[e + q] = a1[q]; w2[e + q] = a2[q]; bb[e + q] = a3[q]; } }
            u32x4 eP = (u32x4){0u, 0u, 0u, 0u}, eN = (u32x4){0u, 0u, 0u, 0u};
            if (wr == 1) eP = *(const PG8_LAS u32x4*)(E + (((ai * 2 + 0) * 2 + 1) * 2 + bj) * 64 + (lc >> 1));
            else if (ai == 1) eP = *(const PG8_LAS u32x4*)(E + (((0 * 2 + 1) * 2 + 1) * 2 + bj) * 64 + (lc >> 1));
            if (wr == 0) eN = *(const PG8_LAS u32x4*)(E + (((ai * 2 + 1) * 2 + 0) * 2 + bj) * 64 + (lc >> 1));
            else if (ai == 0) eN = *(const PG8_LAS u32x4*)(E + (((1 * 2 + 0) * 2 + 0) * 2 + bj) * 64 + (lc >> 1));
            unsigned spm1[4] = {eP.x, eP.y, eP.z, eP.w}, sn0[4];
#pragma unroll
            for (int h = 0; h < 4; ++h) sn0[h] = perm(pk[ai][bj][0][h], srcN4);
#pragma unroll
            for (int m = 0; m < 4; ++m) {
              unsigned sp[4], sn1[4] = {eN.x, eN.y, eN.z, eN.w};
#pragma unroll
              for (int h = 0; h < 4; ++h) { sp[h] = perm(pk[ai][bj][m][h], srcP4); if (m < 3) sn1[h] = perm(pk[ai][bj][m < 3 ? m + 1 : 3][h], srcN4); }
#pragma unroll
              for (int h = 0; h < 4; ++h) {
                const unsigned pv = fr == 0 ? spm1[h] : sp[h], nx = fr == 15 ? sn1[h] : sn0[h], cu = pk[ai][bj][m][h];
                const float c0 = lo(cu) * w1[2 * h] + bb[2 * h] + lo(pv) * w0[2 * h] + lo(nx) * w2[2 * h];
                const float c1 = hi(cu) * w1[2 * h + 1] + bb[2 * h + 1] + hi(pv) * w0[2 * h + 1] + hi(nx) * w2[2 * h + 1];
                if (bj == 0) { ca[m][2 * h] = c0; ca[m][2 * h + 1] = c1; }
                else { ca[m][2 * h] = ca[m][2 * h] / (1.0f + __expf(-ca[m][2 * h])) * c0; ca[m][2 * h + 1] = ca[m][2 * h + 1] / (1.0f + __expf(-ca[m][2 * h + 1])) * c1; }
                spm1[h] = sp[h]; sn0[h] = sn1[h];
              }
              if (bj == 1) { u32x4 w; w.x = cvt_pk_bf16(ca[m][0], ca[m][1]); w.y = cvt_pk_bf16(ca[m][2], ca[m][3]); w.z = cvt_pk_bf16(ca[m][4], ca[m][5]); w.w = cvt_pk_bf16(ca[m][6], ca[m][7]);
                *(u32x4*)(G + (size_t)(u.pm * BM + ai * HALF + wr * 64 + m * 16 + fr) * DFF + gcol) = w; }
            }
            asm volatile("" ::: "memory");
          }
        }
    }
};

struct EpiQK {
    static constexpr bool PERM = true, AFTER_DRAIN = false;
    bf16_t* O; int ldc, kcol0, vcol0; const float* qn; const float* kn; const float* rope; float* kout; float* vout; int kow; PG8_LAS float* SS;
    __device__ __forceinline__ static float perm(float v, int src4) { return __int_as_float(__builtin_amdgcn_ds_bpermute(src4, __float_as_int(v))); }
    __device__ __forceinline__ void operator()(const f32x4 (&acc)[2][2][4][2], const Unit& u, int wr, int wc, int fr_in, int fq_in) const {
        int fr = fr_in, fq = fq_in; asm volatile("" : "+v"(fr), "+v"(fq));
        const int lane = fq * 16 + fr, x16 = (lane ^ 16) << 2, x32 = (lane ^ 32) << 2;
        const int colt = u.pn * BM, kind = colt < kcol0 ? 0 : (colt < vcol0 ? 1 : 2);
        const bool lat = u.pm * BM >= TCTX;
        float ss[2][2][4];
        if (kind != 2) {
#pragma unroll
          for (int ai = 0; ai < 2; ++ai)
#pragma unroll
            for (int bj = 0; bj < 2; ++bj)
#pragma unroll
              for (int m = 0; m < 4; ++m) { const f32x4 a0 = acc[ai][bj][m][0], a1 = acc[ai][bj][m][1];
                float t = (a0[0] * a0[0] + a0[1] * a0[1]) + (a0[2] * a0[2] + a0[3] * a0[3]) + (a1[0] * a1[0] + a1[1] * a1[1]) + (a1[2] * a1[2] + a1[3] * a1[3]);
                t += perm(t, x16); t += perm(t, x32); ss[ai][bj][m] = t;
                if (fq == 0) SS[(((wr * 4 + wc) * 2 + ai) * 2 + bj) * 64 + m * 16 + fr] = t; }
        }
        asm volatile("s_waitcnt lgkmcnt(0)" ::: "memory"); __builtin_amdgcn_s_barrier(); asm volatile("" ::: "memory");
        const int dh = 32 * (wc & 1) + 8 * fq;
        f32x4 w0 = (f32x4){1.f, 1.f, 1.f, 1.f}, w1 = w0;
        if (kind != 2) { const float* wp = (kind == 0 ? qn : kn) + dh; w0 = *(const f32x4*)wp; w1 = *(const f32x4*)(wp + 4); }
        const bool x2side = (fq & 2) != 0;
#pragma unroll
        for (int ai = 0; ai < 2; ++ai)
#pragma unroll
          for (int m = 0; m < 4; ++m) {
            const int row = u.pm * BM + ai * HALF + wr * 64 + m * 16 + fr;
#pragma unroll
            for (int bj = 0; bj < 2; ++bj) {
              float y[8]; { const f32x4 a0 = acc[ai][bj][m][0], a1 = acc[ai][bj][m][1]; y[0] = a0[0]; y[1] = a0[1]; y[2] = a0[2]; y[3] = a0[3]; y[4] = a1[0]; y[5] = a1[1]; y[6] = a1[2]; y[7] = a1[3]; }
              if (kind != 2) {
                const float tot = ss[ai][bj][m] + SS[(((wr * 4 + (wc ^ 1)) * 2 + ai) * 2 + bj) * 64 + m * 16 + fr];
                const float r = 1.0f / sqrtf(tot / 64.0f + EPS);
                y[0] *= r * w0[0]; y[1] *= r * w0[1]; y[2] *= r * w0[2]; y[3] *= r * w0[3]; y[4] *= r * w1[0]; y[5] *= r * w1[1]; y[6] *= r * w1[2]; y[7] *= r * w1[3];
                if (lat) { const int pos = (row - TCTX) % DEC_SEQ; const f32x4* tb = (const f32x4*)(rope + ((size_t)(pos * 2 + (wc & 1)) * 16 + 8 * (fq & 1)) * 2);
#pragma unroll
                  for (int e2 = 0; e2 < 4; ++e2) { const f32x4 cs = tb[e2]; const float p0 = perm(y[2 * e2], x32), p1 = perm(y[2 * e2 + 1], x32);
                    y[2 * e2] = x2side ? y[2 * e2] * cs[0] + p0 * cs[1] : y[2 * e2] * cs[0] - p0 * cs[1];
                    y[2 * e2 + 1] = x2side ? y[2 * e2 + 1] * cs[2] + p1 * cs[3] : y[2 * e2 + 1] * cs[2] - p1 * cs[3]; } }
              }
              const int cl = bj * HALF + wc * 32 + 8 * fq;
              u32x4 w; w.x = cvt_pk_bf16(y[0], y[1]); w.y = cvt_pk_bf16(y[2], y[3]); w.z = cvt_pk_bf16(y[4], y[5]); w.w = cvt_pk_bf16(y[6], y[7]);
              *(u32x4*)(O + (size_t)row * ldc + colt + cl) = w;
              if (!lat && kind != 0) { float* op = (kind == 1 ? kout + (size_t)row * kow + (colt - kcol0) : vout + (size_t)row * kow + (colt - vcol0)) + cl;
                *(f32x4*)op = (f32x4){y[0], y[1], y[2], y[3]}; *(f32x4*)(op + 4) = (f32x4){y[4], y[5], y[6], y[7]}; }
            }
            asm volatile("" ::: "memory");
          }
    }
};

template <class Epi, class Sched, bool ALIGN_EPI = false, bool SP2 = false>
__device__ __forceinline__ void gemm_phase(PG8_LAS unsigned char* lds, const Gemm g, const Sched& S, const Epi& E) {
    int tid_ = threadIdx.x; asm volatile("" : "+v"(tid_));
    const int tid = tid_, wid = __builtin_amdgcn_readfirstlane(tid >> 6), lane = tid & 63, wr = wid >> 2, wc = wid & 3, fr = lane & 15, fq = lane >> 4;
    const int K = g.K / g.ksplit, nt = K / BK;
    unsigned voffA[2], voffB[2];
#pragma unroll
    for (int i = 0; i < 2; ++i) { int R, C; stage_rc(tid * 16 + i * 8192, R, C); const int Rb = Epi::PERM ? ((R & ~31) + perm32(R & 31)) : R;
        voffA[i] = (unsigned)(R * g.lda + C) * 2u; voffB[i] = (unsigned)(Rb * g.ldb + C) * 2u; }
    const size_t kstep = (size_t)(BK * 2);
    const size_t hstepA = (size_t)HALF * g.lda * 2, hstepB = (size_t)HALF * g.ldb * 2;
    const size_t tstepA = 2 * hstepA, tstepB = 2 * hstepB, pnstepA = (size_t)g.a_pn_step * 2, khstep = (size_t)K * 2;
    const unsigned ldsw = (unsigned)wid * 1024u;
    const int aoff = lds_byte(wr * 64 + fr, fq * 8), boff = lds_byte(wc * 32 + fr, fq * 8);
#define PG8_SA(b, h) (((b) * 2 + (h)) * HTB)
#define PG8_SB(b, h) ((4 + (b) * 2 + (h)) * HTB)
#define PG8_STAGE(bufoff, gbase, voff) do { _Pragma("unroll") for (int _i = 0; _i < 2; ++_i) \
        __builtin_amdgcn_global_load_lds((const unsigned*)((const char*)(gbase) + (voff)[_i]), (PG8_LAS unsigned*)(lds + (bufoff) + ldsw + _i * 8192), 16, 0, 0); } while (0)
#define PG8_LDA(dst, b, h) do { _Pragma("unroll") for (int m = 0; m < 4; ++m) _Pragma("unroll") for (int k = 0; k < 2; ++k) dst[m][k] = *(const PG8_LAS bf16x8*)(lds + PG8_SA(b, h) + aoff + m * 2048 + k * 1024); } while (0)
#define PG8_LDB(dst, b, h) do { _Pragma("unroll") for (int n = 0; n < 2; ++n) _Pragma("unroll") for (int k = 0; k < 2; ++k) dst[n][k] = *(const PG8_LAS bf16x8*)(lds + PG8_SB(b, h) + boff + n * 2048 + k * 1024); } while (0)
#define PG8_MMA(ai, bj, At, Bt) do { __builtin_amdgcn_s_setprio(1); _Pragma("unroll") for (int m = 0; m < 4; ++m) _Pragma("unroll") for (int n = 0; n < 2; ++n) _Pragma("unroll") for (int k = 0; k < 2; ++k) \
        acc[ai][bj][m][n] = __builtin_amdgcn_mfma_f32_16x16x32_bf16(Bt[n][k], At[m][k], acc[ai][bj][m][n], 0, 0, 0); __builtin_amdgcn_s_setprio(0); } while (0)
#define PG8_WAIT_V(n) asm volatile("s_waitcnt vmcnt(" #n ")" ::: "memory")
#define PG8_WAIT_L(n) asm volatile("s_waitcnt lgkmcnt(" #n ")" ::: "memory")
#define PG8_BAR __builtin_amdgcn_s_barrier()
#define PG8_SCHED __builtin_amdgcn_sched_barrier(0)
    Unit cur, nxt; int ui = 0;
    if (!S.next(0, cur)) return;
    f32x4 acc[2][2][4][2];
#pragma unroll
    for (int a = 0; a < 2; ++a)
#pragma unroll
        for (int b = 0; b < 2; ++b)
#pragma unroll
            for (int m = 0; m < 4; ++m)
#pragma unroll
                for (int n = 0; n < 2; ++n) acc[a][b][m][n] = (f32x4){0.f, 0.f, 0.f, 0.f};
    bf16x8 At[4][2], B0[2][2], B1[2][2];
    const char* cA = (const char*)g.A + (size_t)cur.pm * tstepA + (size_t)cur.pn * pnstepA + (size_t)cur.kh * khstep; const char* cB = (const char*)g.Bt + (size_t)cur.pn * tstepB + (size_t)cur.kh * khstep;
    S.a_ready(cur);
    if constexpr (SP2) {
        PG8_STAGE(PG8_SB(0, 0), cB, voffB); PG8_STAGE(PG8_SB(0, 1), cB + hstepB, voffB); PG8_STAGE(PG8_SA(0, 0), cA, voffA); PG8_STAGE(PG8_SA(0, 1), cA + hstepA, voffA);
        if (wr == 1) PG8_BAR;
        PG8_WAIT_V(2); PG8_BAR;
        PG8_STAGE(PG8_SB(1, 0), cB + kstep, voffB); PG8_STAGE(PG8_SA(1, 0), cA + kstep, voffA); PG8_STAGE(PG8_SB(1, 1), cB + hstepB + kstep, voffB);
        PG8_WAIT_V(6); PG8_BAR;
    } else {
        PG8_STAGE(PG8_SB(0, 0), cB, voffB); PG8_STAGE(PG8_SA(0, 0), cA, voffA); PG8_STAGE(PG8_SB(0, 1), cB + hstepB, voffB); PG8_STAGE(PG8_SA(0, 1), cA + hstepA, voffA);
        if (wr == 1) PG8_BAR;
        PG8_WAIT_V(4); PG8_BAR;
        PG8_STAGE(PG8_SB(1, 0), cB + kstep, voffB); PG8_STAGE(PG8_SA(1, 0), cA + kstep, voffA); PG8_STAGE(PG8_SB(1, 1), cB + hstepB + kstep, voffB);
        PG8_WAIT_V(6); PG8_BAR;
    }
    for (;;) {
        const bool has_next = S.next(ui + 1, nxt);
        const char* nA = has_next ? (const char*)g.A + (size_t)nxt.pm * tstepA + (size_t)nxt.pn * pnstepA + (size_t)nxt.kh * khstep : cA; const char* nB = has_next ? (const char*)g.Bt + (size_t)nxt.pn * tstepB + (size_t)nxt.kh * khstep : cB;
        for (int t = 0; t < nt; t += 2) {
            const bool last = (t == nt - 2);
            const char* a1 = cA + (size_t)(t + 1) * kstep;
            const char* a2 = last ? nA : cA + (size_t)(t + 2) * kstep; const char* b2 = last ? nB : cB + (size_t)(t + 2) * kstep;
            const char* a3 = a2 + kstep; const char* b3 = b2 + kstep;
            if (last && has_next) S.a_ready(nxt);
            if constexpr (SP2) {
            PG8_LDB(B0, 0, 0); PG8_LDB(B1, 0, 1); PG8_SCHED; PG8_LDA(At, 0, 0); PG8_STAGE(PG8_SA(1, 1), a1 + hstepA, voffA);
            PG8_WAIT_V(8); PG8_WAIT_L(0); PG8_BAR; PG8_MMA(0, 0, At, B0); PG8_MMA(0, 1, At, B1); PG8_BAR; PG8_SCHED;
            PG8_LDA(At, 0, 1); PG8_STAGE(PG8_SB(0, 0), b2, voffB); PG8_STAGE(PG8_SB(0, 1), b2 + hstepB, voffB); PG8_STAGE(PG8_SA(0, 0), a2, voffA);
            PG8_WAIT_V(8); PG8_WAIT_L(0); PG8_BAR; PG8_MMA(1, 0, At, B0); PG8_MMA(1, 1, At, B1); PG8_BAR; PG8_SCHED;
            PG8_LDB(B0, 1, 0); PG8_LDB(B1, 1, 1); PG8_SCHED; PG8_LDA(At, 1, 0); PG8_STAGE(PG8_SA(0, 1), a2 + hstepA, voffA);
            PG8_WAIT_V(8); PG8_WAIT_L(0); PG8_BAR; PG8_MMA(0, 0, At, B0); PG8_MMA(0, 1, At, B1); PG8_BAR; PG8_SCHED;
            PG8_LDA(At, 1, 1); PG8_STAGE(PG8_SB(1, 0), b3, voffB); PG8_STAGE(PG8_SB(1, 1), b3 + hstepB, voffB); PG8_STAGE(PG8_SA(1, 0), a3, voffA);
            PG8_WAIT_V(8); PG8_WAIT_L(0); PG8_BAR; PG8_MMA(1, 0, At, B0); PG8_MMA(1, 1, At, B1); PG8_BAR; PG8_SCHED;
            } else {
            PG8_LDB(B0, 0, 0); PG8_SCHED; PG8_LDA(At, 0, 0); PG8_STAGE(PG8_SA(1, 1), a1 + hstepA, voffA);
            PG8_WAIT_L(8); PG8_BAR; PG8_WAIT_L(0); PG8_MMA(0, 0, At, B0); PG8_BAR; PG8_SCHED;
            PG8_LDB(B1, 0, 1); PG8_STAGE(PG8_SB(0, 0), b2, voffB);
            PG8_BAR; PG8_WAIT_L(0); PG8_MMA(0, 1, At, B1); PG8_BAR;
            PG8_LDA(At, 0, 1); PG8_STAGE(PG8_SA(0, 0), a2, voffA);
            PG8_BAR; PG8_WAIT_L(0); PG8_MMA(1, 0, At, B0); PG8_BAR; PG8_SCHED;
            PG8_STAGE(PG8_SB(0, 1), b2 + hstepB, voffB);
            PG8_WAIT_V(6); PG8_BAR; PG8_MMA(1, 1, At, B1); PG8_BAR;
            PG8_LDB(B0, 1, 0); PG8_SCHED; PG8_LDA(At, 1, 0); PG8_STAGE(PG8_SA(0, 1), a2 + hstepA, voffA);
            PG8_WAIT_L(8); PG8_BAR; PG8_WAIT_L(0); PG8_MMA(0, 0, At, B0); PG8_BAR; PG8_SCHED;
            PG8_LDB(B1, 1, 1); PG8_STAGE(PG8_SB(1, 0), b3, voffB);
            PG8_BAR; PG8_WAIT_L(0); PG8_MMA(0, 1, At, B1); PG8_BAR;
            PG8_LDA(At, 1, 1); PG8_STAGE(PG8_SA(1, 0), a3, voffA);
            PG8_BAR; PG8_WAIT_L(0); PG8_MMA(1, 0, At, B0); PG8_BAR; PG8_SCHED;
            PG8_STAGE(PG8_SB(1, 1), b3 + hstepB, voffB);
            PG8_WAIT_V(6); PG8_BAR; PG8_MMA(1, 1, At, B1); PG8_BAR;
            }
        }
        if constexpr (ALIGN_EPI) { if (wr == 0) PG8_BAR; }
        if constexpr (!Epi::AFTER_DRAIN) { E(acc, cur, wr, wc, fr, fq); S.done(cur); }
        if (!has_next) break;
#pragma unroll
        for (int a = 0; a < 2; ++a)
#pragma unroll
            for (int b = 0; b < 2; ++b)
#pragma unroll
                for (int m = 0; m < 4; ++m)
#pragma unroll
                    for (int n = 0; n < 2; ++n) acc[a][b][m][n] = (f32x4){0.f, 0.f, 0.f, 0.f};
        cur = nxt; cA = nA; cB = nB; ++ui;
        if constexpr (ALIGN_EPI) { if (wr == 1) PG8_BAR; }
    }
    PG8_WAIT_V(0);
    if constexpr (!ALIGN_EPI) { if (wr == 0) PG8_BAR; }
    PG8_BAR;
    if constexpr (Epi::AFTER_DRAIN) { E.fused(acc, cur, wr, wc, fr, fq, lds, wid, lane); S.done(cur); }
#undef PG8_SA
#undef PG8_SB
#undef PG8_STAGE
#undef PG8_LDA
#undef PG8_LDB
#undef PG8_MMA
#undef PG8_WAIT_V
#undef PG8_WAIT_L
#undef PG8_BAR
#undef PG8_SCHED
}
}
#endif

enum { I_XP, I_XS, I_CGK, I_CGV, I_CDK, I_CDV, I_CWK, I_CWV, I_C, I_CCTX, I_N1G, I_N2G, I_WMOD, I_BMOD, I_FWIN, I_FCW, I_FCB, I_FWOUT,
       I_POOLW, I_POOLS, I_GQKV, I_GQN, I_GKN, I_GWO, I_DQKV, I_DQN, I_DKN, I_DLQ1, I_DLK1, I_DLQ2, I_DLK2, I_DSUB, I_DWO,
       I_WQKV, I_WQN, I_WKN, I_WSINK, I_WWO, N_IN };
struct Params { const float* in[N_IN]; float* out; unsigned char* ws; };
#ifdef HOST_EMU
static inline const float* pin(const Params& P, int i) { return P.in[i]; }
#else
__device__ __forceinline__ const float* pin(const Params& P, int i) { asm volatile("" : "+s"(i)); return P.in[i]; }
#endif

constexpr size_t MiB = (size_t)1 << 20;
constexpr size_t WS_CTL = 1 * MiB + 576 * 1024, CTL_ZERO_BYTES = 16384;
constexpr size_t WS_EDGE = 1 * MiB + 640 * 1024;
constexpr size_t WS_MOD = 0, WS_RSTD = 1 * MiB, WS_ROPE = 1 * MiB + 256 * 1024;
constexpr size_t WS_WIN = 3 * MiB;
constexpr size_t WS_WOUT = WS_WIN + (size_t)4 * DFF2 * D * 2;
constexpr size_t WS_GQKV = WS_WOUT + (size_t)4 * D * DFF * 2;
constexpr size_t WS_GWO = WS_GQKV + (size_t)1536 * D * 2, WS_DQKV = WS_GWO + (size_t)D * D * 2, WS_DWO = WS_DQKV + (size_t)3072 * D * 2;
constexpr size_t WS_WQKV = WS_DWO + (size_t)D * D * 2, WS_WWO = WS_WQKV + (size_t)1536 * D * 2, WS_POOL = WS_WWO + (size_t)D * D * 2;
constexpr size_t WS_HB = WS_POOL + (size_t)1024 * 256 * 2;
constexpr size_t WS_UB = WS_HB + (size_t)T * D * 2;
constexpr size_t WS_QKV = WS_UB, WS_OB = WS_QKV + (size_t)T * 3072 * 2, WS_PD = WS_QKV;
constexpr size_t UB_BYTES = ((size_t)T * DFF2 * 2 > (size_t)T * 4096 * 2) ? (size_t)T * DFF2 * 2 : (size_t)T * 4096 * 2;
constexpr size_t WS_GB = WS_UB + UB_BYTES;
constexpr size_t WS_SA = WS_GB + (size_t)T * DFF * 2, WS_SB = WS_SA + (size_t)T * D * 4;
constexpr size_t WS_END = WS_SB + (size_t)T * D * 4;
static_assert(WS_END <= 256 * MiB, "d_ws map");

constexpr int STEPS_PER_LAYER = 13, N_PRE = 3, N_STEPS = N_PRE + 4 * STEPS_PER_LAYER;

struct Ctx {
  float* out_; unsigned char* ws_;
#ifdef HOST_EMU
  float* out_p() const { return out_; } unsigned char* ws_p() const { return ws_; }
#else
  __device__ __forceinline__ float* out_p() const { float* p = out_; asm volatile("" : "+s"(p)); return p; }
  __device__ __forceinline__ unsigned char* ws_p() const { unsigned char* p = ws_; asm volatile("" : "+s"(p)); return p; }
#endif
  __device__ __forceinline__ float* X() const { return out_p(); }
  __device__ __forceinline__ float* o_gk() const { return out_p() + (size_t)T * D; }
  __device__ __forceinline__ float* o_gv() const { return o_gk() + (size_t)TCTX * 256; }
  __device__ __forceinline__ float* o_dk() const { return o_gv() + (size_t)TCTX * 256; }
  __device__ __forceinline__ float* o_dv() const { return o_dk() + (size_t)TCTX * 1024; }
  __device__ __forceinline__ float* o_wk() const { return o_dv() + (size_t)TCTX * 1024; }
  __device__ __forceinline__ float* o_wv() const { return o_wk() + (size_t)TCTX * 256; }
  __device__ __forceinline__ float* MOD() const { return (float*)(ws_p() + WS_MOD); }
  __device__ __forceinline__ float* RSTD() const { return (float*)(ws_p() + WS_RSTD); }
  __device__ __forceinline__ float* ROPE() const { return (float*)(ws_p() + WS_ROPE); }
  __device__ __forceinline__ bf16_t* bf(size_t off) const { return (bf16_t*)(ws_p() + off); }
  __device__ __forceinline__ bf16_t* WinT() const { return bf(WS_WIN); }
  __device__ __forceinline__ bf16_t* WoutT() const { return bf(WS_WOUT); }
  __device__ __forceinline__ bf16_t* GqkvT() const { return bf(WS_GQKV); }
  __device__ __forceinline__ bf16_t* GwoT() const { return bf(WS_GWO); }
  __device__ __forceinline__ bf16_t* DqkvT() const { return bf(WS_DQKV); }
  __device__ __forceinline__ bf16_t* DwoT() const { return bf(WS_DWO); }
  __device__ __forceinline__ bf16_t* WqkvT() const { return bf(WS_WQKV); }
  __device__ __forceinline__ bf16_t* WwoT() const { return bf(WS_WWO); }
  __device__ __forceinline__ bf16_t* PoolT() const { return bf(WS_POOL); }
  __device__ __forceinline__ bf16_t* Hb() const { return bf(WS_HB); }
  __device__ __forceinline__ bf16_t* Ub() const { return bf(WS_UB); }
  __device__ __forceinline__ bf16_t* QKVb() const { return bf(WS_QKV); }
  __device__ __forceinline__ bf16_t* Ob() const { return bf(WS_OB); }
  __device__ __forceinline__ bf16_t* PDb() const { return bf(WS_PD); }
  __device__ __forceinline__ bf16_t* Gb() const { return bf(WS_GB); }
};
__device__ __forceinline__ Ctx make_ctx(const Params& P) { Ctx c; c.out_ = P.out; c.ws_ = P.ws; return c; }

#ifndef KSPLIT
#define KSPLIT 2
#endif
struct GemmDesc { const bf16_t* A; int lda, a_pn_step; const bf16_t* Bt; int ldb, N, K; bool res; bf16_t* C; int ldc; int gate_chunk; const float* colscale; int ksplit; };
__device__ __forceinline__ bool gemm_desc(int step, const Params& P, const Ctx& c, GemmDesc& g) {
  if (step < N_PRE) return false;
  const int l = (step - N_PRE) / STEPS_PER_LAYER, s = (step - N_PRE) % STEPS_PER_LAYER;
  g.a_pn_step = 0; g.colscale = nullptr; g.C = nullptr; g.ldc = 0; g.gate_chunk = 0; g.res = false; g.ksplit = 1;
  if (s == 2 && l != 0) { const int N = (l == 2) ? 3072 : 1536; g.A = c.Hb(); g.lda = D; g.Bt = c.bf(l == 1 ? WS_GQKV : (l == 2 ? WS_DQKV : WS_WQKV)); g.ldb = D; g.N = N; g.K = D; g.C = c.QKVb(); g.ldc = N; return true; }
  if (s == 7) {
    g.res = true; g.gate_chunk = 2;
    if (l == 0) { g.A = c.PDb(); g.lda = D; g.a_pn_step = 256; g.Bt = c.PoolT(); g.ldb = 256; g.N = D; g.K = 256; g.colscale = pin(P, I_POOLS); }
    else { g.A = c.Ob(); g.lda = D; g.Bt = c.bf(l == 1 ? WS_GWO : (l == 2 ? WS_DWO : WS_WWO)); g.ldb = D; g.N = D; g.K = D; g.ksplit = KSPLIT; }
    return true;
  }
  if (s == 10) { g.A = c.Hb(); g.lda = D; g.Bt = c.WinT() + (size_t)l * DFF2 * D; g.ldb = D; g.N = DFF2; g.K = D; g.C = c.Ub(); g.ldc = DFF2; return true; }
  if (s == 12) { g.res = true; g.gate_chunk = 5; g.A = c.Gb(); g.lda = DFF; g.Bt = c.WoutT() + (size_t)l * D * DFF; g.ldb = DFF; g.N = D; g.K = DFF; g.ksplit = (DFF % 256 == 0) ? KSPLIT : 1; return true; }
  return false;
}

__device__ __forceinline__ void naive_step(int step, const Params& P, const Ctx& c) {
#define IN(i) (pin(P, (i)))
  if (step == 0) { nk_copy_x(IN(I_XP), IN(I_XS), c.X()); return; }
  if (step == 1) { nk_mod(IN(I_C), IN(I_CCTX), IN(I_WMOD), IN(I_BMOD), c.MOD(), 4); nk_rope_table(c.ROPE()); return; }
  if (step == 2) {
    for (int l = 0; l < 4; ++l) { nk_wt(IN(I_FWIN) + (size_t)l * D * DFF2, D, DFF2, c.WinT() + (size_t)l * DFF2 * D); nk_wt(IN(I_FWOUT) + (size_t)l * DFF * D, DFF, D, c.WoutT() + (size_t)l * D * DFF); }
    nk_wt(IN(I_GQKV), D, 1536, c.GqkvT()); nk_wt(IN(I_GWO), D, D, c.GwoT()); nk_wt(IN(I_DQKV), D, 3072, c.DqkvT()); nk_wt(IN(I_DWO), D, D, c.DwoT());
    nk_wt(IN(I_WQKV), D, 1536, c.WqkvT()); nk_wt(IN(I_WWO), D, D, c.WwoT());
    for (int g = 0; g < 4; ++g) nk_wt(IN(I_POOLW) + g * 256 * 256, 256, 256, c.PoolT() + g * 256 * 256);
    return;
  }
  const int l = (step - N_PRE) / STEPS_PER_LAYER, s = (step - N_PRE) % STEPS_PER_LAYER;
  const float* MODl = c.MOD() + (long)l * NCOND * MODW;
  const bool gq = (l == 1 || l == 3);
  const float* qn = IN(l == 1 ? I_GQN : I_WQN); const float* kn = IN(l == 1 ? I_GKN : I_WKN);
  const float* ck = IN(l == 1 ? I_CGK : I_CWK); const float* cv = IN(l == 1 ? I_CGV : I_CWV);
  const float lam_init = 0.8f - 0.6f * expf(-0.3f * (float)l);
  GemmDesc g;
  if (gemm_desc(step, P, c, g)) {
    if (g.res) nk_gemm_res(g.A, g.lda, g.a_pn_step, g.Bt, g.ldb, c.X(), T, g.N, g.K, MODl, g.gate_chunk, g.colscale);
    else nk_gemm_bf(g.A, g.lda, g.Bt, g.ldb, g.C, g.ldc, T, g.N, g.K);
    return;
  }
  switch (s) {
    case 0: nk_rstd(c.X(), c.RSTD()); break;
    case 1: nk_normmod(c.X(), c.RSTD(), IN(I_N1G) + l * D, MODl, 0, 1, c.Hb()); break;
    case 2: if (l == 0) nk_pool(c.Hb(), c.PDb()); break;
    case 3:
      if (l == 0) break;
      if (gq) { nk_qknorm_rope(c.QKVb(), 1536, 16, 4, 1024, qn, kn, l == 1 ? c.o_gk() : c.o_wk()); nk_copy_cols_f(c.QKVb(), 1536, 1280, 256, TCTX, l == 1 ? c.o_gv() : c.o_wv()); }
      else { nk_qknorm_rope(c.QKVb(), 3072, 16, 16, 1024, IN(I_DQN), IN(I_DKN), c.o_dk()); nk_copy_cols_f(c.QKVb(), 3072, 2048, 1024, TCTX, c.o_dv()); }
      break;
    case 5:
      if (l == 0) break;
      if (l == 1) nk_attn<0>(c.QKVb(), 1536, 1024, 1280, ck, cv, 256, nullptr, nullptr, nullptr, nullptr, nullptr, 0.f, c.Ob());
      else if (l == 3) nk_attn<1>(c.QKVb(), 1536, 1024, 1280, ck, cv, 256, IN(I_WSINK), nullptr, nullptr, nullptr, nullptr, 0.f, c.Ob());
      else nk_attn<2>(c.QKVb(), 3072, 1024, 2048, IN(I_CDK), IN(I_CDV), 1024, nullptr, IN(I_DLQ1), IN(I_DLK1), IN(I_DLQ2), IN(I_DLK2), lam_init, c.Ob());
      break;
    case 6: if (l == 2) nk_subnorm(c.Ob(), IN(I_DSUB), 1.0f - lam_init); break;
    case 8: nk_rstd(c.X(), c.RSTD()); break;
    case 9: nk_normmod(c.X(), c.RSTD(), IN(I_N2G) + l * D, MODl, 3, 4, c.Hb()); break;
    case 11: nk_convgate(c.Ub(), IN(I_FCW) + (long)l * 3 * DFF2, IN(I_FCB) + (long)l * DFF2, c.Gb()); break;
    default: break;
  }
#undef IN
}
__device__ __forceinline__ bool step_is_noop(int step) {
  if (step < N_PRE) return false;
  const int l = (step - N_PRE) / STEPS_PER_LAYER, s = (step - N_PRE) % STEPS_PER_LAYER;
  if (s == 4) return true;
  if (l == 0 && (s == 3 || s == 5)) return true;
  if (l != 2 && s == 6) return true;
  return false;
}


#ifndef HOST_EMU
#define LAS __attribute__((address_space(3)))
typedef float f32x4 __attribute__((ext_vector_type(4)));
typedef float f32x2 __attribute__((ext_vector_type(2)));
typedef unsigned u32x4 __attribute__((ext_vector_type(4)));
typedef unsigned u32x2 __attribute__((ext_vector_type(2)));
typedef __bf16 bf16x2_t __attribute__((ext_vector_type(2)));
__device__ __forceinline__ unsigned pk_bf16(float lo, float hi) { f32x2 v = {lo, hi}; bf16x2_t b = __builtin_convertvector(v, bf16x2_t); return __builtin_bit_cast(unsigned, b); }
__device__ __forceinline__ float bf_lo(unsigned u) { return __uint_as_float(u << 16); }
__device__ __forceinline__ float bf_hi(unsigned u) { return __uint_as_float(u & 0xffff0000u); }
__device__ __forceinline__ int opaque_i(int v) { asm volatile("" : "+v"(v)); return v; }
__device__ __forceinline__ int opaque_block() { int b = (int)blockIdx.x; asm volatile("" : "+s"(b)); return b; }
__device__ __forceinline__ float shx(float v, int mask, int lane) { return __int_as_float(__builtin_amdgcn_ds_bpermute((lane ^ mask) << 2, __float_as_int(v))); }
__device__ __forceinline__ float wave_sum(float v, int lane) {
#pragma unroll
  for (int o = 1; o < 64; o <<= 1) v += shx(v, o, lane);
  return v;
}
struct WaveId { int lane, wave, gw, ngw; };
__device__ __forceinline__ WaveId wave_id() { WaveId w; const int tid = opaque_i((int)threadIdx.x); w.lane = tid & 63; w.wave = __builtin_amdgcn_readfirstlane(tid >> 6); w.gw = opaque_block() * 8 + w.wave; w.ngw = (int)gridDim.x * 8; return w; }

__device__ __forceinline__ void ph_norm(const float* Xc, const float* Xl, const bf16_t* pend, const float* g, const float* MODl, int sh_chunk, int sc_chunk, bf16_t* Hb) {
  const WaveId w = wave_id();
  constexpr int NR = 3;
  for (int t0 = w.gw; t0 < T; t0 += NR * w.ngw) {
    f32x4 v[NR][4]; u32x2 q[NR][4];
#pragma unroll
    for (int r = 0; r < NR; ++r) { const int t = t0 + r * w.ngw; if (t < T) {
        const f32x4* xr = (const f32x4*)((t < TCTX ? Xc : Xl) + (size_t)t * D) + w.lane;
#pragma unroll
        for (int j = 0; j < 4; ++j) { v[r][j] = xr[64 * j]; if (pend) q[r][j] = ((const u32x2*)(pend + (size_t)t * D) + w.lane)[64 * j]; } } }
#pragma unroll
    for (int r = 0; r < NR; ++r) { const int t = t0 + r * w.ngw; if (t < T) {
        float ss = 0.f;
#pragma unroll
        for (int j = 0; j < 4; ++j) { if (pend) v[r][j] = v[r][j] + (f32x4){bf_lo(q[r][j].x), bf_hi(q[r][j].x), bf_lo(q[r][j].y), bf_hi(q[r][j].y)};
          ss += (v[r][j].x * v[r][j].x + v[r][j].y * v[r][j].y) + (v[r][j].z * v[r][j].z + v[r][j].w * v[r][j].w); }
        const float rstd = 1.0f / sqrtf(wave_sum(ss, w.lane) / (float)D + EPS);
        const float* m = MODl + (size_t)tok_cond(t) * MODW;
        u32x2* o = (u32x2*)(Hb + (size_t)t * D) + w.lane;
#pragma unroll
        for (int j = 0; j < 4; ++j) {
          const int col = 4 * w.lane + 256 * j;
          const f32x4 gg = *(const f32x4*)(g + col), sc = *(const f32x4*)(m + sc_chunk * D + col), sh = *(const f32x4*)(m + sh_chunk * D + col);
          const f32x4 y = v[r][j] * rstd * gg * (1.0f + sc) + sh;
          u32x2 pk; pk.x = pk_bf16(y.x, y.y); pk.y = pk_bf16(y.z, y.w); o[64 * j] = pk;
        } } }
  }
}

__device__ __forceinline__ void unpack8(const u32x4 r, float (&x)[8]) { x[0] = bf_lo(r.x); x[1] = bf_hi(r.x); x[2] = bf_lo(r.y); x[3] = bf_hi(r.y); x[4] = bf_lo(r.z); x[5] = bf_hi(r.z); x[6] = bf_lo(r.w); x[7] = bf_hi(r.w); }
__device__ __forceinline__ u32x4 pack8(const float (&y)[8]) { u32x4 r; r.x = pk_bf16(y[0], y[1]); r.y = pk_bf16(y[2], y[3]); r.z = pk_bf16(y[4], y[5]); r.w = pk_bf16(y[6], y[7]); return r; }

__device__ __forceinline__ void ph_pool(const bf16_t* Hb, bf16_t* PDb) {
  const int tid0 = (opaque_block() * 512 + opaque_i((int)threadIdx.x)), nth = (int)(gridDim.x * blockDim.x);
  for (int i = tid0; i < T * 128; i += nth) {
    const int t = i >> 7, c8 = i & 127, g = c8 >> 5, wdw = 2 << g; int s0, L; tok_seq(t, s0, L);
    const int pos = t - s0; int lo = pos - wdw / 2, hi = pos - wdw / 2 + wdw; lo = lo < 0 ? 0 : lo; hi = hi > L ? L : hi;
    float acc[8], x[8];
#pragma unroll
    for (int e = 0; e < 8; ++e) acc[e] = 0.f;
    for (int j = lo; j < hi; ++j) { unpack8(*(const u32x4*)(Hb + (size_t)(s0 + j) * D + 8 * c8), x);
#pragma unroll
      for (int e = 0; e < 8; ++e) acc[e] += x[e]; }
    unpack8(*(const u32x4*)(Hb + (size_t)t * D + 8 * c8), x);
    const float cnt = (float)(hi - lo); float y[8];
#pragma unroll
    for (int e = 0; e < 8; ++e) y[e] = acc[e] / cnt - x[e];
    *(u32x4*)(PDb + (size_t)t * D + 8 * c8) = pack8(y);
  }
}

__device__ __forceinline__ void ph_qkpost(bf16_t* QKV, int ld, int nq, int nk, int nv, int kcol0, int vcol0, const float* qn, const float* kn, const float* rope, float* kout, float* vout) {
  const WaveId w = wave_id(); const int NG = (nq + nk + nv) >> 3, sl = w.lane >> 3, j = w.lane & 7;
  for (int it = w.gw; it < T * NG; it += w.ngw) {
    const int t = it / NG, sg = it - t * NG, slot = sg * 8 + sl; const bool lat = t >= TCTX;
    const int kind = slot < nq ? 0 : (slot < nq + nk ? 1 : 2);
    const int col = kind == 0 ? slot * 64 : (kind == 1 ? kcol0 + (slot - nq) * 64 : vcol0 + (slot - nq - nk) * 64);
    bf16_t* p = QKV + (size_t)t * ld + col + 8 * j;
    float x[8], y[8]; unpack8(*(const u32x4*)p, x);
    float ss = 0.f;
#pragma unroll
    for (int e = 0; e < 8; ++e) ss += x[e] * x[e];
    ss += shx(ss, 1, w.lane); ss += shx(ss, 2, w.lane); ss += shx(ss, 4, w.lane);
    const float r = 1.0f / sqrtf(ss / 64.0f + EPS);
    const float* wp = (kind == 1 ? kn : qn) + 8 * j; const f32x4 w0 = *(const f32x4*)wp, w1 = *(const f32x4*)(wp + 4);
    y[0] = x[0] * r * w0.x; y[1] = x[1] * r * w0.y; y[2] = x[2] * r * w0.z; y[3] = x[3] * r * w0.w;
    y[4] = x[4] * r * w1.x; y[5] = x[5] * r * w1.y; y[6] = x[6] * r * w1.z; y[7] = x[7] * r * w1.w;
    if (lat) {
      const int pos = (t - TCTX) % DEC_SEQ, a = j >> 2; const f32x4* tb = (const f32x4*)(rope + ((size_t)(pos * 2 + a) * 16 + 8 * (j & 1)) * 2);
      const bool x2side = (j & 2) != 0;
#pragma unroll
      for (int e2 = 0; e2 < 4; ++e2) { const f32x4 cs = tb[e2];
        const float p0 = shx(y[2 * e2], 2, w.lane), p1 = shx(y[2 * e2 + 1], 2, w.lane);
        y[2 * e2] = x2side ? y[2 * e2] * cs.x + p0 * cs.y : y[2 * e2] * cs.x - p0 * cs.y;
        y[2 * e2 + 1] = x2side ? y[2 * e2 + 1] * cs.z + p1 * cs.w : y[2 * e2 + 1] * cs.z - p1 * cs.w; }
    }
    if (kind != 2) *(u32x4*)p = pack8(y);
    if (!lat) {
      if (kind == 1) { float* o = kout + (size_t)t * (nk * 64) + (slot - nq) * 64 + 8 * j; *(f32x4*)o = (f32x4){y[0], y[1], y[2], y[3]}; *(f32x4*)(o + 4) = (f32x4){y[4], y[5], y[6], y[7]}; }
      if (kind == 2) { float* o = vout + (size_t)t * (nv * 64) + (slot - nq - nk) * 64 + 8 * j; *(f32x4*)o = (f32x4){x[0], x[1], x[2], x[3]}; *(f32x4*)(o + 4) = (f32x4){x[4], x[5], x[6], x[7]}; }
    }
  }
}

__device__ __forceinline__ void ph_convgate(const bf16_t* U, const float* cw, const float* cb, bf16_t* G) {
  constexpr int NCG = DFF / 8, RC = 8;
  const int tid0 = (opaque_block() * 512 + opaque_i((int)threadIdx.x)), nth = (int)(gridDim.x * blockDim.x);
  for (int i = tid0; i < (T / RC) * NCG; i += nth) {
    const int rc = i / NCG, cg = i - rc * NCG, r0 = rc * RC; int s0, L; tok_seq(r0, s0, L); const int pos0 = r0 - s0;
    const bool has_prev = pos0 > 0, has_next = pos0 + RC < L;
    u32x4 raw[2][RC + 2];
#pragma unroll
    for (int hf = 0; hf < 2; ++hf) {
      const bf16_t* base = U + (size_t)r0 * DFF2 + hf * DFF + 8 * cg;
      raw[hf][0] = *(const u32x4*)(has_prev ? base - DFF2 : base);
#pragma unroll
      for (int k = 0; k < RC; ++k) raw[hf][k + 1] = *(const u32x4*)(base + (size_t)k * DFF2);
      raw[hf][RC + 1] = *(const u32x4*)(has_next ? base + (size_t)RC * DFF2 : base);
    }
    float w0[2][8], w1[2][8], w2[2][8], bb[2][8];
#pragma unroll
    for (int hf = 0; hf < 2; ++hf) { const int col = hf * DFF + 8 * cg;
#pragma unroll
      for (int e = 0; e < 8; e += 4) { const f32x4 a0 = *(const f32x4*)(cw + col + e), a1 = *(const f32x4*)(cw + DFF2 + col + e), a2 = *(const f32x4*)(cw + 2 * DFF2 + col + e), a3 = *(const f32x4*)(cb + col + e);
#pragma unroll
        for (int q = 0; q < 4; ++q) { w0[hf][e + q] = a0[q]; w1[hf][e + q] = a1[q]; w2[hf][e + q] = a2[q]; bb[hf][e + q] = a3[q]; } } }
    if (!has_prev) { raw[0][0] = (u32x4){0u, 0u, 0u, 0u}; raw[1][0] = (u32x4){0u, 0u, 0u, 0u}; }
    if (!has_next) { raw[0][RC + 1] = (u32x4){0u, 0u, 0u, 0u}; raw[1][RC + 1] = (u32x4){0u, 0u, 0u, 0u}; }
    float up[2][8], uc[2][8], un[2][8];
    unpack8(raw[0][0], up[0]); unpack8(raw[1][0], up[1]); unpack8(raw[0][1], uc[0]); unpack8(raw[1][1], uc[1]);
#pragma unroll
    for (int r = 0; r < RC; ++r) {
      unpack8(raw[0][r + 2], un[0]); unpack8(raw[1][r + 2], un[1]);
      float y[8];
#pragma unroll
      for (int e = 0; e < 8; ++e) {
        const float a = uc[0][e] * w1[0][e] + bb[0][e] + up[0][e] * w0[0][e] + un[0][e] * w2[0][e];
        const float b = uc[1][e] * w1[1][e] + bb[1][e] + up[1][e] * w0[1][e] + un[1][e] * w2[1][e];
        y[e] = a / (1.0f + __expf(-a)) * b;
      }
      *(u32x4*)(G + (size_t)(r0 + r) * DFF + 8 * cg) = pack8(y);
#pragma unroll
      for (int hf = 0; hf < 2; ++hf)
#pragma unroll
        for (int e = 0; e < 8; ++e) { up[hf][e] = uc[hf][e]; uc[hf][e] = un[hf][e]; }
    }
  }
}


__device__ __forceinline__ void ph_conv_fixup(const float* edgebuf, const float* cw, const float* cb, bf16_t* G) {
  const int tid0 = (opaque_block() * 512 + opaque_i((int)threadIdx.x)), nth = (int)(gridDim.x * blockDim.x);
  for (int i = tid0; i < 6 * DFF; i += nth) {
    const int sm = i / DFF, f = i - sm * DFF, tu = (sm / 3) * 4 + (sm % 3), pn = f >> 7, cc = f & 127;
    const float* eu = edgebuf + ((size_t)(tu * (DFF / 128) + pn) * 4) * 256 + cc; const float* el = edgebuf + ((size_t)((tu + 1) * (DFF / 128) + pn) * 4) * 256 + cc;
    float o[2][2];
#pragma unroll
    for (int bj = 0; bj < 2; ++bj) { const int col = bj * DFF + f; const float w0 = cw[col], w1 = cw[DFF2 + col], w2 = cw[2 * DFF2 + col], bb = cb[col];
      const float u254 = eu[2 * 256 + bj * 128], u255 = eu[3 * 256 + bj * 128], l0 = el[0 * 256 + bj * 128], l1 = el[1 * 256 + bj * 128];
      o[0][bj] = u255 * w1 + bb + u254 * w0 + l0 * w2; o[1][bj] = l0 * w1 + bb + u255 * w0 + l1 * w2; }
    const int rowU = TCTX + (tu + 1) * 256 - 1;
    G[(size_t)rowU * DFF + f] = (bf16_t)(pk_bf16(o[0][0] / (1.0f + __expf(-o[0][0])) * o[0][1], 0.f) & 0xffffu);
    G[(size_t)(rowU + 1) * DFF + f] = (bf16_t)(pk_bf16(o[1][0] / (1.0f + __expf(-o[1][0])) * o[1][1], 0.f) & 0xffffu);
  }
}

__device__ __forceinline__ void conv_fixup_unit(const float* edgebuf, const float* cw, const float* cb, bf16_t* G, int pm, int f0, int nf) {
  if (pm * 256 < TCTX) return;
  const int tl = pm - TCTX / 256, tid = opaque_i((int)threadIdx.x);
  const bool up = (tl & 3) != 0, dn = (tl & 3) != 3;
  for (int i = tid; i < nf; i += 512) {
    const int f = f0 + i, pn = f >> 7, cc = f & 127;
    const float* eo = edgebuf + ((size_t)(tl * (DFF / 128) + pn) * 4) * 256 + cc;
    float ga[2], gb[2];
#pragma unroll
    for (int bj = 0; bj < 2; ++bj) { const int col = bj * DFF + f; const float w0 = cw[col], w1 = cw[DFF2 + col], w2 = cw[2 * DFF2 + col], bb = cb[col];
      const float o0 = eo[0 * 256 + bj * 128], o1 = eo[1 * 256 + bj * 128], o254 = eo[2 * 256 + bj * 128], o255 = eo[3 * 256 + bj * 128];
      float pu = 0.f, nd = 0.f;
      if (up) pu = (eo - (size_t)(DFF / 128) * 4 * 256)[3 * 256 + bj * 128];
      if (dn) nd = (eo + (size_t)(DFF / 128) * 4 * 256)[0 * 256 + bj * 128];
      const float c0 = o0 * w1 + bb + pu * w0 + o1 * w2, c255 = o255 * w1 + bb + o254 * w0 + nd * w2;
      if (bj == 0) { ga[0] = c0; ga[1] = c255; } else { gb[0] = c0; gb[1] = c255; } }
    if (up) G[(size_t)(pm * 256) * DFF + f] = (bf16_t)(pk_bf16(ga[0] / (1.0f + __expf(-ga[0])) * gb[0], 0.f) & 0xffffu);
    if (dn) G[(size_t)(pm * 256 + 255) * DFF + f] = (bf16_t)(pk_bf16(ga[1] / (1.0f + __expf(-ga[1])) * gb[1], 0.f) & 0xffffu);
  }
}

__device__ __forceinline__ void win_subunit(const bf16_t* Hb, const bf16_t* WinT, const float* cw, const float* cb, bf16_t* G, float* edgebuf, LAS unsigned char* lds, int pm, int pn, int j) {
  typedef short bf16x8 __attribute__((ext_vector_type(8)));
  const int tid = opaque_i((int)threadIdx.x), lane = tid & 63, wave = tid >> 6, c = lane & 15, g = lane >> 4;
  const bf16_t* a0p = Hb + (size_t)(pm * 256 + 32 * wave + c) * D + 8 * g; const bf16_t* a1p = a0p + (size_t)16 * D;
  const bf16_t* bp = WinT + (size_t)(pn * 256 + (c < 8 ? 8 * j + c : 128 + 8 * j + (c - 8))) * D + 8 * g;
  f32x4 acc0 = (f32x4){0.f, 0.f, 0.f, 0.f}, acc1 = acc0;
#pragma unroll 8
  for (int ks = 0; ks < D / 32; ++ks) {
    const bf16x8 a0 = *(const bf16x8*)(a0p + 32 * ks), a1 = *(const bf16x8*)(a1p + 32 * ks), b = *(const bf16x8*)(bp + 32 * ks);
    acc0 = __builtin_amdgcn_mfma_f32_16x16x32_bf16(a0, b, acc0, 0, 0, 0); acc1 = __builtin_amdgcn_mfma_f32_16x16x32_bf16(a1, b, acc1, 0, 0, 0);
  }
  LAS float* U = (LAS float*)lds;
#pragma unroll
  for (int r = 0; r < 4; ++r) { U[(32 * wave + 4 * g + r) * 16 + c] = bf_lo(pk_bf16(acc0[r], 0.f)); U[(32 * wave + 16 + 4 * g + r) * 16 + c] = bf_lo(pk_bf16(acc1[r], 0.f)); }
  __syncthreads();
  const int row = tid >> 1, q4 = (tid & 1) * 4, gcol = pn * 128 + 8 * j + q4;
  float y[4], ua[4], ub[4];
#pragma unroll
  for (int e = 0; e < 4; ++e) {
    float cv[2];
#pragma unroll
    for (int bj = 0; bj < 2; ++bj) { const int col = bj * DFF + gcol + e, lc = bj * 8 + q4 + e;
      const float uc = U[row * 16 + lc], up = row > 0 ? U[(row - 1) * 16 + lc] : 0.f, un = row < 255 ? U[(row + 1) * 16 + lc] : 0.f;
      cv[bj] = uc * cw[DFF2 + col] + cb[col] + up * cw[col] + un * cw[2 * DFF2 + col]; if (bj == 0) ua[e] = uc; else ub[e] = uc; }
    y[e] = cv[0] / (1.0f + __expf(-cv[0])) * cv[1];
  }
  u32x2 o; o.x = pk_bf16(y[0], y[1]); o.y = pk_bf16(y[2], y[3]);
  *(u32x2*)(G + (size_t)(pm * 256 + row) * DFF + gcol) = o;
  if (pm * 256 >= TCTX && (row < 2 || row >= 254)) {
    float* eb = edgebuf + ((size_t)((pm - TCTX / 256) * (DFF / 128) + pn) * 4 + (row < 2 ? row : row - 252)) * 256 + 8 * j + q4;
    *(f32x4*)eb = (f32x4){ua[0], ua[1], ua[2], ua[3]}; *(f32x4*)(eb + 128) = (f32x4){ub[0], ub[1], ub[2], ub[3]};
  }
  __syncthreads();
}

__device__ __forceinline__ void transpose_item(const float* W, int K, int N, bf16_t* WT, LAS float* scr, int item, int lane, bool pair_ab = false) {
  const int nblk = N / 32, kb = item / nblk, nb = item % nblk, k0 = 64 * kb, n0 = 32 * nb;
  int r0 = n0; if (pair_ab) { const int half = n0 >= DFF ? 1 : 0, np = n0 - half * DFF; r0 = 256 * (np / 128) + 128 * half + np % 128; }
  { const int r8 = lane >> 3, c4 = lane & 7; f32x4 v[8];
#pragma unroll
    for (int i = 0; i < 8; ++i) v[i] = *(const f32x4*)(W + (size_t)(k0 + 8 * i + r8) * N + n0 + 4 * c4);
#pragma unroll
    for (int i = 0; i < 8; ++i) { LAS float* d = scr + (8 * i + r8) * 33 + 4 * c4; d[0] = v[i].x; d[1] = v[i].y; d[2] = v[i].z; d[3] = v[i].w; } }
  asm volatile("s_waitcnt lgkmcnt(0)" ::: "memory");
  const int c = lane & 7;
#pragma unroll
  for (int j = 0; j < 4; ++j) { const int n = (lane >> 3) + 8 * j; const LAS float* sp = scr + (8 * c) * 33 + n;
    u32x4 o; o.x = pk_bf16(sp[0 * 33], sp[1 * 33]); o.y = pk_bf16(sp[2 * 33], sp[3 * 33]); o.z = pk_bf16(sp[4 * 33], sp[5 * 33]); o.w = pk_bf16(sp[6 * 33], sp[7 * 33]);
    *(u32x4*)(WT + (size_t)(r0 + n) * K + k0 + 8 * c) = o; }
  asm volatile("s_waitcnt lgkmcnt(0)" ::: "memory");
}


constexpr int CI_IN = (D / 64) * (DFF2 / 32), CI_OUT = (DFF / 64) * (D / 32), CI_Q15 = (D / 64) * (1536 / 32), CI_Q30 = (D / 64) * (3072 / 32), CI_O = (D / 64) * (D / 32), CI_P = (256 / 64) * (256 / 32);
__device__ __forceinline__ constexpr int layer_items(int l) { return CI_IN + CI_OUT + (l == 0 ? 4 * CI_P : ((l == 2 ? CI_Q30 : CI_Q15) + CI_O)); }
__device__ __forceinline__ constexpr int bg_total_items() { return layer_items(1) + layer_items(2) + layer_items(3); }
__device__ __forceinline__ constexpr int bg_end_of_layer(int l) { return l <= 0 ? 0 : (l == 1 ? layer_items(1) : (l == 2 ? layer_items(1) + layer_items(2) : bg_total_items())); }
__device__ __forceinline__ void convert_item(const Params& P, const Ctx& c, LAS float* scr, int l, int r, int lane) {
  if (r < CI_IN) { transpose_item(pin(P, I_FWIN) + (size_t)l * D * DFF2, D, DFF2, c.WinT() + (size_t)l * DFF2 * D, scr, r, lane, FUSE_CONV != 0); return; } r -= CI_IN;
  if (r < CI_OUT) { transpose_item(pin(P, I_FWOUT) + (size_t)l * DFF * D, DFF, D, c.WoutT() + (size_t)l * D * DFF, scr, r, lane); return; } r -= CI_OUT;
  if (l == 0) { const int g = r / CI_P; transpose_item(pin(P, I_POOLW) + g * 256 * 256, 256, 256, c.PoolT() + g * 256 * 256, scr, r % CI_P, lane); return; }
  const int nq = l == 2 ? CI_Q30 : CI_Q15;
  if (r < nq) { transpose_item(pin(P, l == 1 ? I_GQKV : (l == 2 ? I_DQKV : I_WQKV)), D, l == 2 ? 3072 : 1536, c.bf(l == 1 ? WS_GQKV : (l == 2 ? WS_DQKV : WS_WQKV)), scr, r, lane); return; } r -= nq;
  transpose_item(pin(P, l == 1 ? I_GWO : (l == 2 ? I_DWO : I_WWO)), D, D, c.bf(l == 1 ? WS_GWO : (l == 2 ? WS_DWO : WS_WWO)), scr, r, lane);
}
__device__ __forceinline__ void bg_item(const Params& P, const Ctx& c, LAS float* scr, int q, int lane) {
  const int l = q < bg_end_of_layer(1) ? 1 : (q < bg_end_of_layer(2) ? 2 : 3);
  convert_item(P, c, scr, l, q - bg_end_of_layer(l - 1), lane);
}
__device__ __forceinline__ void bg_work(const Params& P, const Ctx& c, LAS unsigned char* lds, unsigned budget_ticks, int upto) {
  if (!BG_QUEUE) return;
  const WaveId w = wave_id(); LAS float* scr = (LAS float*)(lds + w.wave * 16384);
  unsigned* ctr = (unsigned*)(c.ws_p() + WS_CTL) + 3520;
  const unsigned long long t0 = __builtin_amdgcn_s_memrealtime();
  for (;;) {
    if (budget_ticks != 0xffffffffu && (unsigned)(__builtin_amdgcn_s_memrealtime() - t0) > budget_ticks) break;
    unsigned q = 0xffffffffu;
    if (w.lane == 0 && (int)__hip_atomic_load(ctr, __ATOMIC_RELAXED, __HIP_MEMORY_SCOPE_AGENT) < upto) q = __hip_atomic_fetch_add(ctr, 1u, __ATOMIC_RELAXED, __HIP_MEMORY_SCOPE_AGENT);
    q = (unsigned)__builtin_amdgcn_readfirstlane((int)q);
    if (q >= (unsigned)bg_total_items()) break;
    bg_item(P, c, scr, (int)q, w.lane);
  }
}

__device__ __forceinline__ void ph_prologue(const Params& P, const Ctx& c, LAS unsigned char* lds) {
  const WaveId w = wave_id(); const int tid = opaque_i((int)threadIdx.x);
  {
    LAS float* S = (LAS float*)lds;
    LAS float* red = (LAS float*)(lds + 12288);
    for (int i = tid; i < 3 * D; i += 512) { const int cd = i / D, k = i - cd * D; const float v = cd == 0 ? pin(P, I_CCTX)[k] : pin(P, I_C)[(cd - 1) * D + k]; S[i] = v / (1.0f + expf(-v)); }
    __syncthreads();
    for (int item = opaque_block(); item < 4 * 48; item += (int)gridDim.x) {
      const int l = item / 48, n0 = (item % 48) * 128, h = w.lane >> 5, n4 = w.lane & 31;
      const float* W = pin(P, I_WMOD) + (size_t)l * D * MODW + n0 + 4 * n4;
      f32x4 acc[3] = {{0.f, 0.f, 0.f, 0.f}, {0.f, 0.f, 0.f, 0.f}, {0.f, 0.f, 0.f, 0.f}};
#pragma unroll 8
      for (int i = 0; i < 64; ++i) { const int k = 128 * w.wave + 2 * i + h; const f32x4 wv = *(const f32x4*)(W + (size_t)k * MODW);
        acc[0] += S[k] * wv; acc[1] += S[D + k] * wv; acc[2] += S[2 * D + k] * wv; }
#pragma unroll
      for (int cd = 0; cd < 3; ++cd) { acc[cd].x += shx(acc[cd].x, 32, w.lane); acc[cd].y += shx(acc[cd].y, 32, w.lane); acc[cd].z += shx(acc[cd].z, 32, w.lane); acc[cd].w += shx(acc[cd].w, 32, w.lane); }
      if (h == 0) {
#pragma unroll
        for (int cd = 0; cd < 3; ++cd) *(LAS f32x4*)(red + (w.wave * 3 + cd) * 128 + 4 * n4) = acc[cd]; }
      __syncthreads();
      if (tid < 384) { const int cd = tid >> 7, nn = tid & 127; float sum = pin(P, I_BMOD)[(size_t)l * MODW + n0 + nn];
#pragma unroll
        for (int ww = 0; ww < 8; ++ww) sum += red[(ww * 3 + cd) * 128 + nn];
        c.MOD()[((size_t)l * NCOND + cd) * MODW + n0 + nn] = sum; }
      __syncthreads();
    }
  }
  for (int i = opaque_block() * 512 + tid; i < DEC_SEQ * 32; i += (int)gridDim.x * 512) {
    const int pos = i / 32, a = (i / 16) % 2, f = i % 16;
    const float inv = powf(10000.0f, -(float)(2 * f) / 32.0f), ang = (a == 0 ? (float)(pos / 64) : (float)(pos % 64)) * inv;
    c.ROPE()[2 * i] = cosf(ang); c.ROPE()[2 * i + 1] = sinf(ang);
  }
  __syncthreads();
  {
    LAS float* scr = (LAS float*)(lds + w.wave * 16384);
    const int nitems = BG_QUEUE ? layer_items(0) : layer_items(0) + bg_total_items();
    for (int it = w.gw; it < nitems; it += w.ngw) {
      if (it < layer_items(0)) convert_item(P, c, scr, 0, it, w.lane); else bg_item(P, c, scr, it - layer_items(0), w.lane);
    }
  }
  __syncthreads();
}
#endif


#ifndef HOST_EMU
namespace att {
typedef short bf16x8 __attribute__((ext_vector_type(8)));
typedef short s16x4 __attribute__((ext_vector_type(4)));
constexpr float SC = 0.125f * 1.4426950408889634f, LOG2E = 1.4426950408889634f, NEGBIG = -1.0e30f, REF2 = 16.0f;
constexpr int OFF_K = 0, OFF_V = 32768, OFF_COMB = 73728;
struct Args {
  const bf16_t* QKV; int ld, kcol0, vcol0; const float* ck; const float* cv; int cld; const float* sink;
  const float* lq1; const float* lk1; const float* lq2; const float* lk2; float lam_init; const float* sub_g; bf16_t* O;
  const float* qn; const float* kn; const float* rope; float* kout; float* vout;
};
__device__ __forceinline__ s16x4 tr_read(const LAS unsigned char* p) { return __builtin_bit_cast(s16x4, __builtin_amdgcn_ds_read_tr16_b64_v4i16((LAS s16x4*)p)); }

template <int MODE>
__device__ __forceinline__ void unit(const Args& A, bool lat, int b, int hh, int chunk, float lam, LAS unsigned char* lds) {
  constexpr int KW = MODE == 2 ? 128 : 64, NDB = KW / 16, KROWB = KW * 2, VROWB = KW * 2 + 32, RPU = MODE == 2 ? 64 : 32, CPR = KW / 8, NCH = CPR / 8;
  constexpr int KBUF = 16384, VBUF = 20480;
  const int tid = opaque_i((int)threadIdx.x), lane = tid & 63, wave = __builtin_amdgcn_readfirstlane(tid >> 6), c = lane & 15, g = lane >> 4;
  const int s0 = lat ? TCTX + b * DEC_SEQ : b * SEQ, L = lat ? DEC_SEQ : SEQ, p0 = chunk * RPU;
  const int qpos = p0 + (MODE == 2 ? (wave & 3) * 16 : (wave & 1) * 16) + c;
  const int map = MODE == 2 ? (wave >> 2) : 0;
  const int hcol = MODE == 2 ? hh * 128 + map * 64 : (hh * 4 + (wave >> 1)) * 64;
  const int kcol = A.kcol0 + hh * KW, vcol = A.vcol0 + hh * KW, ccol = hh * KW;
  const int ncache = lat ? PAST / 64 : 0;
  int tlo = 0, thi = L / 64 - 1;
  if (MODE == 1 && lat) { const int lo = p0 - 128 < 0 ? 0 : p0 - 128, hi = p0 + RPU - 1 + 128 > L - 1 ? L - 1 : p0 + RPU - 1 + 128; tlo = lo / 64; thi = hi / 64; }
  const int NT = ncache + (thi - tlo + 1);
  bf16x8 qf[2];
  { const bf16_t* qp = A.QKV + (size_t)(s0 + qpos) * A.ld + hcol + 8 * g; qf[0] = *(const bf16x8*)qp; qf[1] = *(const bf16x8*)(qp + 32); }
  if (FUSE_QKPOST) {
    float x[2][8]; unpack8(__builtin_bit_cast(u32x4, qf[0]), x[0]); unpack8(__builtin_bit_cast(u32x4, qf[1]), x[1]);
    float ss = 0.f;
#pragma unroll
    for (int ks = 0; ks < 2; ++ks)
#pragma unroll
      for (int e = 0; e < 8; ++e) ss += x[ks][e] * x[ks][e];
    ss += shx(ss, 16, lane); ss += shx(ss, 32, lane);
    const float r = 1.0f / sqrtf(ss / 64.0f + EPS);
#pragma unroll
    for (int ks = 0; ks < 2; ++ks) { const f32x4 w0 = *(const f32x4*)(A.qn + 32 * ks + 8 * g), w1 = *(const f32x4*)(A.qn + 32 * ks + 8 * g + 4);
      x[ks][0] *= r * w0.x; x[ks][1] *= r * w0.y; x[ks][2] *= r * w0.z; x[ks][3] *= r * w0.w; x[ks][4] *= r * w1.x; x[ks][5] *= r * w1.y; x[ks][6] *= r * w1.z; x[ks][7] *= r * w1.w; }
    if (lat) { const bool x2side = (g & 2) != 0;
#pragma unroll
      for (int ks = 0; ks < 2; ++ks) { const f32x4* tb = (const f32x4*)(A.rope + ((size_t)(qpos * 2 + ks) * 16 + 8 * (g & 1)) * 2);
#pragma unroll
        for (int e2 = 0; e2 < 4; ++e2) { const f32x4 cs = tb[e2]; const float p0 = shx(x[ks][2 * e2], 32, lane), p1 = shx(x[ks][2 * e2 + 1], 32, lane);
          x[ks][2 * e2] = x2side ? x[ks][2 * e2] * cs.x + p0 * cs.y : x[ks][2 * e2] * cs.x - p0 * cs.y;
          x[ks][2 * e2 + 1] = x2side ? x[ks][2 * e2 + 1] * cs.z + p1 * cs.w : x[ks][2 * e2 + 1] * cs.z - p1 * cs.w; } } }
    qf[0] = __builtin_bit_cast(bf16x8, pack8(x[0])); qf[1] = __builtin_bit_cast(bf16x8, pack8(x[1]));
  }
  f32x4 o[NDB];
#pragma unroll
  for (int db = 0; db < NDB; ++db) o[db] = (f32x4){0.f, 0.f, 0.f, 0.f};
  float m = NEGBIG, lsum = 0.f;
  f32x4 rkA[NCH][2], rvA[NCH][2], rkB[NCH][2], rvB[NCH][2];
  auto load_tileA = [&](int t) {
    if (t < ncache) {
#pragma unroll
      for (int i = 0; i < NCH; ++i) { const int id = tid + 512 * i, row = id / CPR, ch = id % CPR; const size_t off = (size_t)(b * PAST + t * 64 + row) * A.cld + ccol + ch * 8;
        rkA[i][0] = *(const f32x4*)(A.ck + off); rkA[i][1] = *(const f32x4*)(A.ck + off + 4); rvA[i][0] = *(const f32x4*)(A.cv + off); rvA[i][1] = *(const f32x4*)(A.cv + off + 4); }
    } else {
      const int r0 = s0 + (tlo + t - ncache) * 64;
#pragma unroll
      for (int i = 0; i < NCH; ++i) { const int id = tid + 512 * i, row = id / CPR, ch = id % CPR; const bf16_t* rp = A.QKV + (size_t)(r0 + row) * A.ld + ch * 8;
        rkA[i][0] = *(const f32x4*)(rp + kcol); rvA[i][0] = *(const f32x4*)(rp + vcol); }
    }
  };
  auto write_tileA = [&](int t, int buf) {
    LAS unsigned char* Kb = lds + OFF_K + buf * KBUF; LAS unsigned char* Vb = lds + OFF_V + buf * VBUF;
#pragma unroll
    for (int i = 0; i < NCH; ++i) { const int id = tid + 512 * i, row = id / CPR, ch = id % CPR;
      const int pch = KW == 64 ? (ch ^ ((row >> 1) & 7)) : (ch ^ (row & 15));
      u32x4 kq, vq;
      if (t < ncache) {
        kq.x = pk_bf16(rkA[i][0].x, rkA[i][0].y); kq.y = pk_bf16(rkA[i][0].z, rkA[i][0].w); kq.z = pk_bf16(rkA[i][1].x, rkA[i][1].y); kq.w = pk_bf16(rkA[i][1].z, rkA[i][1].w);
        vq.x = pk_bf16(rvA[i][0].x, rvA[i][0].y); vq.y = pk_bf16(rvA[i][0].z, rvA[i][0].w); vq.z = pk_bf16(rvA[i][1].x, rvA[i][1].y); vq.w = pk_bf16(rvA[i][1].z, rvA[i][1].w);
      } else { kq = __builtin_bit_cast(u32x4, rkA[i][0]); vq = __builtin_bit_cast(u32x4, rvA[i][0]);
        if (FUSE_QKPOST) {
          const int j = ch & 7, kpos = (tlo + t - ncache) * 64 + row;
          float x[8]; unpack8(kq, x); float ss = 0.f;
#pragma unroll
          for (int e = 0; e < 8; ++e) ss += x[e] * x[e];
          ss += shx(ss, 1, lane); ss += shx(ss, 2, lane); ss += shx(ss, 4, lane);
          const float r = 1.0f / sqrtf(ss / 64.0f + EPS);
          const f32x4 w0 = *(const f32x4*)(A.kn + 8 * j), w1 = *(const f32x4*)(A.kn + 8 * j + 4);
          x[0] *= r * w0.x; x[1] *= r * w0.y; x[2] *= r * w0.z; x[3] *= r * w0.w; x[4] *= r * w1.x; x[5] *= r * w1.y; x[6] *= r * w1.z; x[7] *= r * w1.w;
          if (lat) { const int a = j >> 2; const f32x4* tb = (const f32x4*)(A.rope + ((size_t)(kpos * 2 + a) * 16 + 8 * (j & 1)) * 2); const bool x2side = (j & 2) != 0;
#pragma unroll
            for (int e2 = 0; e2 < 4; ++e2) { const f32x4 cs = tb[e2]; const float p0 = shx(x[2 * e2], 2, lane), p1 = shx(x[2 * e2 + 1], 2, lane);
              x[2 * e2] = x2side ? x[2 * e2] * cs.x + p0 * cs.y : x[2 * e2] * cs.x - p0 * cs.y;
              x[2 * e2 + 1] = x2side ? x[2 * e2 + 1] * cs.z + p1 * cs.w : x[2 * e2 + 1] * cs.z - p1 * cs.w; } }
          kq = pack8(x);
          if (!lat && kpos >= p0 && kpos < p0 + RPU) {
            constexpr int KOW = MODE == 2 ? 1024 : 256; const size_t oo = (size_t)(s0 + kpos) * KOW + hh * KW + ch * 8;
            *(f32x4*)(A.kout + oo) = (f32x4){x[0], x[1], x[2], x[3]}; *(f32x4*)(A.kout + oo + 4) = (f32x4){x[4], x[5], x[6], x[7]};
            float v[8]; unpack8(vq, v); *(f32x4*)(A.vout + oo) = (f32x4){v[0], v[1], v[2], v[3]}; *(f32x4*)(A.vout + oo + 4) = (f32x4){v[4], v[5], v[6], v[7]}; }
        } }
      *(LAS u32x4*)(Kb + row * KROWB + pch * 16) = kq; *(LAS u32x4*)(Vb + row * VROWB + ch * 16) = vq; }
  };
  auto load_tileB = [&](int t) {
    if (t < ncache) {
#pragma unroll
      for (int i = 0; i < NCH; ++i) { const int id = tid + 512 * i, row = id / CPR, ch = id % CPR; const size_t off = (size_t)(b * PAST + t * 64 + row) * A.cld + ccol + ch * 8;
        rkB[i][0] = *(const f32x4*)(A.ck + off); rkB[i][1] = *(const f32x4*)(A.ck + off + 4); rvB[i][0] = *(const f32x4*)(A.cv + off); rvB[i][1] = *(const f32x4*)(A.cv + off + 4); }
    } else {
      const int r0 = s0 + (tlo + t - ncache) * 64;
#pragma unroll
      for (int i = 0; i < NCH; ++i) { const int id = tid + 512 * i, row = id / CPR, ch = id % CPR; const bf16_t* rp = A.QKV + (size_t)(r0 + row) * A.ld + ch * 8;
        rkB[i][0] = *(const f32x4*)(rp + kcol); rvB[i][0] = *(const f32x4*)(rp + vcol); }
    }
  };
  auto write_tileB = [&](int t, int buf) {
    LAS unsigned char* Kb = lds + OFF_K + buf * KBUF; LAS unsigned char* Vb = lds + OFF_V + buf * VBUF;
#pragma unroll
    for (int i = 0; i < NCH; ++i) { const int id = tid + 512 * i, row = id / CPR, ch = id % CPR;
      const int pch = KW == 64 ? (ch ^ ((row >> 1) & 7)) : (ch ^ (row & 15));
      u32x4 kq, vq;
      if (t < ncache) {
        kq.x = pk_bf16(rkB[i][0].x, rkB[i][0].y); kq.y = pk_bf16(rkB[i][0].z, rkB[i][0].w); kq.z = pk_bf16(rkB[i][1].x, rkB[i][1].y); kq.w = pk_bf16(rkB[i][1].z, rkB[i][1].w);
        vq.x = pk_bf16(rvB[i][0].x, rvB[i][0].y); vq.y = pk_bf16(rvB[i][0].z, rvB[i][0].w); vq.z = pk_bf16(rvB[i][1].x, rvB[i][1].y); vq.w = pk_bf16(rvB[i][1].z, rvB[i][1].w);
      } else { kq = __builtin_bit_cast(u32x4, rkB[i][0]); vq = __builtin_bit_cast(u32x4, rvB[i][0]);
        if (FUSE_QKPOST) {
          const int j = ch & 7, kpos = (tlo + t - ncache) * 64 + row;
          float x[8]; unpack8(kq, x); float ss = 0.f;
#pragma unroll
          for (int e = 0; e < 8; ++e) ss += x[e] * x[e];
          ss += shx(ss, 1, lane); ss += shx(ss, 2, lane); ss += shx(ss, 4, lane);
          const float r = 1.0f / sqrtf(ss / 64.0f + EPS);
          const f32x4 w0 = *(const f32x4*)(A.kn + 8 * j), w1 = *(const f32x4*)(A.kn + 8 * j + 4);
          x[0] *= r * w0.x; x[1] *= r * w0.y; x[2] *= r * w0.z; x[3] *= r * w0.w; x[4] *= r * w1.x; x[5] *= r * w1.y; x[6] *= r * w1.z; x[7] *= r * w1.w;
          if (lat) { const int a = j >> 2; const f32x4* tb = (const f32x4*)(A.rope + ((size_t)(kpos * 2 + a) * 16 + 8 * (j & 1)) * 2); const bool x2side = (j & 2) != 0;
#pragma unroll
            for (int e2 = 0; e2 < 4; ++e2) { const f32x4 cs = tb[e2]; const float p0 = shx(x[2 * e2], 2, lane), p1 = shx(x[2 * e2 + 1], 2, lane);
              x[2 * e2] = x2side ? x[2 * e2] * cs.x + p0 * cs.y : x[2 * e2] * cs.x - p0 * cs.y;
              x[2 * e2 + 1] = x2side ? x[2 * e2 + 1] * cs.z + p1 * cs.w : x[2 * e2 + 1] * cs.z - p1 * cs.w; } }
          kq = pack8(x);
          if (!lat && kpos >= p0 && kpos < p0 + RPU) {
            constexpr int KOW = MODE == 2 ? 1024 : 256; const size_t oo = (size_t)(s0 + kpos) * KOW + hh * KW + ch * 8;
            *(f32x4*)(A.kout + oo) = (f32x4){x[0], x[1], x[2], x[3]}; *(f32x4*)(A.kout + oo + 4) = (f32x4){x[4], x[5], x[6], x[7]};
            float v[8]; unpack8(vq, v); *(f32x4*)(A.vout + oo) = (f32x4){v[0], v[1], v[2], v[3]}; *(f32x4*)(A.vout + oo + 4) = (f32x4){v[4], v[5], v[6], v[7]}; }
        } }
      *(LAS u32x4*)(Kb + row * KROWB + pch * 16) = kq; *(LAS u32x4*)(Vb + row * VROWB + ch * 16) = vq; }
  };
#define ATT_BAR() do { asm volatile("s_waitcnt lgkmcnt(0)" ::: "memory"); __builtin_amdgcn_s_barrier(); asm volatile("" ::: "memory"); } while (0)
  auto compute = [&](int t, int cur) {
    const LAS unsigned char* Kb = lds + OFF_K + cur * KBUF; const LAS unsigned char* Vb = lds + OFF_V + cur * VBUF;
    f32x4 s[4];
#pragma unroll
    for (int kb = 0; kb < 4; ++kb) { s[kb] = (f32x4){0.f, 0.f, 0.f, 0.f};
#pragma unroll
      for (int ks = 0; ks < 2; ++ks) { const int row = 16 * kb + c, ch = map * 8 + 4 * ks + g, pch = KW == 64 ? (ch ^ ((row >> 1) & 7)) : (ch ^ (row & 15));
        const bf16x8 kf = *(const LAS bf16x8*)(Kb + row * KROWB + pch * 16);
        s[kb] = __builtin_amdgcn_mfma_f32_16x16x32_bf16(kf, qf[ks], s[kb], 0, 0, 0); } }
    const bool band = (MODE == 1) && lat && (t >= ncache); const int tb = (tlo + t - ncache) * 64;
    float ps = 0.f;
    if (ATT_FIXED_REF) {
#pragma unroll
      for (int kb = 0; kb < 4; ++kb)
#pragma unroll
        for (int r = 0; r < 4; ++r) { float p = __builtin_amdgcn_exp2f(s[kb][r] * SC - REF2);
          if (band) { const int dlt = qpos - (tb + 16 * kb + 4 * g + r); if (dlt > 128 || dlt < -128) p = 0.f; }
          s[kb][r] = p; ps += p; }
      lsum += ps;
    } else {
    float mx = NEGBIG;
#pragma unroll
    for (int kb = 0; kb < 4; ++kb)
#pragma unroll
      for (int r = 0; r < 4; ++r) { float v = s[kb][r] * SC;
        if (band) { const int dlt = qpos - (tb + 16 * kb + 4 * g + r); if (dlt > 128 || dlt < -128) v = NEGBIG; }
        s[kb][r] = v; mx = fmaxf(mx, v); }
    mx = fmaxf(mx, shx(mx, 16, lane)); mx = fmaxf(mx, shx(mx, 32, lane));
    const float mn = fmaxf(m, mx), alpha = __builtin_amdgcn_exp2f(m - mn); m = mn;
#pragma unroll
    for (int kb = 0; kb < 4; ++kb)
#pragma unroll
      for (int r = 0; r < 4; ++r) { const float p = __builtin_amdgcn_exp2f(s[kb][r] - mn); s[kb][r] = p; ps += p; }
    lsum = lsum * alpha + ps;
#pragma unroll
    for (int db = 0; db < NDB; ++db) o[db] = o[db] * alpha;
    }
    bf16x8 pf[2];
#pragma unroll
    for (int ks = 0; ks < 2; ++ks) { u32x4 pk; pk.x = pk_bf16(s[2 * ks][0], s[2 * ks][1]); pk.y = pk_bf16(s[2 * ks][2], s[2 * ks][3]); pk.z = pk_bf16(s[2 * ks + 1][0], s[2 * ks + 1][1]); pk.w = pk_bf16(s[2 * ks + 1][2], s[2 * ks + 1][3]);
      pf[ks] = __builtin_bit_cast(bf16x8, pk); }
#pragma unroll
    for (int db = 0; db < NDB; ++db)
#pragma unroll
      for (int ks = 0; ks < 2; ++ks) { const LAS unsigned char* vp = Vb + (32 * ks + 4 * g + (c >> 2)) * VROWB + 32 * db + 8 * (c & 3);
        const s16x4 lo = tr_read(vp), hi = tr_read(vp + 16 * VROWB);
        const bf16x8 vt = (bf16x8){lo[0], lo[1], lo[2], lo[3], hi[0], hi[1], hi[2], hi[3]};
        o[db] = __builtin_amdgcn_mfma_f32_16x16x32_bf16(vt, pf[ks], o[db], 0, 0, 0); }
  };
  load_tileA(0); if (NT > 1) load_tileB(1);
  write_tileA(0, 0); ATT_BAR();
  for (int t = 0; t < NT; t += 2) {
    if (t + 2 < NT) load_tileA(t + 2);
    compute(t, 0);
    if (t + 1 < NT) write_tileB(t + 1, 1);
    ATT_BAR();
    if (t + 1 >= NT) break;
    if (t + 3 < NT) load_tileB(t + 3);
    compute(t + 1, 1);
    if (t + 2 < NT) write_tileA(t + 2, 0);
    ATT_BAR();
  }
  lsum += shx(lsum, 16, lane); lsum += shx(lsum, 32, lane);
  if (MODE == 1) lsum += __builtin_amdgcn_exp2f(A.sink[hh * 4 + (wave >> 1)] * LOG2E - (ATT_FIXED_REF ? REF2 : m));
  const float rl = 1.0f / lsum;
  if (MODE != 2) {
    bf16_t* op = A.O + (size_t)(s0 + qpos) * D + hcol + 4 * g;
#pragma unroll
    for (int db = 0; db < NDB; ++db) { u32x2 pk; pk.x = pk_bf16(o[db][0] * rl, o[db][1] * rl); pk.y = pk_bf16(o[db][2] * rl, o[db][3] * rl); *(u32x2*)(op + 16 * db) = pk; }
  } else {
    LAS float* comb = (LAS float*)(lds + OFF_COMB);
    const int row = (wave & 3) * 16 + c;
    if (map == 1) {
#pragma unroll
      for (int db = 0; db < NDB; ++db) *(LAS f32x4*)(comb + row * 132 + 16 * db + 4 * g) = o[db] * rl;
    }
    __syncthreads();
    if (map == 0) {
      float ss = 0.f;
#pragma unroll
      for (int db = 0; db < NDB; ++db) { const f32x4 o2 = *(const LAS f32x4*)(comb + row * 132 + 16 * db + 4 * g); o[db] = o[db] * rl - lam * o2;
        ss += (o[db][0] * o[db][0] + o[db][1] * o[db][1]) + (o[db][2] * o[db][2] + o[db][3] * o[db][3]); }
      ss += shx(ss, 16, lane); ss += shx(ss, 32, lane);
      const float rs = (1.0f - A.lam_init) / sqrtf(ss / 128.0f + EPS);
      bf16_t* op = A.O + (size_t)(s0 + qpos) * D + hh * 128 + 4 * g;
#pragma unroll
      for (int db = 0; db < NDB; ++db) { const f32x4 sg = *(const f32x4*)(A.sub_g + 16 * db + 4 * g); u32x2 pk; pk.x = pk_bf16(o[db][0] * rs * sg.x, o[db][1] * rs * sg.y); pk.y = pk_bf16(o[db][2] * rs * sg.z, o[db][3] * rs * sg.w);
        *(u32x2*)(op + 16 * db) = pk; }
    }
    __syncthreads();
  }
}

template <int MODE>
__device__ __forceinline__ void phase(const Args& A, LAS unsigned char* lds) {
  constexpr int NH = MODE == 2 ? 8 : 4, RPU = MODE == 2 ? 64 : 32, CPS_L = DEC_SEQ / RPU, CPS_C = SEQ / RPU, NLAT = DEC_BATCH * NH * CPS_L, NCTX = BATCH * NH * CPS_C;
  float lam = 0.f;
  if (MODE == 2) { const int lane = opaque_i((int)threadIdx.x) & 63; const float d1 = wave_sum(A.lq1[lane] * A.lk1[lane], lane), d2 = wave_sum(A.lq2[lane] * A.lk2[lane], lane); lam = expf(d1) - expf(d2) + A.lam_init; }
  for (int u = opaque_block(); u < NLAT; u += (int)gridDim.x) unit<MODE>(A, true, u / (NH * CPS_L), (u / CPS_L) % NH, u % CPS_L, lam, lds);
  for (int u = opaque_block(); u < NCTX; u += (int)gridDim.x) unit<MODE>(A, false, u / (NH * CPS_C), (u / CPS_C) % NH, u % CPS_C, lam, lds);
}
}
#endif


#ifndef HOST_EMU
#define XB_TMO      128
#define XB_XCNT(j)  (256  + 64 * (j))
#define XB_XSUB(j)  (1280 + 64 * (j))
#define XB_XGEN(j)  (2304 + 64 * (j))
#define XB_TOP      3328
#define XB_TOPGEN   3392
#define XCD_BAR_WORDS 3456
#define XB_SPIN_CAP (1u << 18)

__device__ __forceinline__ unsigned xb_ld(unsigned* p)              { return __hip_atomic_load(p, __ATOMIC_RELAXED, __HIP_MEMORY_SCOPE_AGENT); }
__device__ __forceinline__ unsigned xb_add(unsigned* p, unsigned v) { return __hip_atomic_fetch_add(p, v, __ATOMIC_RELAXED, __HIP_MEMORY_SCOPE_AGENT); }
__device__ __forceinline__ unsigned xb_xcc_id() { return (unsigned)__builtin_amdgcn_s_getreg((3 << 11) | 20) & 0xFu; }
#define XB_SPIN(cond, bar) do { unsigned _sp = 0; while (cond) { __builtin_amdgcn_s_sleep(1); \
    if ((++_sp & 255u) == 0u) { if (xb_ld(&(bar)[XB_TMO])) break; if (_sp > XB_SPIN_CAP) { atomicAdd(&(bar)[XB_TMO], 1u); break; } } } } while (0)

struct XcdBarrier {
    unsigned* bar; unsigned x;
    volatile LAS unsigned* st;
};

__device__ __forceinline__ XcdBarrier xcd_barrier_post(unsigned* bar, volatile LAS unsigned* st) {
    XcdBarrier b; b.bar = bar; b.x = xb_xcc_id(); b.st = st;
    if (threadIdx.x == 0) (void)xb_add(&bar[XB_XCNT(b.x)], 1u);
    return b;
}
__device__ __forceinline__ void xcd_barrier_complete(unsigned* bar, unsigned x, unsigned& nloc, unsigned& nx) {
    const unsigned G = gridDim.x * gridDim.y * gridDim.z;
    unsigned sum, cnt, mine, sp = 0u;
    for (;;) {
        sum = 0u; cnt = 0u; mine = 0u;
#pragma unroll
        for (unsigned j = 0; j < 16; ++j) { const unsigned c = xb_ld(&bar[XB_XCNT(j)]); sum += c; cnt += (c > 0u) ? 1u : 0u; mine = (j == x) ? c : mine; }
        if (sum == G) break;
        __builtin_amdgcn_s_sleep(1);
        if ((++sp & 255u) == 0u) { if (xb_ld(&bar[XB_TMO])) break; if (sp > XB_SPIN_CAP) { atomicAdd(&bar[XB_TMO], 1u); break; } }
    }
    nloc = mine > 0u ? mine : 1u; nx = cnt > 0u ? cnt : 1u;
}

__device__ __forceinline__ void xcd_barrier(const XcdBarrier& b) {
    asm volatile("s_waitcnt vmcnt(0)" ::: "memory");
    __syncthreads();
    if (threadIdx.x == 0) {
        unsigned* bar = b.bar;
        __builtin_amdgcn_s_waitcnt(0);
        unsigned nloc = b.st[0], nx = b.st[1];
        if (nloc == 0u) { xcd_barrier_complete(bar, b.x, nloc, nx); b.st[0] = nloc; b.st[1] = nx; }
        const unsigned old = xb_add(&bar[XB_XSUB(b.x)], 1u);
        const unsigned gen = old / nloc;
        if (old + 1u == (gen + 1u) * nloc) {
            __builtin_amdgcn_fence(__ATOMIC_RELEASE, "agent");
            asm volatile("s_waitcnt vmcnt(0)" ::: "memory");
            const unsigned og = xb_add(&bar[XB_TOP], 1u);
            const unsigned tg = og / nx;
            if (og + 1u == (tg + 1u) * nx) xb_add(&bar[XB_TOPGEN], 1u);
            else XB_SPIN(xb_ld(&bar[XB_TOPGEN]) == tg, bar);
            __builtin_amdgcn_fence(__ATOMIC_ACQUIRE, "agent");
            xb_add(&bar[XB_XGEN(b.x)], 1u);
            asm volatile("s_waitcnt vmcnt(0)" ::: "memory");
        } else {
            XB_SPIN(xb_ld(&bar[XB_XGEN(b.x)]) == gen, bar);
            __builtin_amdgcn_fence(__ATOMIC_ACQUIRE, "agent");
            asm volatile("s_waitcnt vmcnt(0)" ::: "memory");
        }
    }
    __syncthreads();
}
#endif

#ifndef HOST_EMU
constexpr int LDS_BYTES = 147456;
#ifndef FAST_PRO
#define FAST_PRO 1
#endif
#ifndef FAST_NORM
#define FAST_NORM 1
#endif
#ifndef FAST_POOL
#define FAST_POOL 1
#endif
#ifndef FAST_QKPOST
#define FAST_QKPOST 1
#endif
#ifndef FAST_CONV
#define FAST_CONV 1
#endif
#ifndef FAST_ATTN
#define FAST_ATTN 1
#endif
#ifndef REP_GEMM
#define REP_GEMM 0
#endif
#ifndef REP_ATTN
#define REP_ATTN 0
#endif
#ifndef REP_ELEM
#define REP_ELEM 0
#endif
#ifndef REP_PRO
#define REP_PRO 0
#endif
#ifndef REP_SYNC
#define REP_SYNC 0
#endif
#ifndef USE_CG_SYNC
#define USE_CG_SYNC 0
#endif
__global__ void __launch_bounds__(512, 2) mega(Params P) {
  extern __shared__ __attribute__((aligned(16))) unsigned char lds_raw[];
  cg::grid_group grid = cg::this_grid();
  PG8_LAS unsigned char* lds = (PG8_LAS unsigned char*)lds_raw;
  const Ctx c = make_ctx(P);
  volatile LAS unsigned* MISC = (volatile LAS unsigned*)((LAS unsigned char*)lds_raw + 131072 + 320);
  if (threadIdx.x < 32) MISC[threadIdx.x] = 0u;
  __syncthreads();
  { unsigned* b0_ = (unsigned*)(P.ws + WS_CTL); asm volatile("" : "+s"(b0_)); (void)xcd_barrier_post(b0_, MISC + 8); }
#define BAR_NOW() do { XcdBarrier bar_; { unsigned* b0_ = (unsigned*)(P.ws + WS_CTL); asm volatile("" : "+s"(b0_)); bar_.bar = b0_; } bar_.x = xb_xcc_id(); bar_.st = (volatile LAS unsigned*)((LAS unsigned char*)lds_raw + 131072 + 320) + 8; xcd_barrier(bar_); } while (0)
#define GSYNC() do { if (USE_CG_SYNC) grid.sync(); else BAR_NOW(); if (REP_SYNC) { if (USE_CG_SYNC) grid.sync(); else BAR_NOW(); } } while (0)
#define NAIVE(step) do { naive_step((step), P, c); } while (0)
#define GEMM_RUN(step, rep_) do { GemmDesc g; gemm_desc((step), P, c, g); \
    pg8::Gemm gg{g.A, g.Bt, T, g.N, g.K, g.lda, g.ldb, g.a_pn_step, g.ksplit}; pg8::StaticOrder S; S.init(T, g.N, (int)gridDim.x, opaque_block(), g.ksplit); \
    if (g.res) { bf16_t* slab_ = (bf16_t*)(c.ws_p() + (pend == (const bf16_t*)(c.ws_p() + WS_SA) ? WS_SB : WS_SA)); \
      float* xw_ = (rep_) == 0 ? c.X() : (float*)(g.K == DFF ? c.Ub() : c.Gb()); const bool first_ = ((step) == N_PRE + 7); \
      pg8::EpiRes E{xw_, first_ ? pin(P, I_XP) : (const float*)xw_, first_ ? pin(P, I_XS) - (size_t)TCTX * D : (const float*)xw_, MODl, g.gate_chunk, g.colscale, pend, slab_}; pg8::gemm_phase<pg8::EpiRes, pg8::StaticOrder, true, true>(lds, gg, S, E); \
      if ((rep_) == 0) pend = g.ksplit > 1 ? (const bf16_t*)slab_ : nullptr; } \
    else { pg8::EpiBf16<0> E{g.C, g.ldc, nullptr, 0, 0, 1.f}; pg8::gemm_phase<pg8::EpiBf16<0>, pg8::StaticOrder, true, true>(lds, gg, S, E); } } while (0)
#define GEMM_STEP(step) do { GEMM_RUN(step, 0); if (REP_GEMM) { __syncthreads(); GEMM_RUN(step, 1); } } while (0)
  const bf16_t* pend = nullptr;
#define BG_AFTER_GEMM(nunits, ticks) do { const int G_ = (int)gridDim.x, b_ = opaque_block(), r_ = ((nunits) + G_ - 1) / G_, full_ = (nunits) - (r_ - 1) * G_; \
    if (b_ >= full_) bg_work(P, c, (LAS unsigned char*)lds_raw, (ticks), bg_total_items()); } while (0)
  if (FAST_PRO) { for (int rep_ = 0; rep_ < 1 + REP_PRO; ++rep_) ph_prologue(P, c, (LAS unsigned char*)lds_raw); GSYNC(); }
  else { NAIVE(0); GSYNC(); NAIVE(1); GSYNC(); NAIVE(2); GSYNC(); }
#pragma unroll 1
  for (int l = 0; l < 4; ++l) {
    const int s0 = N_PRE + l * STEPS_PER_LAYER;
    const float* MODl = c.MOD() + (size_t)l * NCOND * MODW;
    if (l > 0) bg_work(P, c, (LAS unsigned char*)lds_raw, 0xffffffffu, bg_end_of_layer(l));
    if (FAST_NORM) { for (int rep_ = 0; rep_ < 1 + REP_ELEM; ++rep_) ph_norm(l == 0 ? pin(P, I_XP) : (const float*)c.X(), l == 0 ? pin(P, I_XS) - (size_t)TCTX * D : (const float*)c.X(), pend, pin(P, I_N1G) + l * D, MODl, 0, 1, c.Hb()); GSYNC(); }
    else { NAIVE(s0 + 0); GSYNC(); NAIVE(s0 + 1); GSYNC(); }
    if (l == 0) {
      if (FAST_POOL) { for (int rep_ = 0; rep_ < 1 + REP_ELEM; ++rep_) ph_pool(c.Hb(), c.PDb()); } else NAIVE(s0 + 2);
      GSYNC();
    } else {
      if (FUSE_QKEPI) {
        GemmDesc g; gemm_desc(s0 + 2, P, c, g);
        pg8::Gemm gg{g.A, g.Bt, T, g.N, g.K, g.lda, g.ldb, g.a_pn_step, 1}; pg8::StaticOrder S; S.init(T, g.N, (int)gridDim.x, opaque_block(), 1);
        pg8::EpiQK E{c.QKVb(), g.N, 1024, l == 2 ? 2048 : 1280, pin(P, l == 1 ? I_GQN : (l == 2 ? I_DQN : I_WQN)), pin(P, l == 1 ? I_GKN : (l == 2 ? I_DKN : I_WKN)), c.ROPE(),
                     l == 1 ? c.o_gk() : (l == 2 ? c.o_dk() : c.o_wk()), l == 1 ? c.o_gv() : (l == 2 ? c.o_dv() : c.o_wv()), l == 2 ? 1024 : 256, (PG8_LAS float*)(lds + 131072 + 1024)};
        pg8::gemm_phase<pg8::EpiQK, pg8::StaticOrder, true, true>(lds, gg, S, E);
      } else GEMM_STEP(s0 + 2);
      GSYNC();
      if (FUSE_QKPOST || FUSE_QKEPI) {   }
      else if (FAST_QKPOST) {
        if (l == 2) ph_qkpost(c.QKVb(), 3072, 16, 16, 16, 1024, 2048, pin(P, I_DQN), pin(P, I_DKN), c.ROPE(), c.o_dk(), c.o_dv());
        else ph_qkpost(c.QKVb(), 1536, 16, 4, 4, 1024, 1280, pin(P, l == 1 ? I_GQN : I_WQN), pin(P, l == 1 ? I_GKN : I_WKN), c.ROPE(), l == 1 ? c.o_gk() : c.o_wk(), l == 1 ? c.o_gv() : c.o_wv());
      } else NAIVE(s0 + 3);
      if (!FUSE_QKPOST && !FUSE_QKEPI) GSYNC();
      if (FAST_ATTN) {
        const float lam_init = 0.8f - 0.6f * expf(-0.3f * (float)l);
        for (int rep_ = 0; rep_ < 1 + REP_ATTN; ++rep_) {
        if (l == 2) { const att::Args A{c.QKVb(), 3072, 1024, 2048, pin(P, I_CDK), pin(P, I_CDV), 1024, nullptr, pin(P, I_DLQ1), pin(P, I_DLK1), pin(P, I_DLQ2), pin(P, I_DLK2), lam_init, pin(P, I_DSUB), c.Ob(), pin(P, I_DQN), pin(P, I_DKN), c.ROPE(), c.o_dk(), c.o_dv()};
          att::phase<2>(A, (LAS unsigned char*)lds_raw); }
        else if (l == 1) { const att::Args A{c.QKVb(), 1536, 1024, 1280, pin(P, I_CGK), pin(P, I_CGV), 256, nullptr, nullptr, nullptr, nullptr, nullptr, 0.f, nullptr, c.Ob(), pin(P, I_GQN), pin(P, I_GKN), c.ROPE(), c.o_gk(), c.o_gv()};
          att::phase<0>(A, (LAS unsigned char*)lds_raw); }
        else { const att::Args A{c.QKVb(), 1536, 1024, 1280, pin(P, I_CWK), pin(P, I_CWV), 256, pin(P, I_WSINK), nullptr, nullptr, nullptr, nullptr, 0.f, nullptr, c.Ob(), pin(P, I_WQN), pin(P, I_WKN), c.ROPE(), c.o_wk(), c.o_wv()};
          att::phase<1>(A, (LAS unsigned char*)lds_raw); }
        }
        GSYNC();
      } else {
        NAIVE(s0 + 5); GSYNC();
        if (l == 2) { NAIVE(s0 + 6); GSYNC(); }
      }
    }
    GEMM_STEP(s0 + 7); BG_AFTER_GEMM((T / 256) * (D / 256) * (l == 0 ? 1 : KSPLIT), l == 0 ? 400u : 800u); GSYNC();
    if (FAST_NORM) { for (int rep_ = 0; rep_ < 1 + REP_ELEM; ++rep_) ph_norm(c.X(), c.X(), pend, pin(P, I_N2G) + l * D, MODl, 3, 4, c.Hb()); GSYNC(); }
    else { NAIVE(s0 + 8); GSYNC(); NAIVE(s0 + 9); GSYNC(); }
    if (FUSE_CONV) {
      GemmDesc g; gemm_desc(s0 + 10, P, c, g);
      pg8::Gemm gg{g.A, g.Bt, T, g.N, g.K, g.lda, g.ldb, g.a_pn_step, 1}; pg8::LimitedOrder S; S.init(T, g.N, (int)gridDim.x, opaque_block(), 1);
      const int G_ = (int)gridDim.x, full_rounds = S.nwg / G_, left = S.nwg - full_rounds * G_;
      S.maxr = (WIN_TAIL && left * 4 < G_) ? full_rounds : full_rounds + 1;
      pg8::EpiConv E{c.Gb(), pin(P, I_FCW) + (size_t)l * 3 * DFF2, pin(P, I_FCB) + (size_t)l * DFF2, (float*)(c.ws_p() + WS_EDGE), (PG8_LAS unsigned*)(lds + 131072 + 1024)};
      pg8::gemm_phase<pg8::EpiConv, pg8::LimitedOrder, true, true>(lds, gg, S, E);
      if (S.maxr == full_rounds) {
        for (int su = opaque_block(); su < left * 16; su += G_) {
          pg8::StaticOrder S2; S2.init(T, g.N, G_, su >> 4, 1); pg8::Unit u; S2.next(full_rounds, u);
          win_subunit(g.A, g.Bt, pin(P, I_FCW) + (size_t)l * 3 * DFF2, pin(P, I_FCB) + (size_t)l * DFF2, c.Gb(), (float*)(c.ws_p() + WS_EDGE), (LAS unsigned char*)lds_raw, u.pm, u.pn, su & 15);
        }
      }
    } else {
    GEMM_STEP(s0 + 10); GSYNC();
    if (FAST_CONV) { for (int rep_ = 0; rep_ < 1 + REP_ELEM; ++rep_) ph_convgate(c.Ub(), pin(P, I_FCW) + (size_t)l * 3 * DFF2, pin(P, I_FCB) + (size_t)l * DFF2, c.Gb()); } else NAIVE(s0 + 11);
    }
    GSYNC();
    if (FUSE_CONV) {
      GemmDesc g; gemm_desc(s0 + 12, P, c, g); pg8::StaticOrder S; S.init(T, g.N, (int)gridDim.x, opaque_block(), g.ksplit); pg8::Unit u;
      for (int i = 0; S.next(i, u); ++i) conv_fixup_unit((const float*)(c.ws_p() + WS_EDGE), pin(P, I_FCW) + (size_t)l * 3 * DFF2, pin(P, I_FCB) + (size_t)l * DFF2, c.Gb(), u.pm, u.kh * (DFF / g.ksplit), DFF / g.ksplit);
      asm volatile("s_waitcnt vmcnt(0)" ::: "memory"); __syncthreads();
    }
    GEMM_STEP(s0 + 12); BG_AFTER_GEMM((T / 256) * (D / 256) * ((DFF % 256 == 0) ? KSPLIT : 1), 2800u);
    if (l < 3) GSYNC();
  }
  if (pend) {
    GSYNC();
    const WaveId w = wave_id();
    for (int t = w.gw; t < T; t += w.ngw) { f32x4* xr = (f32x4*)(c.X() + (size_t)t * D) + w.lane; const u32x2* pr = (const u32x2*)(pend + (size_t)t * D) + w.lane;
#pragma unroll
      for (int j = 0; j < 4; ++j) { const u32x2 q = pr[64 * j]; xr[64 * j] = xr[64 * j] + (f32x4){bf_lo(q.x), bf_hi(q.x), bf_lo(q.y), bf_hi(q.y)}; } }
  }
}
#endif

extern "C" void kernel_launch(void* const* d_in, const int* in_sizes, int n_in, void* d_out, int out_size, void* d_ws, size_t ws_size,
                              hipStream_t stream) {
  (void)in_sizes; (void)n_in; (void)out_size;
  Params P{};
  for (int i = 0; i < N_IN; ++i) P.in[i] = (const float*)d_in[i];
  P.out = (float*)d_out; P.ws = (unsigned char*)d_ws;
#ifdef HOST_EMU
  for (int step = 0; step < N_STEPS; ++step) { if (step_is_noop(step)) continue; emu_launch(256, 8, [&] { const Ctx c = make_ctx(P); naive_step(step, P, c); }); }
#else
  static int grid_blocks = 0;
  if (!grid_blocks) {
    if (ws_size < WS_END) { fprintf(stderr, "kernel_launch: workspace too small (%zu < %zu)\n", ws_size, (size_t)WS_END); grid_blocks = -1; return; }
    int dev = 0, cus = 0, per_cu = 0;
    (void)hipGetDevice(&dev);
    (void)hipDeviceGetAttribute(&cus, hipDeviceAttributeMultiprocessorCount, dev);
    (void)hipFuncSetAttribute((const void*)mega, hipFuncAttributeMaxDynamicSharedMemorySize, LDS_BYTES);
    (void)hipOccupancyMaxActiveBlocksPerMultiprocessor(&per_cu, mega, 512, LDS_BYTES);
    if (per_cu < 1) { fprintf(stderr, "kernel_launch: occupancy query says %d blocks per CU\n", per_cu); per_cu = 1; }
    if (per_cu > 1) per_cu = 1;
    grid_blocks = cus * per_cu;
  }
  if (grid_blocks < 0) return;
  if (hipMemsetAsync((char*)d_ws + WS_CTL, 0, CTL_ZERO_BYTES, stream) != hipSuccess) { fprintf(stderr, "kernel_launch: hipMemsetAsync of the control words failed\n"); return; }
  void* args[] = {&P};
  hipError_t e = hipLaunchCooperativeKernel((void*)mega, dim3(grid_blocks), dim3(512), args, LDS_BYTES, stream);
  if (e != hipSuccess) fprintf(stderr, "cooperative launch failed: %s (grid %d)\n", hipGetErrorString(e), grid_blocks);
#endif
}
```

```cpp
#ifndef HOST_EMU
#include <hip/hip_runtime.h>
#include <hip/hip_cooperative_groups.h>
#include <cstdio>
#include <cstdint>
#include <cmath>
namespace cg = cooperative_groups;
#endif

#ifndef CFG_BATCH
#define CFG_BATCH 16
#endif
#ifndef ATT_FIXED_REF
#define ATT_FIXED_REF 1
#endif
#ifndef BG_QUEUE
#define BG_QUEUE 0
#endif
#ifndef WIN_TAIL
#define WIN_TAIL 0
#endif
#ifndef FUSE_QKEPI
#define FUSE_QKEPI 1
#endif
#ifndef FUSE_QKPOST
#define FUSE_QKPOST 0
#endif
#ifndef FUSE_CONV
#define FUSE_CONV 1
#endif
#ifndef CFG_DFF
#define CFG_DFF 2816
#endif

namespace cfg {
constexpr int D = 1024, BATCH = CFG_BATCH, SEQ = 256, DEC_BATCH = 2, DEC_SEQ = 1024, PAST = 256;
constexpr int TCTX = BATCH * SEQ, TLAT = DEC_BATCH * DEC_SEQ, T = TCTX + TLAT;
constexpr int DFF = CFG_DFF, DFF2 = 2 * DFF;
constexpr int NCOND = 3, MODW = 6 * D;
constexpr float EPS = 1e-6f;
}
using namespace cfg;

typedef unsigned short bf16_t;
#ifdef HOST_EMU
static inline float bf2f(bf16_t v) { unsigned u = (unsigned)v << 16; float f; memcpy(&f, &u, 4); return f; }
static inline bf16_t f2bf(float f) { unsigned u; memcpy(&u, &f, 4); return (bf16_t)((u + 0x7fffu + ((u >> 16) & 1u)) >> 16); }
#else
__device__ __forceinline__ float bf2f(bf16_t v) { return __uint_as_float((unsigned)v << 16); }
__device__ __forceinline__ bf16_t f2bf(float f) { unsigned u = __float_as_uint(f); return (bf16_t)((u + 0x7fffu + ((u >> 16) & 1u)) >> 16); }
#endif

__device__ __forceinline__ int tok_cond(int t) { return t < TCTX ? 0 : 1 + (t - TCTX) / DEC_SEQ; }
__device__ __forceinline__ void tok_seq(int t, int& s0, int& L) {
  if (t < TCTX) { s0 = (t / SEQ) * SEQ; L = SEQ; } else { s0 = TCTX + ((t - TCTX) / DEC_SEQ) * DEC_SEQ; L = DEC_SEQ; }
}
__device__ __forceinline__ float silu_f(float x) { return x / (1.0f + expf(-x)); }

#ifdef HOST_EMU
static inline long opaque_tid() { return (long)blockIdx.x * blockDim.x + threadIdx.x; }
#else
__device__ __forceinline__ long opaque_tid() { int t = (int)(blockIdx.x * blockDim.x + threadIdx.x); asm volatile("" : "+v"(t)); return (long)t; }
#endif
#define GRID_STRIDE(idx, total) \
  for (long idx = opaque_tid(), _gs = (long)gridDim.x * blockDim.x; idx < (long)(total); idx += _gs)

__device__ void nk_copy_x(const float* xp, const float* xs, float* X) {
  GRID_STRIDE(i, (long)T * D) X[i] = i < (long)TCTX * D ? xp[i] : xs[i - (long)TCTX * D];
}

__device__ void nk_mod(const float* c, const float* c_ctx, const float* w_mod, const float* b_mod, float* MOD, int nlayer) {
  GRID_STRIDE(i, (long)nlayer * NCOND * MODW) {
    const int n = (int)(i % MODW), cd = (int)((i / MODW) % NCOND), l = (int)(i / ((long)MODW * NCOND));
    const float* cv = cd == 0 ? c_ctx : c + (cd - 1) * D;
    const float* w = w_mod + (long)l * D * MODW + n;
    float acc = 0.f;
    for (int k = 0; k < D; ++k) acc += silu_f(cv[k]) * w[(long)k * MODW];
    MOD[i] = acc + b_mod[(long)l * MODW + n];
  }
}

__device__ void nk_rope_table(float* ROPE) {
  GRID_STRIDE(i, (long)DEC_SEQ * 32) {
    const int pos = (int)(i / 32), a = (int)((i / 16) % 2), f = (int)(i % 16);
    const float inv = powf(10000.0f, -(float)(2 * f) / 32.0f), ang = (a == 0 ? (float)(pos / 64) : (float)(pos % 64)) * inv;
    ROPE[2 * i] = cosf(ang); ROPE[2 * i + 1] = sinf(ang);
  }
}

__device__ void nk_wt(const float* W, int K, int N, bf16_t* WT) {
  GRID_STRIDE(i, (long)K * N) { const int n = (int)(i / K), k = (int)(i % K); WT[i] = f2bf(W[(long)k * N + n]); }
}

__device__ void nk_rstd(const float* X, float* RSTD) {
  GRID_STRIDE(t, T) {
    const float* x = X + t * D; float ss = 0.f;
    for (int d = 0; d < D; ++d) ss += x[d] * x[d];
    RSTD[t] = 1.0f / sqrtf(ss / (float)D + EPS);
  }
}

__device__ void nk_normmod(const float* X, const float* RSTD, const float* g, const float* MODl, int sh_chunk, int sc_chunk, bf16_t* Hb) {
  GRID_STRIDE(i, (long)T * D) {
    const int t = (int)(i / D), d = (int)(i % D); const float* m = MODl + (long)tok_cond(t) * MODW;
    Hb[i] = f2bf(X[i] * RSTD[t] * g[d] * (1.0f + m[sc_chunk * D + d]) + m[sh_chunk * D + d]);
  }
}

__device__ void nk_gemm_bf(const bf16_t* A, int lda, const bf16_t* Bt, int ldb, bf16_t* C, int ldc, int M, int N, int K) {
  GRID_STRIDE(i, (long)M * N) {
    const int t = (int)(i / N), n = (int)(i % N); const bf16_t* a = A + (long)t * lda; const bf16_t* b = Bt + (long)n * ldb;
    float acc = 0.f;
    for (int k = 0; k < K; ++k) acc += bf2f(a[k]) * bf2f(b[k]);
    C[(long)t * ldc + n] = f2bf(acc);
  }
}

__device__ void nk_gemm_res(const bf16_t* A, int lda, int a_pn_step, const bf16_t* Bt, int ldb, float* X, int M, int N, int K,
                            const float* MODl, int gate_chunk, const float* colscale) {
  GRID_STRIDE(i, (long)M * N) {
    const int t = (int)(i / N), n = (int)(i % N); const bf16_t* a = A + (long)t * lda + (n / 256) * a_pn_step; const bf16_t* b = Bt + (long)n * ldb;
    float acc = 0.f;
    for (int k = 0; k < K; ++k) acc += bf2f(a[k]) * bf2f(b[k]);
    if (colscale) acc *= colscale[n];
    X[(long)t * D + n] += MODl[(long)tok_cond(t) * MODW + gate_chunk * D + n] * acc;
  }
}

__device__ void nk_pool(const bf16_t* Hb, bf16_t* PDb) {
  GRID_STRIDE(i, (long)T * D) {
    const int t = (int)(i / D), d = (int)(i % D), g = d / 256, w = 2 << g; int s0, L; tok_seq(t, s0, L);
    const int pos = t - s0; int lo = pos - w / 2, hi = pos - w / 2 + w; lo = lo < 0 ? 0 : lo; hi = hi > L ? L : hi;
    float s = 0.f;
    for (int j = lo; j < hi; ++j) s += bf2f(Hb[(long)(s0 + j) * D + d]);
    PDb[i] = f2bf(s / (float)(hi - lo) - bf2f(Hb[i]));
  }
}

__device__ void nk_qknorm_rope(bf16_t* QKV, int ld, int nq, int nk, int kcol0, const float* qn, const float* kn, float* kout) {
  GRID_STRIDE(i, (long)T * (nq + nk)) {
    const int t = (int)(i / (nq + nk)), s = (int)(i % (nq + nk));
    bf16_t* v = QKV + (long)t * ld + (s < nq ? s * 64 : kcol0 + (s - nq) * 64); const float* w = s < nq ? qn : kn;
    float ss = 0.f;
    for (int d = 0; d < 64; ++d) ss += bf2f(v[d]) * bf2f(v[d]);
    const float r = 1.0f / sqrtf(ss / 64.0f + EPS);
    if (t < TCTX) {
      for (int d = 0; d < 64; ++d) { const float y = bf2f(v[d]) * r * w[d]; v[d] = f2bf(y); if (s >= nq) kout[(long)t * (nk * 64) + (s - nq) * 64 + d] = y; }
    } else {
      const int pos = (t - TCTX) % DEC_SEQ; const float prow = (float)(pos / 64), pcol = (float)(pos % 64);
      for (int a = 0; a < 2; ++a)
        for (int f = 0; f < 16; ++f) {
          const float inv = powf(10000.0f, -(float)(2 * f) / 32.0f), ang = (a == 0 ? prow : pcol) * inv, cs = cosf(ang), sn = sinf(ang);
          const int i1 = a * 32 + f, i2 = a * 32 + 16 + f; const float x1 = bf2f(v[i1]) * r * w[i1], x2 = bf2f(v[i2]) * r * w[i2];
          v[i1] = f2bf(x1 * cs - x2 * sn); v[i2] = f2bf(x2 * cs + x1 * sn);
        }
    }
  }
}

__device__ void nk_copy_cols_f(const bf16_t* S, int ld, int col0, int width, int rows, float* out) {
  GRID_STRIDE(i, (long)rows * width) { const int t = (int)(i / width), j = (int)(i % width); out[i] = bf2f(S[(long)t * ld + col0 + j]); }
}

__device__ __forceinline__ float dot64_bb(const bf16_t* a, const bf16_t* b) {
  float s = 0.f;
  for (int d = 0; d < 64; ++d) s += bf2f(a[d]) * bf2f(b[d]);
  return s;
}
__device__ __forceinline__ float dot64_bf(const bf16_t* a, const float* b) {
  float s = 0.f;
  for (int d = 0; d < 64; ++d) s += bf2f(a[d]) * bf2f(f2bf(b[d]));
  return s;
}

template <int MODE>
__device__ void nk_attn(const bf16_t* QKV, int ld, int kcol0, int vcol0, const float* ck, const float* cv, int cld,
                        const float* sink, const float* lq1, const float* lk1, const float* lq2, const float* lk2, float lam_init, bf16_t* O) {
  GRID_STRIDE(i, (long)T * 64) {
    const int t = (int)(i / 64), r = (int)(i % 64); const bool lat = t >= TCTX; int s0, L; tok_seq(t, s0, L);
    const int b = lat ? (t - TCTX) / DEC_SEQ : 0, ncache = lat ? PAST : 0;
    int jlo = 0, jhi = L - 1;
    if (MODE == 1 && lat) { const int pos = t - s0; jlo = pos - 128 < 0 ? 0 : pos - 128; jhi = pos + 128 > L - 1 ? L - 1 : pos + 128; }
    if (MODE != 2) {
      const int h = r / 4, ch = r % 4, koff = (h / 4) * 64, voff = (h / 4) * 64 + ch * 16; const bf16_t* q = QKV + (long)t * ld + h * 64;
      float m = -3.0e38f;
      for (int p = 0; p < ncache; ++p) m = fmaxf(m, dot64_bf(q, ck + (long)(b * PAST + p) * cld + koff) * 0.125f);
      for (int j = jlo; j <= jhi; ++j) m = fmaxf(m, dot64_bb(q, QKV + (long)(s0 + j) * ld + kcol0 + koff) * 0.125f);
      if (MODE == 1) m = fmaxf(m, sink[h]);
      float sum = 0.f, o[16];
#pragma unroll
      for (int e = 0; e < 16; ++e) o[e] = 0.f;
      for (int p = 0; p < ncache; ++p) {
        const float pr = expf(dot64_bf(q, ck + (long)(b * PAST + p) * cld + koff) * 0.125f - m); sum += pr; const float* v = cv + (long)(b * PAST + p) * cld + voff;
#pragma unroll
        for (int e = 0; e < 16; ++e) o[e] += pr * v[e];
      }
      for (int j = jlo; j <= jhi; ++j) {
        const float pr = expf(dot64_bb(q, QKV + (long)(s0 + j) * ld + kcol0 + koff) * 0.125f - m); sum += pr; const bf16_t* v = QKV + (long)(s0 + j) * ld + vcol0 + voff;
#pragma unroll
        for (int e = 0; e < 16; ++e) o[e] += pr * bf2f(v[e]);
      }
      if (MODE == 1) sum += expf(sink[h] - m);
#pragma unroll
      for (int e = 0; e < 16; ++e) O[(long)t * D + h * 64 + ch * 16 + e] = f2bf(o[e] / sum);
    } else {
      float d1 = 0.f, d2 = 0.f;
      for (int d = 0; d < 64; ++d) { d1 += lq1[d] * lk1[d]; d2 += lq2[d] * lk2[d]; }
      const float lam = expf(d1) - expf(d2) + lam_init;
      const int hd = r / 8, ch = r % 8, voff = hd * 128 + ch * 16; float res[16];
#pragma unroll
      for (int e = 0; e < 16; ++e) res[e] = 0.f;
      for (int c = 0; c < 2; ++c) {
        const int koff = hd * 128 + c * 64; const bf16_t* q = QKV + (long)t * ld + koff;
        float m = -3.0e38f;
        for (int p = 0; p < ncache; ++p) m = fmaxf(m, dot64_bf(q, ck + (long)(b * PAST + p) * cld + koff) * 0.125f);
        for (int j = jlo; j <= jhi; ++j) m = fmaxf(m, dot64_bb(q, QKV + (long)(s0 + j) * ld + kcol0 + koff) * 0.125f);
        float sum = 0.f, o[16];
#pragma unroll
        for (int e = 0; e < 16; ++e) o[e] = 0.f;
        for (int p = 0; p < ncache; ++p) {
          const float pr = expf(dot64_bf(q, ck + (long)(b * PAST + p) * cld + koff) * 0.125f - m); sum += pr; const float* v = cv + (long)(b * PAST + p) * cld + voff;
#pragma unroll
          for (int e = 0; e < 16; ++e) o[e] += pr * v[e];
        }
        for (int j = jlo; j <= jhi; ++j) {
          const float pr = expf(dot64_bb(q, QKV + (long)(s0 + j) * ld + kcol0 + koff) * 0.125f - m); sum += pr; const bf16_t* v = QKV + (long)(s0 + j) * ld + vcol0 + voff;
#pragma unroll
          for (int e = 0; e < 16; ++e) o[e] += pr * bf2f(v[e]);
        }
        const float f = (c == 0 ? 1.0f : -lam) / sum;
#pragma unroll
        for (int e = 0; e < 16; ++e) res[e] += f * o[e];
      }
#pragma unroll
      for (int e = 0; e < 16; ++e) O[(long)t * D + voff + e] = f2bf(res[e]);
    }
  }
}

__device__ void nk_subnorm(bf16_t* O, const float* sub_g, float factor) {
  GRID_STRIDE(i, (long)T * 8) {
    bf16_t* o = O + i * 128; float ss = 0.f;
    for (int e = 0; e < 128; ++e) ss += bf2f(o[e]) * bf2f(o[e]);
    const float r = factor / sqrtf(ss / 128.0f + EPS);
    for (int e = 0; e < 128; ++e) o[e] = f2bf(bf2f(o[e]) * r * sub_g[e]);
  }
}

__device__ void nk_convgate(const bf16_t* U, const float* cw, const float* cb, bf16_t* G) {
  GRID_STRIDE(i, (long)T * DFF) {
    const int t = (int)(i / DFF), f = (int)(i % DFF); int s0, L; tok_seq(t, s0, L); const int pos = t - s0; float uc[2];
#pragma unroll
    for (int hf = 0; hf < 2; ++hf) {
      const int col = hf * DFF + f; const bf16_t* u = U + (long)t * DFF2 + col;
      float a = bf2f(u[0]) * cw[DFF2 + col] + cb[col];
      if (pos > 0) a += bf2f(u[-DFF2]) * cw[col];
      if (pos < L - 1) a += bf2f(u[DFF2]) * cw[2 * DFF2 + col];
      uc[hf] = a;
    }
    G[i] = f2bf(silu_f(uc[0]) * uc[1]);
  }
}

#ifndef HOST_EMU
#ifndef USE_ENGINE
#define USE_ENGINE 1
#endif
namespace pg8 {
#define PG8_LAS __attribute__((address_space(3)))
typedef unsigned short bf16_t;
typedef short bf16x8 __attribute__((ext_vector_type(8)));
typedef float f32x4 __attribute__((ext_vector_type(4)));
typedef unsigned u32x4 __attribute__((ext_vector_type(4)));
typedef unsigned u32x2v __attribute__((ext_vector_type(2)));
constexpr int BM = 256, BK = 64, HALF = 128, HTB = HALF * BK * 2  , STAGE_BYTES = 8 * HTB, NXCD = 8, WGM = 8;

__host__ __device__ __forceinline__ int lds_byte(int r, int c) { const int st = (r >> 4) * 2 + (c >> 5), rr = r & 15, cc = c & 31, ob = rr * 64 + cc * 2; return st * 1024 + (ob ^ (((ob >> 9) & 1) << 5)); }
__host__ __device__ __forceinline__ void stage_rc(int b, int& R, int& C) { const int st = b / 1024, sb = b % 1024, swz = sb ^ (((sb >> 9) & 1) << 5); R = (st >> 1) * 16 + swz / 64; C = (st & 1) * 32 + (swz % 64) / 2; }
__host__ __device__ __forceinline__ int perm32(int rho) { const int n = rho >> 4, i = rho & 15; return 8 * (i >> 2) + 4 * n + (i & 3); }

struct Unit { int pm, pn, kh; };
struct Gemm { const bf16_t* A; const bf16_t* Bt; int M, N, K, lda, ldb, a_pn_step, ksplit; };

struct StaticOrder {
    int nM, nN, nwg, G, c, ks;
    __host__ __device__ __forceinline__ void init(int M, int N, int G_, int c_, int ks_ = 1) { nM = M / BM; nN = (N / BM) * ks_; nwg = nM * nN; G = G_; c = c_; ks = ks_; }
    __host__ __device__ __forceinline__ bool next(int i, Unit& u) const {
        const long L = (long)i * G + c; if (L >= nwg) return false;
        int wgid = (int)L; { const int q = nwg / NXCD, r = nwg % NXCD, xcd = wgid % NXCD, off = wgid / NXCD; wgid = (xcd < r ? xcd * (q + 1) : r * (q + 1) + (xcd - r) * q) + off; }
        const int nig = WGM * nN, gid = wgid / nig, fm = gid * WGM, gsz = (nM - fm) < WGM ? (nM - fm) : WGM;
        u.pm = fm + ((wgid % nig) % gsz); const int pv = (wgid % nig) / gsz; u.kh = pv % ks; u.pn = pv / ks; return true;
    }
    __device__ __forceinline__ void a_ready(const Unit&) const {}
    __device__ __forceinline__ void done(const Unit&) const {}
};

struct LimitedOrder : StaticOrder {
    int maxr;
    __host__ __device__ __forceinline__ bool next(int i, Unit& u) const { return i < maxr && StaticOrder::next(i, u); }
};

__device__ __forceinline__ unsigned cvt_pk_bf16(float lo, float hi) { unsigned r; asm volatile("v_cvt_pk_bf16_f32 %0, %1, %2" : "=v"(r) : "v"(lo), "v"(hi)); return r; }
typedef float f32x2 __attribute__((ext_vector_type(2)));
__device__ __forceinline__ f32x2 gelu_pk(f32x2 v) {
    const f32x2 av = __builtin_elementwise_abs(v), d = av * 0.2316418882f + 1.0f;
    f32x2 t; t.x = __builtin_amdgcn_rcpf(d.x); t.y = __builtin_amdgcn_rcpf(d.y);
    f32x2 q = t * 0.5307027145f + (-0.7265760135f); q = q * t + 0.7107068705f; q = q * t + (-0.142248368f); q = q * t + 0.127414796f; q = q * t;
    const f32x2 s = (v * v) * (-0.72134752044f);
    f32x2 e; e.x = __builtin_amdgcn_exp2f(s.x); e.y = __builtin_amdgcn_exp2f(s.y);
    const f32x2 m = v * (q * e), r = v - m;
    f32x2 o; o.x = v.x < 0.f ? m.x : r.x; o.y = v.y < 0.f ? m.y : r.y; return o;
}

template <int ACT  > struct EpiBf16 {
    static constexpr bool PERM = true, AFTER_DRAIN = false; static_assert(ACT == 0 || ACT == 1, "EpiBf16: ACT is 0 (none) or 1 (gelu_pk)");
    bf16_t* O; int ldc; const float* bias; int split_cols; size_t split_stride; float scale0;
    __device__ __forceinline__ void operator()(const f32x4 (&acc)[2][2][4][2], const Unit& u, int wr, int wc, int fr, int fq) const {
        const int row0 = u.pm * BM + wr * 64 + fr; int colt = u.pn * BM; bf16_t* base = O;
        float sc = 1.f; if (split_cols) { const int t = colt / split_cols; base += (size_t)t * split_stride; colt -= t * split_cols; if (t == 0) sc = scale0; }
        const int col0 = colt + wc * 32 + 8 * fq, bcol0 = u.pn * BM + wc * 32 + 8 * fq;
        f32x4 bv[2][2];
#pragma unroll
        for (int bj = 0; bj < 2; ++bj)
#pragma unroll
            for (int n = 0; n < 2; ++n) bv[bj][n] = bias ? *(const f32x4*)(bias + bcol0 + bj * HALF + 4 * n) : (f32x4){0.f, 0.f, 0.f, 0.f};
#pragma unroll
        for (int ai = 0; ai < 2; ++ai)
#pragma unroll
            for (int m = 0; m < 4; ++m) { bf16_t* rowp = base + (size_t)(row0 + ai * HALF + m * 16) * ldc + col0;
#pragma unroll
                for (int bj = 0; bj < 2; ++bj) { f32x4 v0 = acc[ai][bj][m][0] + bv[bj][0], v1 = acc[ai][bj][m][1] + bv[bj][1];
                    if (ACT == 1) { f32x2 a = gelu_pk((f32x2){v0[0], v0[1]}), b = gelu_pk((f32x2){v0[2], v0[3]}), c = gelu_pk((f32x2){v1[0], v1[1]}), d = gelu_pk((f32x2){v1[2], v1[3]});
                        v0 = (f32x4){a.x, a.y, b.x, b.y}; v1 = (f32x4){c.x, c.y, d.x, d.y}; }
                    v0 = v0 * sc; v1 = v1 * sc; u32x4 w; w.x = cvt_pk_bf16(v0[0], v0[1]); w.y = cvt_pk_bf16(v0[2], v0[3]); w.z = cvt_pk_bf16(v1[0], v1[1]); w.w = cvt_pk_bf16(v1[2], v1[3]);
                    *(u32x4*)(rowp + bj * HALF) = w; } }
    }
};

struct EpiRes {
    static constexpr bool PERM = false, AFTER_DRAIN = false;
    float* X; const float* Xin_c; const float* Xin_l; const float* MODl; int gate_chunk; const float* colscale; const bf16_t* pend; bf16_t* slab;
    __device__ __forceinline__ void operator()(const f32x4 (&acc)[2][2][4][2], const Unit& u, int wr, int wc, int fr, int fq) const {
        const int row0 = u.pm * BM + wr * 64 + fr, col0 = u.pn * BM + wc * 32 + 4 * fq;
        const int trow = u.pm * BM; const int cond = trow < TCTX ? 0 : 1 + (trow - TCTX) / DEC_SEQ;
        const float* gate = MODl + (size_t)cond * MODW + gate_chunk * D;
        f32x4 gv[2][2];
#pragma unroll
        for (int bj = 0; bj < 2; ++bj)
#pragma unroll
            for (int n = 0; n < 2; ++n) { gv[bj][n] = *(const f32x4*)(gate + col0 + bj * HALF + n * 16); if (colscale) gv[bj][n] = gv[bj][n] * *(const f32x4*)(colscale + col0 + bj * HALF + n * 16); }
        if (u.kh == 0) {
          const float* xin = trow < TCTX ? Xin_c : Xin_l;
          f32x4 xb[2][2][2]; u32x2v pb[2][2][2];
#define EPIRES_LOAD(gi_, buf_) do { const size_t off_ = (size_t)(row0 + ((gi_) >> 2) * HALF + ((gi_) & 3) * 16) * D + col0; \
            _Pragma("unroll") for (int bj = 0; bj < 2; ++bj) _Pragma("unroll") for (int n = 0; n < 2; ++n) { xb[buf_][bj][n] = *(const f32x4*)(xin + off_ + bj * HALF + n * 16); \
              if (pend) pb[buf_][bj][n] = *(const u32x2v*)(pend + off_ + bj * HALF + n * 16); } } while (0)
          EPIRES_LOAD(0, 0);
#pragma unroll
          for (int gi = 0; gi < 8; ++gi) {
            if (gi + 1 < 8) { if ((gi & 1) == 0) EPIRES_LOAD(gi + 1, 1); else EPIRES_LOAD(gi + 1, 0); }
            asm volatile("" ::: "memory");
            const int ai = gi >> 2, m = gi & 3; const size_t off = (size_t)(row0 + ai * HALF + m * 16) * D + col0;
#pragma unroll
            for (int bj = 0; bj < 2; ++bj)
#pragma unroll
              for (int n = 0; n < 2; ++n) { f32x4 v = xb[gi & 1][bj][n] + gv[bj][n] * acc[ai][bj][m][n];
                if (pend) { const u32x2v q = pb[gi & 1][bj][n]; v = v + (f32x4){__uint_as_float(q.x << 16), __uint_as_float(q.x & 0xffff0000u), __uint_as_float(q.y << 16), __uint_as_float(q.y & 0xffff0000u)}; }
                *(f32x4*)(X + off + bj * HALF + n * 16) = v; }
          }
#undef EPIRES_LOAD
        } else {
#pragma unroll
          for (int ai = 0; ai < 2; ++ai)
#pragma unroll
            for (int m = 0; m < 4; ++m) { const size_t off = (size_t)(row0 + ai * HALF + m * 16) * D + col0;
#pragma unroll
                for (int bj = 0; bj < 2; ++bj)
#pragma unroll
                    for (int n = 0; n < 2; ++n) { const f32x4 v = gv[bj][n] * acc[ai][bj][m][n]; u32x2v q; q.x = cvt_pk_bf16(v[0], v[1]); q.y = cvt_pk_bf16(v[2], v[3]); *(u32x2v*)(slab + off + bj * HALF + n * 16) = q; } }
        }
    }
};

struct EpiConv {
    static constexpr bool PERM = true, AFTER_DRAIN = false;
    bf16_t* G; const float* cw; const float* cb; float* edgebuf; PG8_LAS unsigned* E;
    __device__ __forceinline__ static unsigned perm(unsigned v, int src4) { return (unsigned)__builtin_amdgcn_ds_bpermute(src4, (int)v); }
    __device__ __forceinline__ static float lo(unsigned u) { return __uint_as_float(u << 16); }
    __device__ __forceinline__ static float hi(unsigned u) { return __uint_as_float(u & 0xffff0000u); }
    __device__ __forceinline__ void operator()(const f32x4 (&acc)[2][2][4][2], const Unit& u, int wr, int wc, int fr_in, int fq_in) const {
        int fr = fr_in, fq = fq_in; asm volatile("" : "+v"(fr), "+v"(fq));
        const int lane = fq * 16 + fr, srcP4 = ((lane & 48) | ((fr + 15) & 15)) << 2, srcN4 = ((lane & 48) | ((fr + 1) & 15)) << 2;
        const int lc = wc * 32 + 8 * fq;
        unsigned pk[2][2][4][4];
#pragma unroll
        for (int ai = 0; ai < 2; ++ai)
#pragma unroll
          for (int bj = 0; bj < 2; ++bj)
#pragma unroll
            for (int m = 0; m < 4; ++m)
#pragma unroll
              for (int n = 0; n < 2; ++n) { const f32x4 v = acc[ai][bj][m][n]; pk[ai][bj][m][2 * n] = cvt_pk_bf16(v[0], v[1]); pk[ai][bj][m][2 * n + 1] = cvt_pk_bf16(v[2], v[3]); }
        if (fr == 0 || fr == 15) { const int which = fr == 0 ? 0 : 1;
#pragma unroll
          for (int ai = 0; ai < 2; ++ai)
#pragma unroll
            for (int bj = 0; bj < 2; ++bj) { u32x4 w;
              if (fr == 0) { w.x = pk[ai][bj][0][0]; w.y = pk[ai][bj][0][1]; w.z = pk[ai][bj][0][2]; w.w = pk[ai][bj][0][3]; } else { w.x = pk[ai][bj][3][0]; w.y = pk[ai][bj][3][1]; w.z = pk[ai][bj][3][2]; w.w = pk[ai][bj][3][3]; }
              *(PG8_LAS u32x4*)(E + (((ai * 2 + wr) * 2 + which) * 2 + bj) * 64 + (lc >> 1)) = w; } }
        if (u.pm * BM >= TCTX) { const bool top = (wr == 0 && fr < 2), bot = (wr == 1 && fr >= 14);
          if (top || bot) { const int r4 = top ? fr : fr - 12; float* eb = edgebuf + ((size_t)((u.pm - TCTX / BM) * (DFF / 128) + u.pn) * 4 + r4) * 256 + lc;
#pragma unroll
            for (int bj = 0; bj < 2; ++bj) { unsigned q0, q1, q2, q3;
              if (top) { q0 = pk[0][bj][0][0]; q1 = pk[0][bj][0][1]; q2 = pk[0][bj][0][2]; q3 = pk[0][bj][0][3]; } else { q0 = pk[1][bj][3][0]; q1 = pk[1][bj][3][1]; q2 = pk[1][bj][3][2]; q3 = pk[1][bj][3][3]; }
              *(f32x4*)(eb + bj * 128) = (f32x4){lo(q0), hi(q0), lo(q1), hi(q1)}; *(f32x4*)(eb + bj * 128 + 4) = (f32x4){lo(q2), hi(q2), lo(q3), hi(q3)}; } } }
        asm volatile("s_waitcnt lgkmcnt(0)" ::: "memory"); __builtin_amdgcn_s_barrier(); asm volatile("" ::: "memory");
        const int gcol = u.pn * 128 + lc;
        float w0a[2][8], w1a[2][8], w2a[2][8], bba[2][8];
#pragma unroll
        for (int bj = 0; bj < 2; ++bj) { const int col = bj * DFF + gcol;
#pragma unroll
          for (int e = 0; e < 8; e += 4) { const f32x4 a0 = *(const f32x4*)(cw + col + e), a1 = *(const f32x4*)(cw + DFF2 + col + e), a2 = *(const f32x4*)(cw + 2 * DFF2 + col + e), a3 = *(const f32x4*)(cb + col + e);
#pragma unroll
            for (int q = 0; q < 4; ++q) { w0a[bj][e + q] = a0[q]; w1a[bj][e + q] = a1[q]; w2a[bj][e + q] = a2[q]; bba[bj][e + q] = a3[q]; } } }
#pragma unroll
        for (int ai = 0; ai < 2; ++ai) {
          float ca[4][8];
#pragma unroll
          for (int bj = 0; bj < 2; ++bj) {
            const float (&w0)[8] = w0a[bj]; const float (&w1)[8] = w1a[bj]; const float (&w2)[8] = w2a[bj]; const float (&bb)[8] = bba[bj];
            u32x4 eP = (u32x4){0u, 0u, 0u, 0u}, eN = (u32x4){0u, 0u, 0u, 0u};
            if (wr == 1) eP = *(const PG8_LAS u32x4*)(E + (((ai * 2 + 0) * 2 + 1) * 2 + bj) * 64 + (lc >> 1));
            else if (ai == 1) eP = *(const PG8_LAS u32x4*)(E + (((0 * 2 + 1) * 2 + 1) * 2 + bj) * 64 + (lc >> 1));
            if (wr == 0) eN = *(const PG8_LAS u32x4*)(E + (((ai * 2 + 1) * 2 + 0) * 2 + bj) * 64 + (lc >> 1));
            else if (ai == 0) eN = *(const PG8_LAS u32x4*)(E + (((1 * 2 + 0) * 2 + 0) * 2 + bj) * 64 + (lc >> 1));
            unsigned spm1[4] = {eP.x, eP.y, eP.z, eP.w}, sn0[4];
#pragma unroll
            for (int h = 0; h < 4; ++h) sn0[h] = perm(pk[ai][bj][0][h], srcN4);
#pragma unroll
            for (int m = 0; m < 4; ++m) {
              unsigned sp[4], sn1[4] = {eN.x, eN.y, eN.z, eN.w};
#pragma unroll
              for (int h = 0; h < 4; ++h) { sp[h] = perm(pk[ai][bj][m][h], srcP4); if (m < 3) sn1[h] = perm(pk[ai][bj][m < 3 ? m + 1 : 3][h], srcN4); }
#pragma unroll
              for (int h = 0; h < 4; ++h) {
                const unsigned pv = fr == 0 ? spm1[h] : sp[h], nx = fr == 15 ? sn1[h] : sn0[h], cu = pk[ai][bj][m][h];
                const float c0 = lo(cu) * w1[2 * h] + bb[2 * h] + lo(pv) * w0[2 * h] + lo(nx) * w2[2 * h];
                const float c1 = hi(cu) * w1[2 * h + 1] + bb[2 * h + 1] + hi(pv) * w0[2 * h + 1] + hi(nx) * w2[2 * h + 1];
                if (bj == 0) { ca[m][2 * h] = c0; ca[m][2 * h + 1] = c1; }
                else { ca[m][2 * h] = ca[m][2 * h] / (1.0f + __expf(-ca[m][2 * h])) * c0; ca[m][2 * h + 1] = ca[m][2 * h + 1] / (1.0f + __expf(-ca[m][2 * h + 1])) * c1; }
                spm1[h] = sp[h]; sn0[h] = sn1[h];
              }
              if (bj == 1) { u32x4 w; w.x = cvt_pk_bf16(ca[m][0], ca[m][1]); w.y = cvt_pk_bf16(ca[m][2], ca[m][3]); w.z = cvt_pk_bf16(ca[m][4], ca[m][5]); w.w = cvt_pk_bf16(ca[m][6], ca[m][7]);
                *(u32x4*)(G + (size_t)(u.pm * BM + ai * HALF + wr * 64 + m * 16 + fr) * DFF + gcol) = w; }
            }
            asm volatile("" ::: "memory");
          }
        }
    }
};

struct EpiQK {
    static constexpr bool PERM = true, AFTER_DRAIN = false;
    bf16_t* O; int ldc, kcol0, vcol0; const float* qn; const float* kn; const float* rope; float* kout; float* vout; int kow; PG8_LAS float* SS;
    __device__ __forceinline__ static float perm(float v, int src4) { return __int_as_float(__builtin_amdgcn_ds_bpermute(src4, __float_as_int(v))); }
    __device__ __forceinline__ void operator()(const f32x4 (&acc)[2][2][4][2], const Unit& u, int wr, int wc, int fr_in, int fq_in) const {
        int fr = fr_in, fq = fq_in; asm volatile("" : "+v"(fr), "+v"(fq));
        const int lane = fq * 16 + fr, x16 = (lane ^ 16) << 2, x32 = (lane ^ 32) << 2;
        const int colt = u.pn * BM, kind = colt < kcol0 ? 0 : (colt < vcol0 ? 1 : 2);
        const bool lat = u.pm * BM >= TCTX;
        float ss[2][2][4];
        if (kind != 2) {
#pragma unroll
          for (int ai = 0; ai < 2; ++ai)
#pragma unroll
            for (int bj = 0; bj < 2; ++bj)
#pragma unroll
              for (int m = 0; m < 4; ++m) { const f32x4 a0 = acc[ai][bj][m][0], a1 = acc[ai][bj][m][1];
                float t = (a0[0] * a0[0] + a0[1] * a0[1]) + (a0[2] * a0[2] + a0[3] * a0[3]) + (a1[0] * a1[0] + a1[1] * a1[1]) + (a1[2] * a1[2] + a1[3] * a1[3]);
                t += perm(t, x16); t += perm(t, x32); ss[ai][bj][m] = t;
                if (fq == 0) SS[(((wr * 4 + wc) * 2 + ai) * 2 + bj) * 64 + m * 16 + fr] = t; }
        }
        asm volatile("s_waitcnt lgkmcnt(0)" ::: "memory"); __builtin_amdgcn_s_barrier(); asm volatile("" ::: "memory");
        const int dh = 32 * (wc & 1) + 8 * fq;
        f32x4 w0 = (f32x4){1.f, 1.f, 1.f, 1.f}, w1 = w0;
        if (kind != 2) { const float* wp = (kind == 0 ? qn : kn) + dh; w0 = *(const f32x4*)wp; w1 = *(const f32x4*)(wp + 4); }
        const bool x2side = (fq & 2) != 0;
        float rinv[8];
#pragma unroll
        for (int e = 0; e < 8; ++e) rinv[e] = __builtin_amdgcn_exp2f(-(float)(8 * (fq & 1) + e) * (13.287712379549449f / 16.0f)) * 0.15915494309189535f;
#pragma unroll
        for (int ai = 0; ai < 2; ++ai)
#pragma unroll
          for (int m = 0; m < 4; ++m) {
            const int row = u.pm * BM + ai * HALF + wr * 64 + m * 16 + fr;
#pragma unroll
            for (int bj = 0; bj < 2; ++bj) {
              float y[8]; { const f32x4 a0 = acc[ai][bj][m][0], a1 = acc[ai][bj][m][1]; y[0] = a0[0]; y[1] = a0[1]; y[2] = a0[2]; y[3] = a0[3]; y[4] = a1[0]; y[5] = a1[1]; y[6] = a1[2]; y[7] = a1[3]; }
              if (kind != 2) {
                const float tot = ss[ai][bj][m] + SS[(((wr * 4 + (wc ^ 1)) * 2 + ai) * 2 + bj) * 64 + m * 16 + fr];
                const float r = 1.0f / sqrtf(tot / 64.0f + EPS);
                y[0] *= r * w0[0]; y[1] *= r * w0[1]; y[2] *= r * w0[2]; y[3] *= r * w0[3]; y[4] *= r * w1[0]; y[5] *= r * w1[1]; y[6] *= r * w1[2]; y[7] *= r * w1[3];
                if (lat) { const int pos = (row - TCTX) % DEC_SEQ; const float posa = (float)((wc & 1) ? (pos & 63) : (pos >> 6));
#pragma unroll
                  for (int e = 0; e < 8; ++e) { const float rev = posa * rinv[e], cs = __builtin_amdgcn_cosf(rev), sn = __builtin_amdgcn_sinf(rev), pp = perm(y[e], x32);
                    y[e] = x2side ? y[e] * cs + pp * sn : y[e] * cs - pp * sn; } }
              }
              const int cl = bj * HALF + wc * 32 + 8 * fq;
              u32x4 w; w.x = cvt_pk_bf16(y[0], y[1]); w.y = cvt_pk_bf16(y[2], y[3]); w.z = cvt_pk_bf16(y[4], y[5]); w.w = cvt_pk_bf16(y[6], y[7]);
              *(u32x4*)(O + (size_t)row * ldc + colt + cl) = w;
              if (!lat && kind != 0) { float* op = (kind == 1 ? kout + (size_t)row * kow + (colt - kcol0) : vout + (size_t)row * kow + (colt - vcol0)) + cl;
                *(f32x4*)op = (f32x4){y[0], y[1], y[2], y[3]}; *(f32x4*)(op + 4) = (f32x4){y[4], y[5], y[6], y[7]}; }
            }
          }
    }
};

template <class Epi, class Sched, bool ALIGN_EPI = false, bool SP2 = false>
__device__ __forceinline__ void gemm_phase(PG8_LAS unsigned char* lds, const Gemm g, const Sched& S, const Epi& E) {
    int tid_ = threadIdx.x; asm volatile("" : "+v"(tid_));
    const int tid = tid_, wid = __builtin_amdgcn_readfirstlane(tid >> 6), lane = tid & 63, wr = wid >> 2, wc = wid & 3, fr = lane & 15, fq = lane >> 4;
    const int K = g.K / g.ksplit, nt = K / BK;
    unsigned voffA[2], voffB[2];
#pragma unroll
    for (int i = 0; i < 2; ++i) { int R, C; stage_rc(tid * 16 + i * 8192, R, C); const int Rb = Epi::PERM ? ((R & ~31) + perm32(R & 31)) : R;
        voffA[i] = (unsigned)(R * g.lda + C) * 2u; voffB[i] = (unsigned)(Rb * g.ldb + C) * 2u; }
    const size_t kstep = (size_t)(BK * 2);
    const size_t hstepA = (size_t)HALF * g.lda * 2, hstepB = (size_t)HALF * g.ldb * 2;
    const size_t tstepA = 2 * hstepA, tstepB = 2 * hstepB, pnstepA = (size_t)g.a_pn_step * 2, khstep = (size_t)K * 2;
    const unsigned ldsw = (unsigned)wid * 1024u;
    const int aoff = lds_byte(wr * 64 + fr, fq * 8), boff = lds_byte(wc * 32 + fr, fq * 8);
#define PG8_SA(b, h) (((b) * 2 + (h)) * HTB)
#define PG8_SB(b, h) ((4 + (b) * 2 + (h)) * HTB)
#define PG8_STAGE(bufoff, gbase, voff) do { _Pragma("unroll") for (int _i = 0; _i < 2; ++_i) \
        __builtin_amdgcn_global_load_lds((const unsigned*)((const char*)(gbase) + (voff)[_i]), (PG8_LAS unsigned*)(lds + (bufoff) + ldsw + _i * 8192), 16, 0, 0); } while (0)
#define PG8_LDA(dst, b, h) do { _Pragma("unroll") for (int m = 0; m < 4; ++m) _Pragma("unroll") for (int k = 0; k < 2; ++k) dst[m][k] = *(const PG8_LAS bf16x8*)(lds + PG8_SA(b, h) + aoff + m * 2048 + k * 1024); } while (0)
#define PG8_LDB(dst, b, h) do { _Pragma("unroll") for (int n = 0; n < 2; ++n) _Pragma("unroll") for (int k = 0; k < 2; ++k) dst[n][k] = *(const PG8_LAS bf16x8*)(lds + PG8_SB(b, h) + boff + n * 2048 + k * 1024); } while (0)
#define PG8_MMA(ai, bj, At, Bt) do { __builtin_amdgcn_s_setprio(1); _Pragma("unroll") for (int m = 0; m < 4; ++m) _Pragma("unroll") for (int n = 0; n < 2; ++n) _Pragma("unroll") for (int k = 0; k < 2; ++k) \
        acc[ai][bj][m][n] = __builtin_amdgcn_mfma_f32_16x16x32_bf16(Bt[n][k], At[m][k], acc[ai][bj][m][n], 0, 0, 0); __builtin_amdgcn_s_setprio(0); } while (0)
#define PG8_WAIT_V(n) asm volatile("s_waitcnt vmcnt(" #n ")" ::: "memory")
#define PG8_WAIT_L(n) asm volatile("s_waitcnt lgkmcnt(" #n ")" ::: "memory")
#define PG8_BAR __builtin_amdgcn_s_barrier()
#define PG8_SCHED __builtin_amdgcn_sched_barrier(0)
    Unit cur, nxt; int ui = 0;
    if (!S.next(0, cur)) return;
    f32x4 acc[2][2][4][2];
#pragma unroll
    for (int a = 0; a < 2; ++a)
#pragma unroll
        for (int b = 0; b < 2; ++b)
#pragma unroll
            for (int m = 0; m < 4; ++m)
#pragma unroll
                for (int n = 0; n < 2; ++n) acc[a][b][m][n] = (f32x4){0.f, 0.f, 0.f, 0.f};
    bf16x8 At[4][2], B0[2][2], B1[2][2];
    const char* cA = (const char*)g.A + (size_t)cur.pm * tstepA + (size_t)cur.pn * pnstepA + (size_t)cur.kh * khstep; const char* cB = (const char*)g.Bt + (size_t)cur.pn * tstepB + (size_t)cur.kh * khstep;
    S.a_ready(cur);
    if constexpr (SP2) {
        PG8_STAGE(PG8_SB(0, 0), cB, voffB); PG8_STAGE(PG8_SB(0, 1), cB + hstepB, voffB); PG8_STAGE(PG8_SA(0, 0), cA, voffA); PG8_STAGE(PG8_SA(0, 1), cA + hstepA, voffA);
        if (wr == 1) PG8_BAR;
        PG8_WAIT_V(2); PG8_BAR;
        PG8_STAGE(PG8_SB(1, 0), cB + kstep, voffB); PG8_STAGE(PG8_SA(1, 0), cA + kstep, voffA); PG8_STAGE(PG8_SB(1, 1), cB + hstepB + kstep, voffB);
        PG8_WAIT_V(6); PG8_BAR;
    } else {
        PG8_STAGE(PG8_SB(0, 0), cB, voffB); PG8_STAGE(PG8_SA(0, 0), cA, voffA); PG8_STAGE(PG8_SB(0, 1), cB + hstepB, voffB); PG8_STAGE(PG8_SA(0, 1), cA + hstepA, voffA);
        if (wr == 1) PG8_BAR;
        PG8_WAIT_V(4); PG8_BAR;
        PG8_STAGE(PG8_SB(1, 0), cB + kstep, voffB); PG8_STAGE(PG8_SA(1, 0), cA + kstep, voffA); PG8_STAGE(PG8_SB(1, 1), cB + hstepB + kstep, voffB);
        PG8_WAIT_V(6); PG8_BAR;
    }
    for (;;) {
        const bool has_next = S.next(ui + 1, nxt);
        const char* nA = has_next ? (const char*)g.A + (size_t)nxt.pm * tstepA + (size_t)nxt.pn * pnstepA + (size_t)nxt.kh * khstep : cA; const char* nB = has_next ? (const char*)g.Bt + (size_t)nxt.pn * tstepB + (size_t)nxt.kh * khstep : cB;
        for (int t = 0; t < nt; t += 2) {
            const bool last = (t == nt - 2);
            const char* a1 = cA + (size_t)(t + 1) * kstep;
            const char* a2 = last ? nA : cA + (size_t)(t + 2) * kstep; const char* b2 = last ? nB : cB + (size_t)(t + 2) * kstep;
            const char* a3 = a2 + kstep; const char* b3 = b2 + kstep;
            if (last && has_next) S.a_ready(nxt);
            if constexpr (SP2) {
            PG8_LDB(B0, 0, 0); PG8_LDB(B1, 0, 1); PG8_SCHED; PG8_LDA(At, 0, 0); PG8_STAGE(PG8_SA(1, 1), a1 + hstepA, voffA);
            PG8_WAIT_V(8); PG8_WAIT_L(0); PG8_BAR; PG8_MMA(0, 0, At, B0); PG8_MMA(0, 1, At, B1); PG8_BAR; PG8_SCHED;
            PG8_LDA(At, 0, 1); PG8_STAGE(PG8_SB(0, 0), b2, voffB); PG8_STAGE(PG8_SB(0, 1), b2 + hstepB, voffB); PG8_STAGE(PG8_SA(0, 0), a2, voffA);
            PG8_WAIT_V(8); PG8_WAIT_L(0); PG8_BAR; PG8_MMA(1, 0, At, B0); PG8_MMA(1, 1, At, B1); PG8_BAR; PG8_SCHED;
            PG8_LDB(B0, 1, 0); PG8_LDB(B1, 1, 1); PG8_SCHED; PG8_LDA(At, 1, 0); PG8_STAGE(PG8_SA(0, 1), a2 + hstepA, voffA);
            PG8_WAIT_V(8); PG8_WAIT_L(0); PG8_BAR; PG8_MMA(0, 0, At, B0); PG8_MMA(0, 1, At, B1); PG8_BAR; PG8_SCHED;
            PG8_LDA(At, 1, 1); PG8_STAGE(PG8_SB(1, 0), b3, voffB); PG8_STAGE(PG8_SB(1, 1), b3 + hstepB, voffB); PG8_STAGE(PG8_SA(1, 0), a3, voffA);
            PG8_WAIT_V(8); PG8_WAIT_L(0); PG8_BAR; PG8_MMA(1, 0, At, B0); PG8_MMA(1, 1, At, B1); PG8_BAR; PG8_SCHED;
            } else {
            PG8_LDB(B0, 0, 0); PG8_SCHED; PG8_LDA(At, 0, 0); PG8_STAGE(PG8_SA(1, 1), a1 + hstepA, voffA);
            PG8_WAIT_L(8); PG8_BAR; PG8_WAIT_L(0); PG8_MMA(0, 0, At, B0); PG8_BAR; PG8_SCHED;
            PG8_LDB(B1, 0, 1); PG8_STAGE(PG8_SB(0, 0), b2, voffB);
            PG8_BAR; PG8_WAIT_L(0); PG8_MMA(0, 1, At, B1); PG8_BAR;
            PG8_LDA(At, 0, 1); PG8_STAGE(PG8_SA(0, 0), a2, voffA);
            PG8_BAR; PG8_WAIT_L(0); PG8_MMA(1, 0, At, B0); PG8_BAR; PG8_SCHED;
            PG8_STAGE(PG8_SB(0, 1), b2 + hstepB, voffB);
            PG8_WAIT_V(6); PG8_BAR; PG8_MMA(1, 1, At, B1); PG8_BAR;
            PG8_LDB(B0, 1, 0); PG8_SCHED; PG8_LDA(At, 1, 0); PG8_STAGE(PG8_SA(0, 1), a2 + hstepA, voffA);
            PG8_WAIT_L(8); PG8_BAR; PG8_WAIT_L(0); PG8_MMA(0, 0, At, B0); PG8_BAR; PG8_SCHED;
            PG8_LDB(B1, 1, 1); PG8_STAGE(PG8_SB(1, 0), b3, voffB);
            PG8_BAR; PG8_WAIT_L(0); PG8_MMA(0, 1, At, B1); PG8_BAR;
            PG8_LDA(At, 1, 1); PG8_STAGE(PG8_SA(1, 0), a3, voffA);
            PG8_BAR; PG8_WAIT_L(0); PG8_MMA(1, 0, At, B0); PG8_BAR; PG8_SCHED;
            PG8_STAGE(PG8_SB(1, 1), b3 + hstepB, voffB);
            PG8_WAIT_V(6); PG8_BAR; PG8_MMA(1, 1, At, B1); PG8_BAR;
            }
        }
        if constexpr (ALIGN_EPI) { if (wr == 0) PG8_BAR; }
        if constexpr (!Epi::AFTER_DRAIN) { E(acc, cur, wr, wc, fr, fq); S.done(cur); }
        if (!has_next) break;
#pragma unroll
        for (int a = 0; a < 2; ++a)
#pragma unroll
            for (int b = 0; b < 2; ++b)
#pragma unroll
                for (int m = 0; m < 4; ++m)
#pragma unroll
                    for (int n = 0; n < 2; ++n) acc[a][b][m][n] = (f32x4){0.f, 0.f, 0.f, 0.f};
        cur = nxt; cA = nA; cB = nB; ++ui;
        if constexpr (ALIGN_EPI) { if (wr == 1) PG8_BAR; }
    }
    PG8_WAIT_V(0);
    if constexpr (!ALIGN_EPI) { if (wr == 0) PG8_BAR; }
    PG8_BAR;
    if constexpr (Epi::AFTER_DRAIN) { E.fused(acc, cur, wr, wc, fr, fq, lds, wid, lane); S.done(cur); }
#undef PG8_SA
#undef PG8_SB
#undef PG8_STAGE
#undef PG8_LDA
#undef PG8_LDB
#undef PG8_MMA
#undef PG8_WAIT_V
#undef PG8_WAIT_L
#undef PG8_BAR
#undef PG8_SCHED
}
}
#endif

enum { I_XP, I_XS, I_CGK, I_CGV, I_CDK, I_CDV, I_CWK, I_CWV, I_C, I_CCTX, I_N1G, I_N2G, I_WMOD, I_BMOD, I_FWIN, I_FCW, I_FCB, I_FWOUT,
       I_POOLW, I_POOLS, I_GQKV, I_GQN, I_GKN, I_GWO, I_DQKV, I_DQN, I_DKN, I_DLQ1, I_DLK1, I_DLQ2, I_DLK2, I_DSUB, I_DWO,
       I_WQKV, I_WQN, I_WKN, I_WSINK, I_WWO, N_IN };
struct Params { const float* in[N_IN]; float* out; unsigned char* ws; };
#ifdef HOST_EMU
static inline const float* pin(const Params& P, int i) { return P.in[i]; }
#else
__device__ __forceinline__ const float* pin(const Params& P, int i) { asm volatile("" : "+s"(i)); return P.in[i]; }
#endif

constexpr size_t MiB = (size_t)1 << 20;
constexpr size_t WS_CTL = 1 * MiB + 576 * 1024, CTL_ZERO_BYTES = 16384;
constexpr size_t WS_EDGE = 1 * MiB + 640 * 1024;
constexpr size_t WS_MOD = 0, WS_RSTD = 1 * MiB, WS_ROPE = 1 * MiB + 256 * 1024;
constexpr size_t WS_WIN = 3 * MiB;
constexpr size_t WS_WOUT = WS_WIN + (size_t)4 * DFF2 * D * 2;
constexpr size_t WS_GQKV = WS_WOUT + (size_t)4 * D * DFF * 2;
constexpr size_t WS_GWO = WS_GQKV + (size_t)1536 * D * 2, WS_DQKV = WS_GWO + (size_t)D * D * 2, WS_DWO = WS_DQKV + (size_t)3072 * D * 2;
constexpr size_t WS_WQKV = WS_DWO + (size_t)D * D * 2, WS_WWO = WS_WQKV + (size_t)1536 * D * 2, WS_POOL = WS_WWO + (size_t)D * D * 2;
constexpr size_t WS_HB = WS_POOL + (size_t)1024 * 256 * 2;
constexpr size_t WS_UB = WS_HB + (size_t)T * D * 2;
constexpr size_t WS_QKV = WS_UB, WS_OB = WS_QKV + (size_t)T * 3072 * 2, WS_PD = WS_QKV;
constexpr size_t UB_BYTES = ((size_t)T * DFF2 * 2 > (size_t)T * 4096 * 2) ? (size_t)T * DFF2 * 2 : (size_t)T * 4096 * 2;
constexpr size_t WS_GB = WS_UB + UB_BYTES;
constexpr size_t WS_SA = WS_GB + (size_t)T * DFF * 2, WS_SB = WS_SA + (size_t)T * D * 4;
constexpr size_t WS_END = WS_SB + (size_t)T * D * 4;
static_assert(WS_END <= 256 * MiB, "d_ws map");

constexpr int STEPS_PER_LAYER = 13, N_PRE = 3, N_STEPS = N_PRE + 4 * STEPS_PER_LAYER;

struct Ctx {
  float* out_; unsigned char* ws_;
#ifdef HOST_EMU
  float* out_p() const { return out_; } unsigned char* ws_p() const { return ws_; }
#else
  __device__ __forceinline__ float* out_p() const { float* p = out_; asm volatile("" : "+s"(p)); return p; }
  __device__ __forceinline__ unsigned char* ws_p() const { unsigned char* p = ws_; asm volatile("" : "+s"(p)); return p; }
#endif
  __device__ __forceinline__ float* X() const { return out_p(); }
  __device__ __forceinline__ float* o_gk() const { return out_p() + (size_t)T * D; }
  __device__ __forceinline__ float* o_gv() const { return o_gk() + (size_t)TCTX * 256; }
  __device__ __forceinline__ float* o_dk() const { return o_gv() + (size_t)TCTX * 256; }
  __device__ __forceinline__ float* o_dv() const { return o_dk() + (size_t)TCTX * 1024; }
  __device__ __forceinline__ float* o_wk() const { return o_dv() + (size_t)TCTX * 1024; }
  __device__ __forceinline__ float* o_wv() const { return o_wk() + (size_t)TCTX * 256; }
  __device__ __forceinline__ float* MOD() const { return (float*)(ws_p() + WS_MOD); }
  __device__ __forceinline__ float* RSTD() const { return (float*)(ws_p() + WS_RSTD); }
  __device__ __forceinline__ float* ROPE() const { return (float*)(ws_p() + WS_ROPE); }
  __device__ __forceinline__ bf16_t* bf(size_t off) const { return (bf16_t*)(ws_p() + off); }
  __device__ __forceinline__ bf16_t* WinT() const { return bf(WS_WIN); }
  __device__ __forceinline__ bf16_t* WoutT() const { return bf(WS_WOUT); }
  __device__ __forceinline__ bf16_t* GqkvT() const { return bf(WS_GQKV); }
  __device__ __forceinline__ bf16_t* GwoT() const { return bf(WS_GWO); }
  __device__ __forceinline__ bf16_t* DqkvT() const { return bf(WS_DQKV); }
  __device__ __forceinline__ bf16_t* DwoT() const { return bf(WS_DWO); }
  __device__ __forceinline__ bf16_t* WqkvT() const { return bf(WS_WQKV); }
  __device__ __forceinline__ bf16_t* WwoT() const { return bf(WS_WWO); }
  __device__ __forceinline__ bf16_t* PoolT() const { return bf(WS_POOL); }
  __device__ __forceinline__ bf16_t* Hb() const { return bf(WS_HB); }
  __device__ __forceinline__ bf16_t* Ub() const { return bf(WS_UB); }
  __device__ __forceinline__ bf16_t* QKVb() const { return bf(WS_QKV); }
  __device__ __forceinline__ bf16_t* Ob() const { return bf(WS_OB); }
  __device__ __forceinline__ bf16_t* PDb() const { return bf(WS_PD); }
  __device__ __forceinline__ bf16_t* Gb() const { return bf(WS_GB); }
};
__device__ __forceinline__ Ctx make_ctx(const Params& P) { Ctx c; c.out_ = P.out; c.ws_ = P.ws; return c; }

#ifndef KSPLIT
#define KSPLIT 2
#endif
struct GemmDesc { const bf16_t* A; int lda, a_pn_step; const bf16_t* Bt; int ldb, N, K; bool res; bf16_t* C; int ldc; int gate_chunk; const float* colscale; int ksplit; };
__device__ __forceinline__ bool gemm_desc(int step, const Params& P, const Ctx& c, GemmDesc& g) {
  if (step < N_PRE) return false;
  const int l = (step - N_PRE) / STEPS_PER_LAYER, s = (step - N_PRE) % STEPS_PER_LAYER;
  g.a_pn_step = 0; g.colscale = nullptr; g.C = nullptr; g.ldc = 0; g.gate_chunk = 0; g.res = false; g.ksplit = 1;
  if (s == 2 && l != 0) { const int N = (l == 2) ? 3072 : 1536; g.A = c.Hb(); g.lda = D; g.Bt = c.bf(l == 1 ? WS_GQKV : (l == 2 ? WS_DQKV : WS_WQKV)); g.ldb = D; g.N = N; g.K = D; g.C = c.QKVb(); g.ldc = N; return true; }
  if (s == 7) {
    g.res = true; g.gate_chunk = 2;
    if (l == 0) { g.A = c.PDb(); g.lda = D; g.a_pn_step = 256; g.Bt = c.PoolT(); g.ldb = 256; g.N = D; g.K = 256; g.colscale = pin(P, I_POOLS); }
    else { g.A = c.Ob(); g.lda = D; g.Bt = c.bf(l == 1 ? WS_GWO : (l == 2 ? WS_DWO : WS_WWO)); g.ldb = D; g.N = D; g.K = D; g.ksplit = KSPLIT; }
    return true;
  }
  if (s == 10) { g.A = c.Hb(); g.lda = D; g.Bt = c.WinT() + (size_t)l * DFF2 * D; g.ldb = D; g.N = DFF2; g.K = D; g.C = c.Ub(); g.ldc = DFF2; return true; }
  if (s == 12) { g.res = true; g.gate_chunk = 5; g.A = c.Gb(); g.lda = DFF; g.Bt = c.WoutT() + (size_t)l * D * DFF; g.ldb = DFF; g.N = D; g.K = DFF; g.ksplit = (DFF % 256 == 0) ? KSPLIT : 1; return true; }
  return false;
}

__device__ __forceinline__ void naive_step(int step, const Params& P, const Ctx& c) {
#define IN(i) (pin(P, (i)))
  if (step == 0) { nk_copy_x(IN(I_XP), IN(I_XS), c.X()); return; }
  if (step == 1) { nk_mod(IN(I_C), IN(I_CCTX), IN(I_WMOD), IN(I_BMOD), c.MOD(), 4); nk_rope_table(c.ROPE()); return; }
  if (step == 2) {
    for (int l = 0; l < 4; ++l) { nk_wt(IN(I_FWIN) + (size_t)l * D * DFF2, D, DFF2, c.WinT() + (size_t)l * DFF2 * D); nk_wt(IN(I_FWOUT) + (size_t)l * DFF * D, DFF, D, c.WoutT() + (size_t)l * D * DFF); }
    nk_wt(IN(I_GQKV), D, 1536, c.GqkvT()); nk_wt(IN(I_GWO), D, D, c.GwoT()); nk_wt(IN(I_DQKV), D, 3072, c.DqkvT()); nk_wt(IN(I_DWO), D, D, c.DwoT());
    nk_wt(IN(I_WQKV), D, 1536, c.WqkvT()); nk_wt(IN(I_WWO), D, D, c.WwoT());
    for (int g = 0; g < 4; ++g) nk_wt(IN(I_POOLW) + g * 256 * 256, 256, 256, c.PoolT() + g * 256 * 256);
    return;
  }
  const int l = (step - N_PRE) / STEPS_PER_LAYER, s = (step - N_PRE) % STEPS_PER_LAYER;
  const float* MODl = c.MOD() + (long)l * NCOND * MODW;
  const bool gq = (l == 1 || l == 3);
  const float* qn = IN(l == 1 ? I_GQN : I_WQN); const float* kn = IN(l == 1 ? I_GKN : I_WKN);
  const float* ck = IN(l == 1 ? I_CGK : I_CWK); const float* cv = IN(l == 1 ? I_CGV : I_CWV);
  const float lam_init = 0.8f - 0.6f * expf(-0.3f * (float)l);
  GemmDesc g;
  if (gemm_desc(step, P, c, g)) {
    if (g.res) nk_gemm_res(g.A, g.lda, g.a_pn_step, g.Bt, g.ldb, c.X(), T, g.N, g.K, MODl, g.gate_chunk, g.colscale);
    else nk_gemm_bf(g.A, g.lda, g.Bt, g.ldb, g.C, g.ldc, T, g.N, g.K);
    return;
  }
  switch (s) {
    case 0: nk_rstd(c.X(), c.RSTD()); break;
    case 1: nk_normmod(c.X(), c.RSTD(), IN(I_N1G) + l * D, MODl, 0, 1, c.Hb()); break;
    case 2: if (l == 0) nk_pool(c.Hb(), c.PDb()); break;
    case 3:
      if (l == 0) break;
      if (gq) { nk_qknorm_rope(c.QKVb(), 1536, 16, 4, 1024, qn, kn, l == 1 ? c.o_gk() : c.o_wk()); nk_copy_cols_f(c.QKVb(), 1536, 1280, 256, TCTX, l == 1 ? c.o_gv() : c.o_wv()); }
      else { nk_qknorm_rope(c.QKVb(), 3072, 16, 16, 1024, IN(I_DQN), IN(I_DKN), c.o_dk()); nk_copy_cols_f(c.QKVb(), 3072, 2048, 1024, TCTX, c.o_dv()); }
      break;
    case 5:
      if (l == 0) break;
      if (l == 1) nk_attn<0>(c.QKVb(), 1536, 1024, 1280, ck, cv, 256, nullptr, nullptr, nullptr, nullptr, nullptr, 0.f, c.Ob());
      else if (l == 3) nk_attn<1>(c.QKVb(), 1536, 1024, 1280, ck, cv, 256, IN(I_WSINK), nullptr, nullptr, nullptr, nullptr, 0.f, c.Ob());
      else nk_attn<2>(c.QKVb(), 3072, 1024, 2048, IN(I_CDK), IN(I_CDV), 1024, nullptr, IN(I_DLQ1), IN(I_DLK1), IN(I_DLQ2), IN(I_DLK2), lam_init, c.Ob());
      break;
    case 6: if (l == 2) nk_subnorm(c.Ob(), IN(I_DSUB), 1.0f - lam_init); break;
    case 8: nk_rstd(c.X(), c.RSTD()); break;
    case 9: nk_normmod(c.X(), c.RSTD(), IN(I_N2G) + l * D, MODl, 3, 4, c.Hb()); break;
    case 11: nk_convgate(c.Ub(), IN(I_FCW) + (long)l * 3 * DFF2, IN(I_FCB) + (long)l * DFF2, c.Gb()); break;
    default: break;
  }
#undef IN
}
__device__ __forceinline__ bool step_is_noop(int step) {
  if (step < N_PRE) return false;
  const int l = (step - N_PRE) / STEPS_PER_LAYER, s = (step - N_PRE) % STEPS_PER_LAYER;
  if (s == 4) return true;
  if (l == 0 && (s == 3 || s == 5)) return true;
  if (l != 2 && s == 6) return true;
  return false;
}


#ifndef HOST_EMU
#define LAS __attribute__((address_space(3)))
typedef float f32x4 __attribute__((ext_vector_type(4)));
typedef float f32x2 __attribute__((ext_vector_type(2)));
typedef unsigned u32x4 __attribute__((ext_vector_type(4)));
typedef unsigned u32x2 __attribute__((ext_vector_type(2)));
typedef __bf16 bf16x2_t __attribute__((ext_vector_type(2)));
__device__ __forceinline__ unsigned pk_bf16(float lo, float hi) { f32x2 v = {lo, hi}; bf16x2_t b = __builtin_convertvector(v, bf16x2_t); return __builtin_bit_cast(unsigned, b); }
__device__ __forceinline__ float bf_lo(unsigned u) { return __uint_as_float(u << 16); }
__device__ __forceinline__ float bf_hi(unsigned u) { return __uint_as_float(u & 0xffff0000u); }
__device__ __forceinline__ int opaque_i(int v) { asm volatile("" : "+v"(v)); return v; }
__device__ __forceinline__ int opaque_block() { int b = (int)blockIdx.x; asm volatile("" : "+s"(b)); return b; }
__device__ __forceinline__ float shx(float v, int mask, int lane) { return __int_as_float(__builtin_amdgcn_ds_bpermute((lane ^ mask) << 2, __float_as_int(v))); }
__device__ __forceinline__ float wave_sum(float v, int lane) {
#pragma unroll
  for (int o = 1; o < 64; o <<= 1) v += shx(v, o, lane);
  return v;
}
struct WaveId { int lane, wave, gw, ngw; };
__device__ __forceinline__ WaveId wave_id() { WaveId w; const int tid = opaque_i((int)threadIdx.x); w.lane = tid & 63; w.wave = __builtin_amdgcn_readfirstlane(tid >> 6); w.gw = opaque_block() * 8 + w.wave; w.ngw = (int)gridDim.x * 8; return w; }

__device__ __forceinline__ void ph_norm(const float* Xc, const float* Xl, const bf16_t* pend, const float* g, const float* MODl, int sh_chunk, int sc_chunk, bf16_t* Hb) {
  const WaveId w = wave_id();
  constexpr int NR = 3;
  for (int t0 = w.gw; t0 < T; t0 += NR * w.ngw) {
    f32x4 v[NR][4]; u32x2 q[NR][4];
#pragma unroll
    for (int r = 0; r < NR; ++r) { const int t = t0 + r * w.ngw; if (t < T) {
        const f32x4* xr = (const f32x4*)((t < TCTX ? Xc : Xl) + (size_t)t * D) + w.lane;
#pragma unroll
        for (int j = 0; j < 4; ++j) { v[r][j] = xr[64 * j]; if (pend) q[r][j] = ((const u32x2*)(pend + (size_t)t * D) + w.lane)[64 * j]; } } }
#pragma unroll
    for (int r = 0; r < NR; ++r) { const int t = t0 + r * w.ngw; if (t < T) {
        float ss = 0.f;
#pragma unroll
        for (int j = 0; j < 4; ++j) { if (pend) v[r][j] = v[r][j] + (f32x4){bf_lo(q[r][j].x), bf_hi(q[r][j].x), bf_lo(q[r][j].y), bf_hi(q[r][j].y)};
          ss += (v[r][j].x * v[r][j].x + v[r][j].y * v[r][j].y) + (v[r][j].z * v[r][j].z + v[r][j].w * v[r][j].w); }
        const float rstd = 1.0f / sqrtf(wave_sum(ss, w.lane) / (float)D + EPS);
        const float* m = MODl + (size_t)tok_cond(t) * MODW;
        u32x2* o = (u32x2*)(Hb + (size_t)t * D) + w.lane;
#pragma unroll
        for (int j = 0; j < 4; ++j) {
          const int col = 4 * w.lane + 256 * j;
          const f32x4 gg = *(const f32x4*)(g + col), sc = *(const f32x4*)(m + sc_chunk * D + col), sh = *(const f32x4*)(m + sh_chunk * D + col);
          const f32x4 y = v[r][j] * rstd * gg * (1.0f + sc) + sh;
          u32x2 pk; pk.x = pk_bf16(y.x, y.y); pk.y = pk_bf16(y.z, y.w); o[64 * j] = pk;
        } } }
  }
}

__device__ __forceinline__ void unpack8(const u32x4 r, float (&x)[8]) { x[0] = bf_lo(r.x); x[1] = bf_hi(r.x); x[2] = bf_lo(r.y); x[3] = bf_hi(r.y); x[4] = bf_lo(r.z); x[5] = bf_hi(r.z); x[6] = bf_lo(r.w); x[7] = bf_hi(r.w); }
__device__ __forceinline__ u32x4 pack8(const float (&y)[8]) { u32x4 r; r.x = pk_bf16(y[0], y[1]); r.y = pk_bf16(y[2], y[3]); r.z = pk_bf16(y[4], y[5]); r.w = pk_bf16(y[6], y[7]); return r; }

__device__ __forceinline__ void ph_pool(const bf16_t* Hb, bf16_t* PDb) {
  const int tid0 = (opaque_block() * 512 + opaque_i((int)threadIdx.x)), nth = (int)(gridDim.x * blockDim.x);
  for (int i = tid0; i < T * 128; i += nth) {
    const int t = i >> 7, c8 = i & 127, g = c8 >> 5, wdw = 2 << g; int s0, L; tok_seq(t, s0, L);
    const int pos = t - s0; int lo = pos - wdw / 2, hi = pos - wdw / 2 + wdw; lo = lo < 0 ? 0 : lo; hi = hi > L ? L : hi;
    float acc[8], x[8];
#pragma unroll
    for (int e = 0; e < 8; ++e) acc[e] = 0.f;
    for (int j = lo; j < hi; ++j) { unpack8(*(const u32x4*)(Hb + (size_t)(s0 + j) * D + 8 * c8), x);
#pragma unroll
      for (int e = 0; e < 8; ++e) acc[e] += x[e]; }
    unpack8(*(const u32x4*)(Hb + (size_t)t * D + 8 * c8), x);
    const float cnt = (float)(hi - lo); float y[8];
#pragma unroll
    for (int e = 0; e < 8; ++e) y[e] = acc[e] / cnt - x[e];
    *(u32x4*)(PDb + (size_t)t * D + 8 * c8) = pack8(y);
  }
}

__device__ __forceinline__ void ph_qkpost(bf16_t* QKV, int ld, int nq, int nk, int nv, int kcol0, int vcol0, const float* qn, const float* kn, const float* rope, float* kout, float* vout) {
  const WaveId w = wave_id(); const int NG = (nq + nk + nv) >> 3, sl = w.lane >> 3, j = w.lane & 7;
  for (int it = w.gw; it < T * NG; it += w.ngw) {
    const int t = it / NG, sg = it - t * NG, slot = sg * 8 + sl; const bool lat = t >= TCTX;
    const int kind = slot < nq ? 0 : (slot < nq + nk ? 1 : 2);
    const int col = kind == 0 ? slot * 64 : (kind == 1 ? kcol0 + (slot - nq) * 64 : vcol0 + (slot - nq - nk) * 64);
    bf16_t* p = QKV + (size_t)t * ld + col + 8 * j;
    float x[8], y[8]; unpack8(*(const u32x4*)p, x);
    float ss = 0.f;
#pragma unroll
    for (int e = 0; e < 8; ++e) ss += x[e] * x[e];
    ss += shx(ss, 1, w.lane); ss += shx(ss, 2, w.lane); ss += shx(ss, 4, w.lane);
    const float r = 1.0f / sqrtf(ss / 64.0f + EPS);
    const float* wp = (kind == 1 ? kn : qn) + 8 * j; const f32x4 w0 = *(const f32x4*)wp, w1 = *(const f32x4*)(wp + 4);
    y[0] = x[0] * r * w0.x; y[1] = x[1] * r * w0.y; y[2] = x[2] * r * w0.z; y[3] = x[3] * r * w0.w;
    y[4] = x[4] * r * w1.x; y[5] = x[5] * r * w1.y; y[6] = x[6] * r * w1.z; y[7] = x[7] * r * w1.w;
    if (lat) {
      const int pos = (t - TCTX) % DEC_SEQ, a = j >> 2; const f32x4* tb = (const f32x4*)(rope + ((size_t)(pos * 2 + a) * 16 + 8 * (j & 1)) * 2);
      const bool x2side = (j & 2) != 0;
#pragma unroll
      for (int e2 = 0; e2 < 4; ++e2) { const f32x4 cs = tb[e2];
        const float p0 = shx(y[2 * e2], 2, w.lane), p1 = shx(y[2 * e2 + 1], 2, w.lane);
        y[2 * e2] = x2side ? y[2 * e2] * cs.x + p0 * cs.y : y[2 * e2] * cs.x - p0 * cs.y;
        y[2 * e2 + 1] = x2side ? y[2 * e2 + 1] * cs.z + p1 * cs.w : y[2 * e2 + 1] * cs.z - p1 * cs.w; }
    }
    if (kind != 2) *(u32x4*)p = pack8(y);
    if (!lat) {
      if (kind == 1) { float* o = kout + (size_t)t * (nk * 64) + (slot - nq) * 64 + 8 * j; *(f32x4*)o = (f32x4){y[0], y[1], y[2], y[3]}; *(f32x4*)(o + 4) = (f32x4){y[4], y[5], y[6], y[7]}; }
      if (kind == 2) { float* o = vout + (size_t)t * (nv * 64) + (slot - nq - nk) * 64 + 8 * j; *(f32x4*)o = (f32x4){x[0], x[1], x[2], x[3]}; *(f32x4*)(o + 4) = (f32x4){x[4], x[5], x[6], x[7]}; }
    }
  }
}

__device__ __forceinline__ void ph_convgate(const bf16_t* U, const float* cw, const float* cb, bf16_t* G) {
  constexpr int NCG = DFF / 8, RC = 8;
  const int tid0 = (opaque_block() * 512 + opaque_i((int)threadIdx.x)), nth = (int)(gridDim.x * blockDim.x);
  for (int i = tid0; i < (T / RC) * NCG; i += nth) {
    const int rc = i / NCG, cg = i - rc * NCG, r0 = rc * RC; int s0, L; tok_seq(r0, s0, L); const int pos0 = r0 - s0;
    const bool has_prev = pos0 > 0, has_next = pos0 + RC < L;
    u32x4 raw[2][RC + 2];
#pragma unroll
    for (int hf = 0; hf < 2; ++hf) {
      const bf16_t* base = U + (size_t)r0 * DFF2 + hf * DFF + 8 * cg;
      raw[hf][0] = *(const u32x4*)(has_prev ? base - DFF2 : base);
#pragma unroll
      for (int k = 0; k < RC; ++k) raw[hf][k + 1] = *(const u32x4*)(base + (size_t)k * DFF2);
      raw[hf][RC + 1] = *(const u32x4*)(has_next ? base + (size_t)RC * DFF2 : base);
    }
    float w0[2][8], w1[2][8], w2[2][8], bb[2][8];
#pragma unroll
    for (int hf = 0; hf < 2; ++hf) { const int col = hf * DFF + 8 * cg;
#pragma unroll
      for (int e = 0; e < 8; e += 4) { const f32x4 a0 = *(const f32x4*)(cw + col + e), a1 = *(const f32x4*)(cw + DFF2 + col + e), a2 = *(const f32x4*)(cw + 2 * DFF2 + col + e), a3 = *(const f32x4*)(cb + col + e);
#pragma unroll
        for (int q = 0; q < 4; ++q) { w0[hf][e + q] = a0[q]; w1[hf][e + q] = a1[q]; w2[hf][e + q] = a2[q]; bb[hf][e + q] = a3[q]; } } }
    if (!has_prev) { raw[0][0] = (u32x4){0u, 0u, 0u, 0u}; raw[1][0] = (u32x4){0u, 0u, 0u, 0u}; }
    if (!has_next) { raw[0][RC + 1] = (u32x4){0u, 0u, 0u, 0u}; raw[1][RC + 1] = (u32x4){0u, 0u, 0u, 0u}; }
    float up[2][8], uc[2][8], un[2][8];
    unpack8(raw[0][0], up[0]); unpack8(raw[1][0], up[1]); unpack8(raw[0][1], uc[0]); unpack8(raw[1][1], uc[1]);
#pragma unroll
    for (int r = 0; r < RC; ++r) {
      unpack8(raw[0][r + 2], un[0]); unpack8(raw[1][r + 2], un[1]);
      float y[8];
#pragma unroll
      for (int e = 0; e < 8; ++e) {
        const float a = uc[0][e] * w1[0][e] + bb[0][e] + up[0][e] * w0[0][e] + un[0][e] * w2[0][e];
        const float b = uc[1][e] * w1[1][e] + bb[1][e] + up[1][e] * w0[1][e] + un[1][e] * w2[1][e];
        y[e] = a / (1.0f + __expf(-a)) * b;
      }
      *(u32x4*)(G + (size_t)(r0 + r) * DFF + 8 * cg) = pack8(y);
#pragma unroll
      for (int hf = 0; hf < 2; ++hf)
#pragma unroll
        for (int e = 0; e < 8; ++e) { up[hf][e] = uc[hf][e]; uc[hf][e] = un[hf][e]; }
    }
  }
}


__device__ __forceinline__ void ph_conv_fixup(const float* edgebuf, const float* cw, const float* cb, bf16_t* G) {
  const int tid0 = (opaque_block() * 512 + opaque_i((int)threadIdx.x)), nth = (int)(gridDim.x * blockDim.x);
  for (int i = tid0; i < 6 * DFF; i += nth) {
    const int sm = i / DFF, f = i - sm * DFF, tu = (sm / 3) * 4 + (sm % 3), pn = f >> 7, cc = f & 127;
    const float* eu = edgebuf + ((size_t)(tu * (DFF / 128) + pn) * 4) * 256 + cc; const float* el = edgebuf + ((size_t)((tu + 1) * (DFF / 128) + pn) * 4) * 256 + cc;
    float o[2][2];
#pragma unroll
    for (int bj = 0; bj < 2; ++bj) { const int col = bj * DFF + f; const float w0 = cw[col], w1 = cw[DFF2 + col], w2 = cw[2 * DFF2 + col], bb = cb[col];
      const float u254 = eu[2 * 256 + bj * 128], u255 = eu[3 * 256 + bj * 128], l0 = el[0 * 256 + bj * 128], l1 = el[1 * 256 + bj * 128];
      o[0][bj] = u255 * w1 + bb + u254 * w0 + l0 * w2; o[1][bj] = l0 * w1 + bb + u255 * w0 + l1 * w2; }
    const int rowU = TCTX + (tu + 1) * 256 - 1;
    G[(size_t)rowU * DFF + f] = (bf16_t)(pk_bf16(o[0][0] / (1.0f + __expf(-o[0][0])) * o[0][1], 0.f) & 0xffffu);
    G[(size_t)(rowU + 1) * DFF + f] = (bf16_t)(pk_bf16(o[1][0] / (1.0f + __expf(-o[1][0])) * o[1][1], 0.f) & 0xffffu);
  }
}

__device__ __forceinline__ void conv_fixup_unit(const float* edgebuf, const float* cw, const float* cb, bf16_t* G, int pm, int f0, int nf) {
  if (pm * 256 < TCTX) return;
  const int tl = pm - TCTX / 256, tid = opaque_i((int)threadIdx.x);
  const bool up = (tl & 3) != 0, dn = (tl & 3) != 3;
  for (int i = tid; i < nf; i += 512) {
    const int f = f0 + i, pn = f >> 7, cc = f & 127;
    const float* eo = edgebuf + ((size_t)(tl * (DFF / 128) + pn) * 4) * 256 + cc;
    float ga[2], gb[2];
#pragma unroll
    for (int bj = 0; bj < 2; ++bj) { const int col = bj * DFF + f; const float w0 = cw[col], w1 = cw[DFF2 + col], w2 = cw[2 * DFF2 + col], bb = cb[col];
      const float o0 = eo[0 * 256 + bj * 128], o1 = eo[1 * 256 + bj * 128], o254 = eo[2 * 256 + bj * 128], o255 = eo[3 * 256 + bj * 128];
      float pu = 0.f, nd = 0.f;
      if (up) pu = (eo - (size_t)(DFF / 128) * 4 * 256)[3 * 256 + bj * 128];
      if (dn) nd = (eo + (size_t)(DFF / 128) * 4 * 256)[0 * 256 + bj * 128];
      const float c0 = o0 * w1 + bb + pu * w0 + o1 * w2, c255 = o255 * w1 + bb + o254 * w0 + nd * w2;
      if (bj == 0) { ga[0] = c0; ga[1] = c255; } else { gb[0] = c0; gb[1] = c255; } }
    if (up) G[(size_t)(pm * 256) * DFF + f] = (bf16_t)(pk_bf16(ga[0] / (1.0f + __expf(-ga[0])) * gb[0], 0.f) & 0xffffu);
    if (dn) G[(size_t)(pm * 256 + 255) * DFF + f] = (bf16_t)(pk_bf16(ga[1] / (1.0f + __expf(-ga[1])) * gb[1], 0.f) & 0xffffu);
  }
}

__device__ __forceinline__ void win_subunit(const bf16_t* Hb, const bf16_t* WinT, const float* cw, const float* cb, bf16_t* G, float* edgebuf, LAS unsigned char* lds, int pm, int pn, int j) {
  typedef short bf16x8 __attribute__((ext_vector_type(8)));
  const int tid = opaque_i((int)threadIdx.x), lane = tid & 63, wave = tid >> 6, c = lane & 15, g = lane >> 4;
  const bf16_t* a0p = Hb + (size_t)(pm * 256 + 32 * wave + c) * D + 8 * g; const bf16_t* a1p = a0p + (size_t)16 * D;
  const bf16_t* bp = WinT + (size_t)(pn * 256 + (c < 8 ? 8 * j + c : 128 + 8 * j + (c - 8))) * D + 8 * g;
  f32x4 acc0 = (f32x4){0.f, 0.f, 0.f, 0.f}, acc1 = acc0;
#pragma unroll 8
  for (int ks = 0; ks < D / 32; ++ks) {
    const bf16x8 a0 = *(const bf16x8*)(a0p + 32 * ks), a1 = *(const bf16x8*)(a1p + 32 * ks), b = *(const bf16x8*)(bp + 32 * ks);
    acc0 = __builtin_amdgcn_mfma_f32_16x16x32_bf16(a0, b, acc0, 0, 0, 0); acc1 = __builtin_amdgcn_mfma_f32_16x16x32_bf16(a1, b, acc1, 0, 0, 0);
  }
  LAS float* U = (LAS float*)lds;
#pragma unroll
  for (int r = 0; r < 4; ++r) { U[(32 * wave + 4 * g + r) * 16 + c] = bf_lo(pk_bf16(acc0[r], 0.f)); U[(32 * wave + 16 + 4 * g + r) * 16 + c] = bf_lo(pk_bf16(acc1[r], 0.f)); }
  __syncthreads();
  const int row = tid >> 1, q4 = (tid & 1) * 4, gcol = pn * 128 + 8 * j + q4;
  float y[4], ua[4], ub[4];
#pragma unroll
  for (int e = 0; e < 4; ++e) {
    float cv[2];
#pragma unroll
    for (int bj = 0; bj < 2; ++bj) { const int col = bj * DFF + gcol + e, lc = bj * 8 + q4 + e;
      const float uc = U[row * 16 + lc], up = row > 0 ? U[(row - 1) * 16 + lc] : 0.f, un = row < 255 ? U[(row + 1) * 16 + lc] : 0.f;
      cv[bj] = uc * cw[DFF2 + col] + cb[col] + up * cw[col] + un * cw[2 * DFF2 + col]; if (bj == 0) ua[e] = uc; else ub[e] = uc; }
    y[e] = cv[0] / (1.0f + __expf(-cv[0])) * cv[1];
  }
  u32x2 o; o.x = pk_bf16(y[0], y[1]); o.y = pk_bf16(y[2], y[3]);
  *(u32x2*)(G + (size_t)(pm * 256 + row) * DFF + gcol) = o;
  if (pm * 256 >= TCTX && (row < 2 || row >= 254)) {
    float* eb = edgebuf + ((size_t)((pm - TCTX / 256) * (DFF / 128) + pn) * 4 + (row < 2 ? row : row - 252)) * 256 + 8 * j + q4;
    *(f32x4*)eb = (f32x4){ua[0], ua[1], ua[2], ua[3]}; *(f32x4*)(eb + 128) = (f32x4){ub[0], ub[1], ub[2], ub[3]};
  }
  __syncthreads();
}

__device__ __forceinline__ void transpose_item(const float* W, int K, int N, bf16_t* WT, LAS float* scr, int item, int lane, bool pair_ab = false) {
  const int nblk = N / 32, kb = item / nblk, nb = item % nblk, k0 = 64 * kb, n0 = 32 * nb;
  int r0 = n0; if (pair_ab) { const int half = n0 >= DFF ? 1 : 0, np = n0 - half * DFF; r0 = 256 * (np / 128) + 128 * half + np % 128; }
  { const int r8 = lane >> 3, c4 = lane & 7; f32x4 v[8];
#pragma unroll
    for (int i = 0; i < 8; ++i) v[i] = *(const f32x4*)(W + (size_t)(k0 + 8 * i + r8) * N + n0 + 4 * c4);
#pragma unroll
    for (int i = 0; i < 8; ++i) { LAS float* d = scr + (8 * i + r8) * 33 + 4 * c4; d[0] = v[i].x; d[1] = v[i].y; d[2] = v[i].z; d[3] = v[i].w; } }
  asm volatile("s_waitcnt lgkmcnt(0)" ::: "memory");
  const int c = lane & 7;
#pragma unroll
  for (int j = 0; j < 4; ++j) { const int n = (lane >> 3) + 8 * j; const LAS float* sp = scr + (8 * c) * 33 + n;
    u32x4 o; o.x = pk_bf16(sp[0 * 33], sp[1 * 33]); o.y = pk_bf16(sp[2 * 33], sp[3 * 33]); o.z = pk_bf16(sp[4 * 33], sp[5 * 33]); o.w = pk_bf16(sp[6 * 33], sp[7 * 33]);
    *(u32x4*)(WT + (size_t)(r0 + n) * K + k0 + 8 * c) = o; }
  asm volatile("s_waitcnt lgkmcnt(0)" ::: "memory");
}


constexpr int CI_IN = (D / 64) * (DFF2 / 32), CI_OUT = (DFF / 64) * (D / 32), CI_Q15 = (D / 64) * (1536 / 32), CI_Q30 = (D / 64) * (3072 / 32), CI_O = (D / 64) * (D / 32), CI_P = (256 / 64) * (256 / 32);
__device__ __forceinline__ constexpr int layer_items(int l) { return CI_IN + CI_OUT + (l == 0 ? 4 * CI_P : ((l == 2 ? CI_Q30 : CI_Q15) + CI_O)); }
__device__ __forceinline__ constexpr int bg_total_items() { return layer_items(1) + layer_items(2) + layer_items(3); }
__device__ __forceinline__ constexpr int bg_end_of_layer(int l) { return l <= 0 ? 0 : (l == 1 ? layer_items(1) : (l == 2 ? layer_items(1) + layer_items(2) : bg_total_items())); }
__device__ __forceinline__ void convert_item(const Params& P, const Ctx& c, LAS float* scr, int l, int r, int lane) {
  if (r < CI_IN) { transpose_item(pin(P, I_FWIN) + (size_t)l * D * DFF2, D, DFF2, c.WinT() + (size_t)l * DFF2 * D, scr, r, lane, FUSE_CONV != 0); return; } r -= CI_IN;
  if (r < CI_OUT) { transpose_item(pin(P, I_FWOUT) + (size_t)l * DFF * D, DFF, D, c.WoutT() + (size_t)l * D * DFF, scr, r, lane); return; } r -= CI_OUT;
  if (l == 0) { const int g = r / CI_P; transpose_item(pin(P, I_POOLW) + g * 256 * 256, 256, 256, c.PoolT() + g * 256 * 256, scr, r % CI_P, lane); return; }
  const int nq = l == 2 ? CI_Q30 : CI_Q15;
  if (r < nq) { transpose_item(pin(P, l == 1 ? I_GQKV : (l == 2 ? I_DQKV : I_WQKV)), D, l == 2 ? 3072 : 1536, c.bf(l == 1 ? WS_GQKV : (l == 2 ? WS_DQKV : WS_WQKV)), scr, r, lane); return; } r -= nq;
  transpose_item(pin(P, l == 1 ? I_GWO : (l == 2 ? I_DWO : I_WWO)), D, D, c.bf(l == 1 ? WS_GWO : (l == 2 ? WS_DWO : WS_WWO)), scr, r, lane);
}
__device__ __forceinline__ void bg_item(const Params& P, const Ctx& c, LAS float* scr, int q, int lane) {
  const int l = q < bg_end_of_layer(1) ? 1 : (q < bg_end_of_layer(2) ? 2 : 3);
  convert_item(P, c, scr, l, q - bg_end_of_layer(l - 1), lane);
}
__device__ __forceinline__ void bg_work(const Params& P, const Ctx& c, LAS unsigned char* lds, unsigned budget_ticks, int upto) {
  if (!BG_QUEUE) return;
  const WaveId w = wave_id(); LAS float* scr = (LAS float*)(lds + w.wave * 16384);
  unsigned* ctr = (unsigned*)(c.ws_p() + WS_CTL) + 3520;
  const unsigned long long t0 = __builtin_amdgcn_s_memrealtime();
  for (;;) {
    if (budget_ticks != 0xffffffffu && (unsigned)(__builtin_amdgcn_s_memrealtime() - t0) > budget_ticks) break;
    unsigned q = 0xffffffffu;
    if (w.lane == 0 && (int)__hip_atomic_load(ctr, __ATOMIC_RELAXED, __HIP_MEMORY_SCOPE_AGENT) < upto) q = __hip_atomic_fetch_add(ctr, 1u, __ATOMIC_RELAXED, __HIP_MEMORY_SCOPE_AGENT);
    q = (unsigned)__builtin_amdgcn_readfirstlane((int)q);
    if (q >= (unsigned)bg_total_items()) break;
    bg_item(P, c, scr, (int)q, w.lane);
  }
}

__device__ __forceinline__ void ph_prologue(const Params& P, const Ctx& c, LAS unsigned char* lds) {
  const WaveId w = wave_id(); const int tid = opaque_i((int)threadIdx.x);
  {
    LAS float* S = (LAS float*)lds;
    LAS float* red = (LAS float*)(lds + 12288);
    for (int i = tid; i < 3 * D; i += 512) { const int cd = i / D, k = i - cd * D; const float v = cd == 0 ? pin(P, I_CCTX)[k] : pin(P, I_C)[(cd - 1) * D + k]; S[i] = v / (1.0f + expf(-v)); }
    __syncthreads();
    for (int item = opaque_block(); item < 4 * 48; item += (int)gridDim.x) {
      const int l = item / 48, n0 = (item % 48) * 128, h = w.lane >> 5, n4 = w.lane & 31;
      const float* W = pin(P, I_WMOD) + (size_t)l * D * MODW + n0 + 4 * n4;
      f32x4 acc[3] = {{0.f, 0.f, 0.f, 0.f}, {0.f, 0.f, 0.f, 0.f}, {0.f, 0.f, 0.f, 0.f}};
#pragma unroll 8
      for (int i = 0; i < 64; ++i) { const int k = 128 * w.wave + 2 * i + h; const f32x4 wv = *(const f32x4*)(W + (size_t)k * MODW);
        acc[0] += S[k] * wv; acc[1] += S[D + k] * wv; acc[2] += S[2 * D + k] * wv; }
#pragma unroll
      for (int cd = 0; cd < 3; ++cd) { acc[cd].x += shx(acc[cd].x, 32, w.lane); acc[cd].y += shx(acc[cd].y, 32, w.lane); acc[cd].z += shx(acc[cd].z, 32, w.lane); acc[cd].w += shx(acc[cd].w, 32, w.lane); }
      if (h == 0) {
#pragma unroll
        for (int cd = 0; cd < 3; ++cd) *(LAS f32x4*)(red + (w.wave * 3 + cd) * 128 + 4 * n4) = acc[cd]; }
      __syncthreads();
      if (tid < 384) { const int cd = tid >> 7, nn = tid & 127; float sum = pin(P, I_BMOD)[(size_t)l * MODW + n0 + nn];
#pragma unroll
        for (int ww = 0; ww < 8; ++ww) sum += red[(ww * 3 + cd) * 128 + nn];
        c.MOD()[((size_t)l * NCOND + cd) * MODW + n0 + nn] = sum; }
      __syncthreads();
    }
  }
  for (int i = opaque_block() * 512 + tid; i < DEC_SEQ * 32; i += (int)gridDim.x * 512) {
    const int pos = i / 32, a = (i / 16) % 2, f = i % 16;
    const float inv = powf(10000.0f, -(float)(2 * f) / 32.0f), ang = (a == 0 ? (float)(pos / 64) : (float)(pos % 64)) * inv;
    c.ROPE()[2 * i] = cosf(ang); c.ROPE()[2 * i + 1] = sinf(ang);
  }
  __syncthreads();
  {
    LAS float* scr = (LAS float*)(lds + w.wave * 16384);
    const int nitems = BG_QUEUE ? layer_items(0) : layer_items(0) + bg_total_items();
    for (int it = w.gw; it < nitems; it += w.ngw) {
      if (it < layer_items(0)) convert_item(P, c, scr, 0, it, w.lane); else bg_item(P, c, scr, it - layer_items(0), w.lane);
    }
  }
  __syncthreads();
}
#endif


#ifndef HOST_EMU
namespace att {
typedef short bf16x8 __attribute__((ext_vector_type(8)));
typedef short s16x4 __attribute__((ext_vector_type(4)));
constexpr float SC = 0.125f * 1.4426950408889634f, LOG2E = 1.4426950408889634f, NEGBIG = -1.0e30f, REF2 = 16.0f;
constexpr int OFF_K = 0, OFF_V = 32768, OFF_COMB = 73728;
struct Args {
  const bf16_t* QKV; int ld, kcol0, vcol0; const float* ck; const float* cv; int cld; const float* sink;
  const float* lq1; const float* lk1; const float* lq2; const float* lk2; float lam_init; const float* sub_g; bf16_t* O;
  const float* qn; const float* kn; const float* rope; float* kout; float* vout;
};
__device__ __forceinline__ s16x4 tr_read(const LAS unsigned char* p) { return __builtin_bit_cast(s16x4, __builtin_amdgcn_ds_read_tr16_b64_v4i16((LAS s16x4*)p)); }

template <int MODE>
__device__ __forceinline__ void unit(const Args& A, bool lat, int b, int hh, int chunk, float lam, LAS unsigned char* lds) {
  constexpr int KW = MODE == 2 ? 128 : 64, NDB = KW / 16, KROWB = KW * 2, VROWB = KW * 2 + 32, RPU = MODE == 2 ? 64 : 32, CPR = KW / 8, NCH = CPR / 8;
  constexpr int KBUF = 16384, VBUF = 20480;
  const int tid = opaque_i((int)threadIdx.x), lane = tid & 63, wave = __builtin_amdgcn_readfirstlane(tid >> 6), c = lane & 15, g = lane >> 4;
  const int s0 = lat ? TCTX + b * DEC_SEQ : b * SEQ, L = lat ? DEC_SEQ : SEQ, p0 = chunk * RPU;
  const int qpos = p0 + (MODE == 2 ? (wave & 3) * 16 : (wave & 1) * 16) + c;
  const int map = MODE == 2 ? (wave >> 2) : 0;
  const int hcol = MODE == 2 ? hh * 128 + map * 64 : (hh * 4 + (wave >> 1)) * 64;
  const int kcol = A.kcol0 + hh * KW, vcol = A.vcol0 + hh * KW, ccol = hh * KW;
  const int ncache = lat ? PAST / 64 : 0;
  int tlo = 0, thi = L / 64 - 1;
  if (MODE == 1 && lat) { const int lo = p0 - 128 < 0 ? 0 : p0 - 128, hi = p0 + RPU - 1 + 128 > L - 1 ? L - 1 : p0 + RPU - 1 + 128; tlo = lo / 64; thi = hi / 64; }
  const int NT = ncache + (thi - tlo + 1);
  bf16x8 qf[2];
  { const bf16_t* qp = A.QKV + (size_t)(s0 + qpos) * A.ld + hcol + 8 * g; qf[0] = *(const bf16x8*)qp; qf[1] = *(const bf16x8*)(qp + 32); }
  if (FUSE_QKPOST) {
    float x[2][8]; unpack8(__builtin_bit_cast(u32x4, qf[0]), x[0]); unpack8(__builtin_bit_cast(u32x4, qf[1]), x[1]);
    float ss = 0.f;
#pragma unroll
    for (int ks = 0; ks < 2; ++ks)
#pragma unroll
      for (int e = 0; e < 8; ++e) ss += x[ks][e] * x[ks][e];
    ss += shx(ss, 16, lane); ss += shx(ss, 32, lane);
    const float r = 1.0f / sqrtf(ss / 64.0f + EPS);
#pragma unroll
    for (int ks = 0; ks < 2; ++ks) { const f32x4 w0 = *(const f32x4*)(A.qn + 32 * ks + 8 * g), w1 = *(const f32x4*)(A.qn + 32 * ks + 8 * g + 4);
      x[ks][0] *= r * w0.x; x[ks][1] *= r * w0.y; x[ks][2] *= r * w0.z; x[ks][3] *= r * w0.w; x[ks][4] *= r * w1.x; x[ks][5] *= r * w1.y; x[ks][6] *= r * w1.z; x[ks][7] *= r * w1.w; }
    if (lat) { const bool x2side = (g & 2) != 0;
#pragma unroll
      for (int ks = 0; ks < 2; ++ks) { const f32x4* tb = (const f32x4*)(A.rope + ((size_t)(qpos * 2 + ks) * 16 + 8 * (g & 1)) * 2);
#pragma unroll
        for (int e2 = 0; e2 < 4; ++e2) { const f32x4 cs = tb[e2]; const float p0 = shx(x[ks][2 * e2], 32, lane), p1 = shx(x[ks][2 * e2 + 1], 32, lane);
          x[ks][2 * e2] = x2side ? x[ks][2 * e2] * cs.x + p0 * cs.y : x[ks][2 * e2] * cs.x - p0 * cs.y;
          x[ks][2 * e2 + 1] = x2side ? x[ks][2 * e2 + 1] * cs.z + p1 * cs.w : x[ks][2 * e2 + 1] * cs.z - p1 * cs.w; } } }
    qf[0] = __builtin_bit_cast(bf16x8, pack8(x[0])); qf[1] = __builtin_bit_cast(bf16x8, pack8(x[1]));
  }
  f32x4 o[NDB];
#pragma unroll
  for (int db = 0; db < NDB; ++db) o[db] = (f32x4){0.f, 0.f, 0.f, 0.f};
  float m = NEGBIG, lsum = 0.f;
  f32x4 rkA[NCH][2], rvA[NCH][2], rkB[NCH][2], rvB[NCH][2];
  auto load_tileA = [&](int t) {
    if (t < ncache) {
#pragma unroll
      for (int i = 0; i < NCH; ++i) { const int id = tid + 512 * i, row = id / CPR, ch = id % CPR; const size_t off = (size_t)(b * PAST + t * 64 + row) * A.cld + ccol + ch * 8;
        rkA[i][0] = *(const f32x4*)(A.ck + off); rkA[i][1] = *(const f32x4*)(A.ck + off + 4); rvA[i][0] = *(const f32x4*)(A.cv + off); rvA[i][1] = *(const f32x4*)(A.cv + off + 4); }
    } else {
      const int r0 = s0 + (tlo + t - ncache) * 64;
#pragma unroll
      for (int i = 0; i < NCH; ++i) { const int id = tid + 512 * i, row = id / CPR, ch = id % CPR; const bf16_t* rp = A.QKV + (size_t)(r0 + row) * A.ld + ch * 8;
        rkA[i][0] = *(const f32x4*)(rp + kcol); rvA[i][0] = *(const f32x4*)(rp + vcol); }
    }
  };
  auto write_tileA = [&](int t, int buf) {
    LAS unsigned char* Kb = lds + OFF_K + buf * KBUF; LAS unsigned char* Vb = lds + OFF_V + buf * VBUF;
#pragma unroll
    for (int i = 0; i < NCH; ++i) { const int id = tid + 512 * i, row = id / CPR, ch = id % CPR;
      const int pch = KW == 64 ? (ch ^ ((row >> 1) & 7)) : (ch ^ (row & 15));
      u32x4 kq, vq;
      if (t < ncache) {
        kq.x = pk_bf16(rkA[i][0].x, rkA[i][0].y); kq.y = pk_bf16(rkA[i][0].z, rkA[i][0].w); kq.z = pk_bf16(rkA[i][1].x, rkA[i][1].y); kq.w = pk_bf16(rkA[i][1].z, rkA[i][1].w);
        vq.x = pk_bf16(rvA[i][0].x, rvA[i][0].y); vq.y = pk_bf16(rvA[i][0].z, rvA[i][0].w); vq.z = pk_bf16(rvA[i][1].x, rvA[i][1].y); vq.w = pk_bf16(rvA[i][1].z, rvA[i][1].w);
      } else { kq = __builtin_bit_cast(u32x4, rkA[i][0]); vq = __builtin_bit_cast(u32x4, rvA[i][0]);
        if (FUSE_QKPOST) {
          const int j = ch & 7, kpos = (tlo + t - ncache) * 64 + row;
          float x[8]; unpack8(kq, x); float ss = 0.f;
#pragma unroll
          for (int e = 0; e < 8; ++e) ss += x[e] * x[e];
          ss += shx(ss, 1, lane); ss += shx(ss, 2, lane); ss += shx(ss, 4, lane);
          const float r = 1.0f / sqrtf(ss / 64.0f + EPS);
          const f32x4 w0 = *(const f32x4*)(A.kn + 8 * j), w1 = *(const f32x4*)(A.kn + 8 * j + 4);
          x[0] *= r * w0.x; x[1] *= r * w0.y; x[2] *= r * w0.z; x[3] *= r * w0.w; x[4] *= r * w1.x; x[5] *= r * w1.y; x[6] *= r * w1.z; x[7] *= r * w1.w;
          if (lat) { const int a = j >> 2; const f32x4* tb = (const f32x4*)(A.rope + ((size_t)(kpos * 2 + a) * 16 + 8 * (j & 1)) * 2); const bool x2side = (j & 2) != 0;
#pragma unroll
            for (int e2 = 0; e2 < 4; ++e2) { const f32x4 cs = tb[e2]; const float p0 = shx(x[2 * e2], 2, lane), p1 = shx(x[2 * e2 + 1], 2, lane);
              x[2 * e2] = x2side ? x[2 * e2] * cs.x + p0 * cs.y : x[2 * e2] * cs.x - p0 * cs.y;
              x[2 * e2 + 1] = x2side ? x[2 * e2 + 1] * cs.z + p1 * cs.w : x[2 * e2 + 1] * cs.z - p1 * cs.w; } }
          kq = pack8(x);
          if (!lat && kpos >= p0 && kpos < p0 + RPU) {
            constexpr int KOW = MODE == 2 ? 1024 : 256; const size_t oo = (size_t)(s0 + kpos) * KOW + hh * KW + ch * 8;
            *(f32x4*)(A.kout + oo) = (f32x4){x[0], x[1], x[2], x[3]}; *(f32x4*)(A.kout + oo + 4) = (f32x4){x[4], x[5], x[6], x[7]};
            float v[8]; unpack8(vq, v); *(f32x4*)(A.vout + oo) = (f32x4){v[0], v[1], v[2], v[3]}; *(f32x4*)(A.vout + oo + 4) = (f32x4){v[4], v[5], v[6], v[7]}; }
        } }
      *(LAS u32x4*)(Kb + row * KROWB + pch * 16) = kq; *(LAS u32x4*)(Vb + row * VROWB + ch * 16) = vq; }
  };
  auto load_tileB = [&](int t) {
    if (t < ncache) {
#pragma unroll
      for (int i = 0; i < NCH; ++i) { const int id = tid + 512 * i, row = id / CPR, ch = id % CPR; const size_t off = (size_t)(b * PAST + t * 64 + row) * A.cld + ccol + ch * 8;
        rkB[i][0] = *(const f32x4*)(A.ck + off); rkB[i][1] = *(const f32x4*)(A.ck + off + 4); rvB[i][0] = *(const f32x4*)(A.cv + off); rvB[i][1] = *(const f32x4*)(A.cv + off + 4); }
    } else {
      const int r0 = s0 + (tlo + t - ncache) * 64;
#pragma unroll
      for (int i = 0; i < NCH; ++i) { const int id = tid + 512 * i, row = id / CPR, ch = id % CPR; const bf16_t* rp = A.QKV + (size_t)(r0 + row) * A.ld + ch * 8;
        rkB[i][0] = *(const f32x4*)(rp + kcol); rvB[i][0] = *(const f32x4*)(rp + vcol); }
    }
  };
  auto write_tileB = [&](int t, int buf) {
    LAS unsigned char* Kb = lds + OFF_K + buf * KBUF; LAS unsigned char* Vb = lds + OFF_V + buf * VBUF;
#pragma unroll
    for (int i = 0; i < NCH; ++i) { const int id = tid + 512 * i, row = id / CPR, ch = id % CPR;
      const int pch = KW == 64 ? (ch ^ ((row >> 1) & 7)) : (ch ^ (row & 15));
      u32x4 kq, vq;
      if (t < ncache) {
        kq.x = pk_bf16(rkB[i][0].x, rkB[i][0].y); kq.y = pk_bf16(rkB[i][0].z, rkB[i][0].w); kq.z = pk_bf16(rkB[i][1].x, rkB[i][1].y); kq.w = pk_bf16(rkB[i][1].z, rkB[i][1].w);
        vq.x = pk_bf16(rvB[i][0].x, rvB[i][0].y); vq.y = pk_bf16(rvB[i][0].z, rvB[i][0].w); vq.z = pk_bf16(rvB[i][1].x, rvB[i][1].y); vq.w = pk_bf16(rvB[i][1].z, rvB[i][1].w);
      } else { kq = __builtin_bit_cast(u32x4, rkB[i][0]); vq = __builtin_bit_cast(u32x4, rvB[i][0]);
        if (FUSE_QKPOST) {
          const int j = ch & 7, kpos = (tlo + t - ncache) * 64 + row;
          float x[8]; unpack8(kq, x); float ss = 0.f;
#pragma unroll
          for (int e = 0; e < 8; ++e) ss += x[e] * x[e];
          ss += shx(ss, 1, lane); ss += shx(ss, 2, lane); ss += shx(ss, 4, lane);
          const float r = 1.0f / sqrtf(ss / 64.0f + EPS);
          const f32x4 w0 = *(const f32x4*)(A.kn + 8 * j), w1 = *(const f32x4*)(A.kn + 8 * j + 4);
          x[0] *= r * w0.x; x[1] *= r * w0.y; x[2] *= r * w0.z; x[3] *= r * w0.w; x[4] *= r * w1.x; x[5] *= r * w1.y; x[6] *= r * w1.z; x[7] *= r * w1.w;
          if (lat) { const int a = j >> 2; const f32x4* tb = (const f32x4*)(A.rope + ((size_t)(kpos * 2 + a) * 16 + 8 * (j & 1)) * 2); const bool x2side = (j & 2) != 0;
#pragma unroll
            for (int e2 = 0; e2 < 4; ++e2) { const f32x4 cs = tb[e2]; const float p0 = shx(x[2 * e2], 2, lane), p1 = shx(x[2 * e2 + 1], 2, lane);
              x[2 * e2] = x2side ? x[2 * e2] * cs.x + p0 * cs.y : x[2 * e2] * cs.x - p0 * cs.y;
              x[2 * e2 + 1] = x2side ? x[2 * e2 + 1] * cs.z + p1 * cs.w : x[2 * e2 + 1] * cs.z - p1 * cs.w; } }
          kq = pack8(x);
          if (!lat && kpos >= p0 && kpos < p0 + RPU) {
            constexpr int KOW = MODE == 2 ? 1024 : 256; const size_t oo = (size_t)(s0 + kpos) * KOW + hh * KW + ch * 8;
            *(f32x4*)(A.kout + oo) = (f32x4){x[0], x[1], x[2], x[3]}; *(f32x4*)(A.kout + oo + 4) = (f32x4){x[4], x[5], x[6], x[7]};
            float v[8]; unpack8(vq, v); *(f32x4*)(A.vout + oo) = (f32x4){v[0], v[1], v[2], v[3]}; *(f32x4*)(A.vout + oo + 4) = (f32x4){v[4], v[5], v[6], v[7]}; }
        } }
      *(LAS u32x4*)(Kb + row * KROWB + pch * 16) = kq; *(LAS u32x4*)(Vb + row * VROWB + ch * 16) = vq; }
  };
#define ATT_BAR() do { asm volatile("s_waitcnt lgkmcnt(0)" ::: "memory"); __builtin_amdgcn_s_barrier(); asm volatile("" ::: "memory"); } while (0)
  auto compute = [&](int t, int cur) {
    const LAS unsigned char* Kb = lds + OFF_K + cur * KBUF; const LAS unsigned char* Vb = lds + OFF_V + cur * VBUF;
    f32x4 s[4];
#pragma unroll
    for (int kb = 0; kb < 4; ++kb) { s[kb] = (f32x4){0.f, 0.f, 0.f, 0.f};
#pragma unroll
      for (int ks = 0; ks < 2; ++ks) { const int row = 16 * kb + c, ch = map * 8 + 4 * ks + g, pch = KW == 64 ? (ch ^ ((row >> 1) & 7)) : (ch ^ (row & 15));
        const bf16x8 kf = *(const LAS bf16x8*)(Kb + row * KROWB + pch * 16);
        s[kb] = __builtin_amdgcn_mfma_f32_16x16x32_bf16(kf, qf[ks], s[kb], 0, 0, 0); } }
    const bool band = (MODE == 1) && lat && (t >= ncache); const int tb = (tlo + t - ncache) * 64;
    float ps = 0.f;
    if (ATT_FIXED_REF) {
#pragma unroll
      for (int kb = 0; kb < 4; ++kb)
#pragma unroll
        for (int r = 0; r < 4; ++r) { float p = __builtin_amdgcn_exp2f(s[kb][r] * SC - REF2);
          if (band) { const int dlt = qpos - (tb + 16 * kb + 4 * g + r); if (dlt > 128 || dlt < -128) p = 0.f; }
          s[kb][r] = p; ps += p; }
      lsum += ps;
    } else {
    float mx = NEGBIG;
#pragma unroll
    for (int kb = 0; kb < 4; ++kb)
#pragma unroll
      for (int r = 0; r < 4; ++r) { float v = s[kb][r] * SC;
        if (band) { const int dlt = qpos - (tb + 16 * kb + 4 * g + r); if (dlt > 128 || dlt < -128) v = NEGBIG; }
        s[kb][r] = v; mx = fmaxf(mx, v); }
    mx = fmaxf(mx, shx(mx, 16, lane)); mx = fmaxf(mx, shx(mx, 32, lane));
    const float mn = fmaxf(m, mx), alpha = __builtin_amdgcn_exp2f(m - mn); m = mn;
#pragma unroll
    for (int kb = 0; kb < 4; ++kb)
#pragma unroll
      for (int r = 0; r < 4; ++r) { const float p = __builtin_amdgcn_exp2f(s[kb][r] - mn); s[kb][r] = p; ps += p; }
    lsum = lsum * alpha + ps;
#pragma unroll
    for (int db = 0; db < NDB; ++db) o[db] = o[db] * alpha;
    }
    bf16x8 pf[2];
#pragma unroll
    for (int ks = 0; ks < 2; ++ks) { u32x4 pk; pk.x = pk_bf16(s[2 * ks][0], s[2 * ks][1]); pk.y = pk_bf16(s[2 * ks][2], s[2 * ks][3]); pk.z = pk_bf16(s[2 * ks + 1][0], s[2 * ks + 1][1]); pk.w = pk_bf16(s[2 * ks + 1][2], s[2 * ks + 1][3]);
      pf[ks] = __builtin_bit_cast(bf16x8, pk); }
#pragma unroll
    for (int db = 0; db < NDB; ++db)
#pragma unroll
      for (int ks = 0; ks < 2; ++ks) { const LAS unsigned char* vp = Vb + (32 * ks + 4 * g + (c >> 2)) * VROWB + 32 * db + 8 * (c & 3);
        const s16x4 lo = tr_read(vp), hi = tr_read(vp + 16 * VROWB);
        const bf16x8 vt = (bf16x8){lo[0], lo[1], lo[2], lo[3], hi[0], hi[1], hi[2], hi[3]};
        o[db] = __builtin_amdgcn_mfma_f32_16x16x32_bf16(vt, pf[ks], o[db], 0, 0, 0); }
  };
  load_tileA(0); if (NT > 1) load_tileB(1);
  write_tileA(0, 0); ATT_BAR();
  for (int t = 0; t < NT; t += 2) {
    if (t + 2 < NT) load_tileA(t + 2);
    compute(t, 0);
    if (t + 1 < NT) write_tileB(t + 1, 1);
    ATT_BAR();
    if (t + 1 >= NT) break;
    if (t + 3 < NT) load_tileB(t + 3);
    compute(t + 1, 1);
    if (t + 2 < NT) write_tileA(t + 2, 0);
    ATT_BAR();
  }
  lsum += shx(lsum, 16, lane); lsum += shx(lsum, 32, lane);
  if (MODE == 1) lsum += __builtin_amdgcn_exp2f(A.sink[hh * 4 + (wave >> 1)] * LOG2E - (ATT_FIXED_REF ? REF2 : m));
  const float rl = 1.0f / lsum;
  if (MODE != 2) {
    bf16_t* op = A.O + (size_t)(s0 + qpos) * D + hcol + 4 * g;
#pragma unroll
    for (int db = 0; db < NDB; ++db) { u32x2 pk; pk.x = pk_bf16(o[db][0] * rl, o[db][1] * rl); pk.y = pk_bf16(o[db][2] * rl, o[db][3] * rl); *(u32x2*)(op + 16 * db) = pk; }
  } else {
    LAS float* comb = (LAS float*)(lds + OFF_COMB);
    const int row = (wave & 3) * 16 + c;
    if (map == 1) {
#pragma unroll
      for (int db = 0; db < NDB; ++db) *(LAS f32x4*)(comb + row * 132 + 16 * db + 4 * g) = o[db] * rl;
    }
    __syncthreads();
    if (map == 0) {
      float ss = 0.f;
#pragma unroll
      for (int db = 0; db < NDB; ++db) { const f32x4 o2 = *(const LAS f32x4*)(comb + row * 132 + 16 * db + 4 * g); o[db] = o[db] * rl - lam * o2;
        ss += (o[db][0] * o[db][0] + o[db][1] * o[db][1]) + (o[db][2] * o[db][2] + o[db][3] * o[db][3]); }
      ss += shx(ss, 16, lane); ss += shx(ss, 32, lane);
      const float rs = (1.0f - A.lam_init) / sqrtf(ss / 128.0f + EPS);
      bf16_t* op = A.O + (size_t)(s0 + qpos) * D + hh * 128 + 4 * g;
#pragma unroll
      for (int db = 0; db < NDB; ++db) { const f32x4 sg = *(const f32x4*)(A.sub_g + 16 * db + 4 * g); u32x2 pk; pk.x = pk_bf16(o[db][0] * rs * sg.x, o[db][1] * rs * sg.y); pk.y = pk_bf16(o[db][2] * rs * sg.z, o[db][3] * rs * sg.w);
        *(u32x2*)(op + 16 * db) = pk; }
    }
    __syncthreads();
  }
}

template <int MODE>
__device__ __forceinline__ void phase(const Args& A, LAS unsigned char* lds) {
  constexpr int NH = MODE == 2 ? 8 : 4, RPU = MODE == 2 ? 64 : 32, CPS_L = DEC_SEQ / RPU, CPS_C = SEQ / RPU, NLAT = DEC_BATCH * NH * CPS_L, NCTX = BATCH * NH * CPS_C;
  float lam = 0.f;
  if (MODE == 2) { const int lane = opaque_i((int)threadIdx.x) & 63; const float d1 = wave_sum(A.lq1[lane] * A.lk1[lane], lane), d2 = wave_sum(A.lq2[lane] * A.lk2[lane], lane); lam = expf(d1) - expf(d2) + A.lam_init; }
  for (int u = opaque_block(); u < NLAT; u += (int)gridDim.x) unit<MODE>(A, true, u / (NH * CPS_L), (u / CPS_L) % NH, u % CPS_L, lam, lds);
  for (int u = opaque_block(); u < NCTX; u += (int)gridDim.x) unit<MODE>(A, false, u / (NH * CPS_C), (u / CPS_C) % NH, u % CPS_C, lam, lds);
}
}
#endif


#ifndef HOST_EMU
#define XB_TMO      128
#define XB_XCNT(j)  (256  + 64 * (j))
#define XB_XSUB(j)  (1280 + 64 * (j))
#define XB_XGEN(j)  (2304 + 64 * (j))
#define XB_TOP      3328
#define XB_TOPGEN   3392
#define XCD_BAR_WORDS 3456
#define XB_SPIN_CAP (1u << 18)

__device__ __forceinline__ unsigned xb_ld(unsigned* p)              { return __hip_atomic_load(p, __ATOMIC_RELAXED, __HIP_MEMORY_SCOPE_AGENT); }
__device__ __forceinline__ unsigned xb_add(unsigned* p, unsigned v) { return __hip_atomic_fetch_add(p, v, __ATOMIC_RELAXED, __HIP_MEMORY_SCOPE_AGENT); }
__device__ __forceinline__ unsigned xb_xcc_id() { return (unsigned)__builtin_amdgcn_s_getreg((3 << 11) | 20) & 0xFu; }
#define XB_SPIN(cond, bar) do { unsigned _sp = 0; while (cond) { __builtin_amdgcn_s_sleep(1); \
    if ((++_sp & 255u) == 0u) { if (xb_ld(&(bar)[XB_TMO])) break; if (_sp > XB_SPIN_CAP) { atomicAdd(&(bar)[XB_TMO], 1u); break; } } } } while (0)

struct XcdBarrier {
    unsigned* bar; unsigned x;
    volatile LAS unsigned* st;
};

__device__ __forceinline__ XcdBarrier xcd_barrier_post(unsigned* bar, volatile LAS unsigned* st) {
    XcdBarrier b; b.bar = bar; b.x = xb_xcc_id(); b.st = st;
    if (threadIdx.x == 0) (void)xb_add(&bar[XB_XCNT(b.x)], 1u);
    return b;
}
__device__ __forceinline__ void xcd_barrier_complete(unsigned* bar, unsigned x, unsigned& nloc, unsigned& nx) {
    const unsigned G = gridDim.x * gridDim.y * gridDim.z;
    unsigned sum, cnt, mine, sp = 0u;
    for (;;) {
        sum = 0u; cnt = 0u; mine = 0u;
#pragma unroll
        for (unsigned j = 0; j < 16; ++j) { const unsigned c = xb_ld(&bar[XB_XCNT(j)]); sum += c; cnt += (c > 0u) ? 1u : 0u; mine = (j == x) ? c : mine; }
        if (sum == G) break;
        __builtin_amdgcn_s_sleep(1);
        if ((++sp & 255u) == 0u) { if (xb_ld(&bar[XB_TMO])) break; if (sp > XB_SPIN_CAP) { atomicAdd(&bar[XB_TMO], 1u); break; } }
    }
    nloc = mine > 0u ? mine : 1u; nx = cnt > 0u ? cnt : 1u;
}

__device__ __forceinline__ void xcd_barrier(const XcdBarrier& b) {
    asm volatile("s_waitcnt vmcnt(0)" ::: "memory");
    __syncthreads();
    if (threadIdx.x == 0) {
        unsigned* bar = b.bar;
        __builtin_amdgcn_s_waitcnt(0);
        unsigned nloc = b.st[0], nx = b.st[1];
        if (nloc == 0u) { xcd_barrier_complete(bar, b.x, nloc, nx); b.st[0] = nloc; b.st[1] = nx; }
        const unsigned old = xb_add(&bar[XB_XSUB(b.x)], 1u);
        const unsigned gen = old / nloc;
        if (old + 1u == (gen + 1u) * nloc) {
            __builtin_amdgcn_fence(__ATOMIC_RELEASE, "agent");
            asm volatile("s_waitcnt vmcnt(0)" ::: "memory");
            const unsigned og = xb_add(&bar[XB_TOP], 1u);
            const unsigned tg = og / nx;
            if (og + 1u == (tg + 1u) * nx) xb_add(&bar[XB_TOPGEN], 1u);
            else XB_SPIN(xb_ld(&bar[XB_TOPGEN]) == tg, bar);
            __builtin_amdgcn_fence(__ATOMIC_ACQUIRE, "agent");
            xb_add(&bar[XB_XGEN(b.x)], 1u);
            asm volatile("s_waitcnt vmcnt(0)" ::: "memory");
        } else {
            XB_SPIN(xb_ld(&bar[XB_XGEN(b.x)]) == gen, bar);
            __builtin_amdgcn_fence(__ATOMIC_ACQUIRE, "agent");
            asm volatile("s_waitcnt vmcnt(0)" ::: "memory");
        }
    }
    __syncthreads();
}
#endif

#ifndef HOST_EMU
constexpr int LDS_BYTES = 147456;
#ifndef FAST_PRO
#define FAST_PRO 1
#endif
#ifndef FAST_NORM
#define FAST_NORM 1
#endif
#ifndef FAST_POOL
#define FAST_POOL 1
#endif
#ifndef FAST_QKPOST
#define FAST_QKPOST 1
#endif
#ifndef FAST_CONV
#define FAST_CONV 1
#endif
#ifndef FAST_ATTN
#define FAST_ATTN 1
#endif
#ifndef REP_GEMM
#define REP_GEMM 0
#endif
#ifndef REP_ATTN
#define REP_ATTN 0
#endif
#ifndef REP_ELEM
#define REP_ELEM 0
#endif
#ifndef REP_PRO
#define REP_PRO 0
#endif
#ifndef REP_SYNC
#define REP_SYNC 0
#endif
#ifndef USE_CG_SYNC
#define USE_CG_SYNC 0
#endif
__global__ void __launch_bounds__(512, 2) mega(Params P) {
  extern __shared__ __attribute__((aligned(16))) unsigned char lds_raw[];
  cg::grid_group grid = cg::this_grid();
  PG8_LAS unsigned char* lds = (PG8_LAS unsigned char*)lds_raw;
  const Ctx c = make_ctx(P);
  volatile LAS unsigned* MISC = (volatile LAS unsigned*)((LAS unsigned char*)lds_raw + 131072 + 320);
  if (threadIdx.x < 32) MISC[threadIdx.x] = 0u;
  __syncthreads();
  { unsigned* b0_ = (unsigned*)(P.ws + WS_CTL); asm volatile("" : "+s"(b0_)); (void)xcd_barrier_post(b0_, MISC + 8); }
#define BAR_NOW() do { XcdBarrier bar_; { unsigned* b0_ = (unsigned*)(P.ws + WS_CTL); asm volatile("" : "+s"(b0_)); bar_.bar = b0_; } bar_.x = xb_xcc_id(); bar_.st = (volatile LAS unsigned*)((LAS unsigned char*)lds_raw + 131072 + 320) + 8; xcd_barrier(bar_); } while (0)
#define GSYNC() do { if (USE_CG_SYNC) grid.sync(); else BAR_NOW(); if (REP_SYNC) { if (USE_CG_SYNC) grid.sync(); else BAR_NOW(); } } while (0)
#define NAIVE(step) do { naive_step((step), P, c); } while (0)
#define GEMM_RUN(step, rep_) do { GemmDesc g; gemm_desc((step), P, c, g); \
    pg8::Gemm gg{g.A, g.Bt, T, g.N, g.K, g.lda, g.ldb, g.a_pn_step, g.ksplit}; pg8::StaticOrder S; S.init(T, g.N, (int)gridDim.x, opaque_block(), g.ksplit); \
    if (g.res) { bf16_t* slab_ = (bf16_t*)(c.ws_p() + (pend == (const bf16_t*)(c.ws_p() + WS_SA) ? WS_SB : WS_SA)); \
      float* xw_ = (rep_) == 0 ? c.X() : (float*)(g.K == DFF ? c.Ub() : c.Gb()); const bool first_ = ((step) == N_PRE + 7); \
      pg8::EpiRes E{xw_, first_ ? pin(P, I_XP) : (const float*)xw_, first_ ? pin(P, I_XS) - (size_t)TCTX * D : (const float*)xw_, MODl, g.gate_chunk, g.colscale, pend, slab_}; pg8::gemm_phase<pg8::EpiRes, pg8::StaticOrder, true, true>(lds, gg, S, E); \
      if ((rep_) == 0) pend = g.ksplit > 1 ? (const bf16_t*)slab_ : nullptr; } \
    else { pg8::EpiBf16<0> E{g.C, g.ldc, nullptr, 0, 0, 1.f}; pg8::gemm_phase<pg8::EpiBf16<0>, pg8::StaticOrder, true, true>(lds, gg, S, E); } } while (0)
#define GEMM_STEP(step) do { GEMM_RUN(step, 0); if (REP_GEMM) { __syncthreads(); GEMM_RUN(step, 1); } } while (0)
  const bf16_t* pend = nullptr;
#define BG_AFTER_GEMM(nunits, ticks) do { const int G_ = (int)gridDim.x, b_ = opaque_block(), r_ = ((nunits) + G_ - 1) / G_, full_ = (nunits) - (r_ - 1) * G_; \
    if (b_ >= full_) bg_work(P, c, (LAS unsigned char*)lds_raw, (ticks), bg_total_items()); } while (0)
  if (FAST_PRO) { for (int rep_ = 0; rep_ < 1 + REP_PRO; ++rep_) ph_prologue(P, c, (LAS unsigned char*)lds_raw); GSYNC(); }
  else { NAIVE(0); GSYNC(); NAIVE(1); GSYNC(); NAIVE(2); GSYNC(); }
#pragma unroll 1
  for (int l = 0; l < 4; ++l) {
    const int s0 = N_PRE + l * STEPS_PER_LAYER;
    const float* MODl = c.MOD() + (size_t)l * NCOND * MODW;
    if (l > 0) bg_work(P, c, (LAS unsigned char*)lds_raw, 0xffffffffu, bg_end_of_layer(l));
    if (FAST_NORM) { for (int rep_ = 0; rep_ < 1 + REP_ELEM; ++rep_) ph_norm(l == 0 ? pin(P, I_XP) : (const float*)c.X(), l == 0 ? pin(P, I_XS) - (size_t)TCTX * D : (const float*)c.X(), pend, pin(P, I_N1G) + l * D, MODl, 0, 1, c.Hb()); GSYNC(); }
    else { NAIVE(s0 + 0); GSYNC(); NAIVE(s0 + 1); GSYNC(); }
    if (l == 0) {
      if (FAST_POOL) { for (int rep_ = 0; rep_ < 1 + REP_ELEM; ++rep_) ph_pool(c.Hb(), c.PDb()); } else NAIVE(s0 + 2);
      GSYNC();
    } else {
      if (FUSE_QKEPI) {
        GemmDesc g; gemm_desc(s0 + 2, P, c, g);
        pg8::Gemm gg{g.A, g.Bt, T, g.N, g.K, g.lda, g.ldb, g.a_pn_step, 1}; pg8::StaticOrder S; S.init(T, g.N, (int)gridDim.x, opaque_block(), 1);
        pg8::EpiQK E{c.QKVb(), g.N, 1024, l == 2 ? 2048 : 1280, pin(P, l == 1 ? I_GQN : (l == 2 ? I_DQN : I_WQN)), pin(P, l == 1 ? I_GKN : (l == 2 ? I_DKN : I_WKN)), c.ROPE(),
                     l == 1 ? c.o_gk() : (l == 2 ? c.o_dk() : c.o_wk()), l == 1 ? c.o_gv() : (l == 2 ? c.o_dv() : c.o_wv()), l == 2 ? 1024 : 256, (PG8_LAS float*)(lds + 131072 + 1024)};
        pg8::gemm_phase<pg8::EpiQK, pg8::StaticOrder, true, true>(lds, gg, S, E);
      } else GEMM_STEP(s0 + 2);
      GSYNC();
      if (FUSE_QKPOST || FUSE_QKEPI) {   }
      else if (FAST_QKPOST) {
        if (l == 2) ph_qkpost(c.QKVb(), 3072, 16, 16, 16, 1024, 2048, pin(P, I_DQN), pin(P, I_DKN), c.ROPE(), c.o_dk(), c.o_dv());
        else ph_qkpost(c.QKVb(), 1536, 16, 4, 4, 1024, 1280, pin(P, l == 1 ? I_GQN : I_WQN), pin(P, l == 1 ? I_GKN : I_WKN), c.ROPE(), l == 1 ? c.o_gk() : c.o_wk(), l == 1 ? c.o_gv() : c.o_wv());
      } else NAIVE(s0 + 3);
      if (!FUSE_QKPOST && !FUSE_QKEPI) GSYNC();
      if (FAST_ATTN) {
        const float lam_init = 0.8f - 0.6f * expf(-0.3f * (float)l);
        for (int rep_ = 0; rep_ < 1 + REP_ATTN; ++rep_) {
        if (l == 2) { const att::Args A{c.QKVb(), 3072, 1024, 2048, pin(P, I_CDK), pin(P, I_CDV), 1024, nullptr, pin(P, I_DLQ1), pin(P, I_DLK1), pin(P, I_DLQ2), pin(P, I_DLK2), lam_init, pin(P, I_DSUB), c.Ob(), pin(P, I_DQN), pin(P, I_DKN), c.ROPE(), c.o_dk(), c.o_dv()};
          att::phase<2>(A, (LAS unsigned char*)lds_raw); }
        else if (l == 1) { const att::Args A{c.QKVb(), 1536, 1024, 1280, pin(P, I_CGK), pin(P, I_CGV), 256, nullptr, nullptr, nullptr, nullptr, nullptr, 0.f, nullptr, c.Ob(), pin(P, I_GQN), pin(P, I_GKN), c.ROPE(), c.o_gk(), c.o_gv()};
          att::phase<0>(A, (LAS unsigned char*)lds_raw); }
        else { const att::Args A{c.QKVb(), 1536, 1024, 1280, pin(P, I_CWK), pin(P, I_CWV), 256, pin(P, I_WSINK), nullptr, nullptr, nullptr, nullptr, 0.f, nullptr, c.Ob(), pin(P, I_WQN), pin(P, I_WKN), c.ROPE(), c.o_wk(), c.o_wv()};
          att::phase<1>(A, (LAS unsigned char*)lds_raw); }
        }
        GSYNC();
      } else {
        NAIVE(s0 + 5); GSYNC();
        if (l == 2) { NAIVE(s0 + 6); GSYNC(); }
      }
    }
    GEMM_STEP(s0 + 7); BG_AFTER_GEMM((T / 256) * (D / 256) * (l == 0 ? 1 : KSPLIT), l == 0 ? 400u : 800u); GSYNC();
    if (FAST_NORM) { for (int rep_ = 0; rep_ < 1 + REP_ELEM; ++rep_) ph_norm(c.X(), c.X(), pend, pin(P, I_N2G) + l * D, MODl, 3, 4, c.Hb()); GSYNC(); }
    else { NAIVE(s0 + 8); GSYNC(); NAIVE(s0 + 9); GSYNC(); }
    if (FUSE_CONV) {
      GemmDesc g; gemm_desc(s0 + 10, P, c, g);
      pg8::Gemm gg{g.A, g.Bt, T, g.N, g.K, g.lda, g.ldb, g.a_pn_step, 1}; pg8::LimitedOrder S; S.init(T, g.N, (int)gridDim.x, opaque_block(), 1);
      const int G_ = (int)gridDim.x, full_rounds = S.nwg / G_, left = S.nwg - full_rounds * G_;
      S.maxr = (WIN_TAIL && left * 4 < G_) ? full_rounds : full_rounds + 1;
      pg8::EpiConv E{c.Gb(), pin(P, I_FCW) + (size_t)l * 3 * DFF2, pin(P, I_FCB) + (size_t)l * DFF2, (float*)(c.ws_p() + WS_EDGE), (PG8_LAS unsigned*)(lds + 131072 + 1024)};
      pg8::gemm_phase<pg8::EpiConv, pg8::LimitedOrder, true, true>(lds, gg, S, E);
      if (S.maxr == full_rounds) {
        for (int su = opaque_block(); su < left * 16; su += G_) {
          pg8::StaticOrder S2; S2.init(T, g.N, G_, su >> 4, 1); pg8::Unit u; S2.next(full_rounds, u);
          win_subunit(g.A, g.Bt, pin(P, I_FCW) + (size_t)l * 3 * DFF2, pin(P, I_FCB) + (size_t)l * DFF2, c.Gb(), (float*)(c.ws_p() + WS_EDGE), (LAS unsigned char*)lds_raw, u.pm, u.pn, su & 15);
        }
      }
    } else {
    GEMM_STEP(s0 + 10); GSYNC();
    if (FAST_CONV) { for (int rep_ = 0; rep_ < 1 + REP_ELEM; ++rep_) ph_convgate(c.Ub(), pin(P, I_FCW) + (size_t)l * 3 * DFF2, pin(P, I_FCB) + (size_t)l * DFF2, c.Gb()); } else NAIVE(s0 + 11);
    }
    GSYNC();
    if (FUSE_CONV) {
      GemmDesc g; gemm_desc(s0 + 12, P, c, g); pg8::StaticOrder S; S.init(T, g.N, (int)gridDim.x, opaque_block(), g.ksplit); pg8::Unit u;
      for (int i = 0; S.next(i, u); ++i) conv_fixup_unit((const float*)(c.ws_p() + WS_EDGE), pin(P, I_FCW) + (size_t)l * 3 * DFF2, pin(P, I_FCB) + (size_t)l * DFF2, c.Gb(), u.pm, u.kh * (DFF / g.ksplit), DFF / g.ksplit);
      asm volatile("s_waitcnt vmcnt(0)" ::: "memory"); __syncthreads();
    }
    GEMM_STEP(s0 + 12); BG_AFTER_GEMM((T / 256) * (D / 256) * ((DFF % 256 == 0) ? KSPLIT : 1), 2800u);
    if (l < 3) GSYNC();
  }
  if (pend) {
    GSYNC();
    const WaveId w = wave_id();
    for (int t = w.gw; t < T; t += w.ngw) { f32x4* xr = (f32x4*)(c.X() + (size_t)t * D) + w.lane; const u32x2* pr = (const u32x2*)(pend + (size_t)t * D) + w.lane;
#pragma unroll
      for (int j = 0; j < 4; ++j) { const u32x2 q = pr[64 * j]; xr[64 * j] = xr[64 * j] + (f32x4){bf_lo(q.x), bf_hi(q.x), bf_lo(q.y), bf_hi(q.y)}; } }
  }
}
#endif

extern "C" void kernel_launch(void* const* d_in, const int* in_sizes, int n_in, void* d_out, int out_size, void* d_ws, size_t ws_size,
                              hipStream_t stream) {
  (void)in_sizes; (void)n_in; (void)out_size;
  Params P{};
  for (int i = 0; i < N_IN; ++i) P.in[i] = (const float*)d_in[i];
  P.out = (float*)d_out; P.ws = (unsigned char*)d_ws;
#ifdef HOST_EMU
  for (int step = 0; step < N_STEPS; ++step) { if (step_is_noop(step)) continue; emu_launch(256, 8, [&] { const Ctx c = make_ctx(P); naive_step(step, P, c); }); }
#else
  static int grid_blocks = 0;
  if (!grid_blocks) {
    if (ws_size < WS_END) { fprintf(stderr, "kernel_launch: workspace too small (%zu < %zu)\n", ws_size, (size_t)WS_END); grid_blocks = -1; return; }
    int dev = 0, cus = 0, per_cu = 0;
    (void)hipGetDevice(&dev);
    (void)hipDeviceGetAttribute(&cus, hipDeviceAttributeMultiprocessorCount, dev);
    (void)hipFuncSetAttribute((const void*)mega, hipFuncAttributeMaxDynamicSharedMemorySize, LDS_BYTES);
    (void)hipOccupancyMaxActiveBlocksPerMultiprocessor(&per_cu, mega, 512, LDS_BYTES);
    if (per_cu < 1) { fprintf(stderr, "kernel_launch: occupancy query says %d blocks per CU\n", per_cu); per_cu = 1; }
    if (per_cu > 1) per_cu = 1;
    grid_blocks = cus * per_cu;
  }
  if (grid_blocks < 0) return;
  if (hipMemsetAsync((char*)d_ws + WS_CTL, 0, CTL_ZERO_BYTES, stream) != hipSuccess) { fprintf(stderr, "kernel_launch: hipMemsetAsync of the control words failed\n"); return; }
  void* args[] = {&P};
  hipError_t e = hipLaunchCooperativeKernel((void*)mega, dim3(grid_blocks), dim3(512), args, LDS_BYTES, stream);
  if (e != hipSuccess) fprintf(stderr, "cooperative launch failed: %s (grid %d)\n", hipGetErrorString(e), grid_blocks);
#endif
}
```

```cpp
#ifndef HOST_EMU
#include <hip/hip_runtime.h>
#include <hip/hip_cooperative_groups.h>
#include <cstdio>
#include <cstdint>
#include <cmath>
namespace cg = cooperative_groups;
#endif

#ifndef CFG_BATCH
#define CFG_BATCH 16
#endif
#ifndef ATT_FIXED_REF
#define ATT_FIXED_REF 1
#endif
#ifndef BG_QUEUE
#define BG_QUEUE 0
#endif
#ifndef WIN_TAIL
#define WIN_TAIL 0
#endif
#ifndef FUSE_QKEPI
#define FUSE_QKEPI 1
#endif
#ifndef FUSE_QKPOST
#define FUSE_QKPOST 0
#endif
#ifndef FUSE_CONV
#define FUSE_CONV 1
#endif
#ifndef CFG_DFF
#define CFG_DFF 2816
#endif

namespace cfg {
constexpr int D = 1024, BATCH = CFG_BATCH, SEQ = 256, DEC_BATCH = 2, DEC_SEQ = 1024, PAST = 256;
constexpr int TCTX = BATCH * SEQ, TLAT = DEC_BATCH * DEC_SEQ, T = TCTX + TLAT;
constexpr int DFF = CFG_DFF, DFF2 = 2 * DFF;
constexpr int NCOND = 3, MODW = 6 * D;
constexpr float EPS = 1e-6f;
}
using namespace cfg;

typedef unsigned short bf16_t;
#ifdef HOST_EMU
static inline float bf2f(bf16_t v) { unsigned u = (unsigned)v << 16; float f; memcpy(&f, &u, 4); return f; }
static inline bf16_t f2bf(float f) { unsigned u; memcpy(&u, &f, 4); return (bf16_t)((u + 0x7fffu + ((u >> 16) & 1u)) >> 16); }
#else
__device__ __forceinline__ float bf2f(bf16_t v) { return __uint_as_float((unsigned)v << 16); }
__device__ __forceinline__ bf16_t f2bf(float f) { unsigned u = __float_as_uint(f); return (bf16_t)((u + 0x7fffu + ((u >> 16) & 1u)) >> 16); }
#endif

__device__ __forceinline__ int tok_cond(int t) { return t < TCTX ? 0 : 1 + (t - TCTX) / DEC_SEQ; }
__device__ __forceinline__ void tok_seq(int t, int& s0, int& L) {
  if (t < TCTX) { s0 = (t / SEQ) * SEQ; L = SEQ; } else { s0 = TCTX + ((t - TCTX) / DEC_SEQ) * DEC_SEQ; L = DEC_SEQ; }
}
__device__ __forceinline__ float silu_f(float x) { return x / (1.0f + expf(-x)); }

#ifdef HOST_EMU
static inline long opaque_tid() { return (long)blockIdx.x * blockDim.x + threadIdx.x; }
#else
__device__ __forceinline__ long opaque_tid() { int t = (int)(blockIdx.x * blockDim.x + threadIdx.x); asm volatile("" : "+v"(t)); return (long)t; }
#endif
#define GRID_STRIDE(idx, total) \
  for (long idx = opaque_tid(), _gs = (long)gridDim.x * blockDim.x; idx < (long)(total); idx += _gs)

__device__ void nk_copy_x(const float* xp, const float* xs, float* X) {
  GRID_STRIDE(i, (long)T * D) X[i] = i < (long)TCTX * D ? xp[i] : xs[i - (long)TCTX * D];
}

__device__ void nk_mod(const float* c, const float* c_ctx, const float* w_mod, const float* b_mod, float* MOD, int nlayer) {
  GRID_STRIDE(i, (long)nlayer * NCOND * MODW) {
    const int n = (int)(i % MODW), cd = (int)((i / MODW) % NCOND), l = (int)(i / ((long)MODW * NCOND));
    const float* cv = cd == 0 ? c_ctx : c + (cd - 1) * D;
    const float* w = w_mod + (long)l * D * MODW + n;
    float acc = 0.f;
    for (int k = 0; k < D; ++k) acc += silu_f(cv[k]) * w[(long)k * MODW];
    MOD[i] = acc + b_mod[(long)l * MODW + n];
  }
}

__device__ void nk_rope_table(float* ROPE) {
  GRID_STRIDE(i, (long)DEC_SEQ * 32) {
    const int pos = (int)(i / 32), a = (int)((i / 16) % 2), f = (int)(i % 16);
    const float inv = powf(10000.0f, -(float)(2 * f) / 32.0f), ang = (a == 0 ? (float)(pos / 64) : (float)(pos % 64)) * inv;
    ROPE[2 * i] = cosf(ang); ROPE[2 * i + 1] = sinf(ang);
  }
}

__device__ void nk_wt(const float* W, int K, int N, bf16_t* WT) {
  GRID_STRIDE(i, (long)K * N) { const int n = (int)(i / K), k = (int)(i % K); WT[i] = f2bf(W[(long)k * N + n]); }
}

__device__ void nk_rstd(const float* X, float* RSTD) {
  GRID_STRIDE(t, T) {
    const float* x = X + t * D; float ss = 0.f;
    for (int d = 0; d < D; ++d) ss += x[d] * x[d];
    RSTD[t] = 1.0f / sqrtf(ss / (float)D + EPS);
  }
}

__device__ void nk_normmod(const float* X, const float* RSTD, const float* g, const float* MODl, int sh_chunk, int sc_chunk, bf16_t* Hb) {
  GRID_STRIDE(i, (long)T * D) {
    const int t = (int)(i / D), d = (int)(i % D); const float* m = MODl + (long)tok_cond(t) * MODW;
    Hb[i] = f2bf(X[i] * RSTD[t] * g[d] * (1.0f + m[sc_chunk * D + d]) + m[sh_chunk * D + d]);
  }
}

__device__ void nk_gemm_bf(const bf16_t* A, int lda, const bf16_t* Bt, int ldb, bf16_t* C, int ldc, int M, int N, int K) {
  GRID_STRIDE(i, (long)M * N) {
    const int t = (int)(i / N), n = (int)(i % N); const bf16_t* a = A + (long)t * lda; const bf16_t* b = Bt + (long)n * ldb;
    float acc = 0.f;
    for (int k = 0; k < K; ++k) acc += bf2f(a[k]) * bf2f(b[k]);
    C[(long)t * ldc + n] = f2bf(acc);
  }
}

__device__ void nk_gemm_res(const bf16_t* A, int lda, int a_pn_step, const bf16_t* Bt, int ldb, float* X, int M, int N, int K,
                            const float* MODl, int gate_chunk, const float* colscale) {
  GRID_STRIDE(i, (long)M * N) {
    const int t = (int)(i / N), n = (int)(i % N); const bf16_t* a = A + (long)t * lda + (n / 256) * a_pn_step; const bf16_t* b = Bt + (long)n * ldb;
    float acc = 0.f;
    for (int k = 0; k < K; ++k) acc += bf2f(a[k]) * bf2f(b[k]);
    if (colscale) acc *= colscale[n];
    X[(long)t * D + n] += MODl[(long)tok_cond(t) * MODW + gate_chunk * D + n] * acc;
  }
}

__device__ void nk_pool(const bf16_t* Hb, bf16_t* PDb) {
  GRID_STRIDE(i, (long)T * D) {
    const int t = (int)(i / D), d = (int)(i % D), g = d / 256, w = 2 << g; int s0, L; tok_seq(t, s0, L);
    const int pos = t - s0; int lo = pos - w / 2, hi = pos - w / 2 + w; lo = lo < 0 ? 0 : lo; hi = hi > L ? L : hi;
    float s = 0.f;
    for (int j = lo; j < hi; ++j) s += bf2f(Hb[(long)(s0 + j) * D + d]);
    PDb[i] = f2bf(s / (float)(hi - lo) - bf2f(Hb[i]));
  }
}

__device__ void nk_qknorm_rope(bf16_t* QKV, int ld, int nq, int nk, int kcol0, const float* qn, const float* kn, float* kout) {
  GRID_STRIDE(i, (long)T * (nq + nk)) {
    const int t = (int)(i / (nq + nk)), s = (int)(i % (nq + nk));
    bf16_t* v = QKV + (long)t * ld + (s < nq ? s * 64 : kcol0 + (s - nq) * 64); const float* w = s < nq ? qn : kn;
    float ss = 0.f;
    for (int d = 0; d < 64; ++d) ss += bf2f(v[d]) * bf2f(v[d]);
    const float r = 1.0f / sqrtf(ss / 64.0f + EPS);
    if (t < TCTX) {
      for (int d = 0; d < 64; ++d) { const float y = bf2f(v[d]) * r * w[d]; v[d] = f2bf(y); if (s >= nq) kout[(long)t * (nk * 64) + (s - nq) * 64 + d] = y; }
    } else {
      const int pos = (t - TCTX) % DEC_SEQ; const float prow = (float)(pos / 64), pcol = (float)(pos % 64);
      for (int a = 0; a < 2; ++a)
        for (int f = 0; f < 16; ++f) {
          const float inv = powf(10000.0f, -(float)(2 * f) / 32.0f), ang = (a == 0 ? prow : pcol) * inv, cs = cosf(ang), sn = sinf(ang);
          const int i1 = a * 32 + f, i2 = a * 32 + 16 + f; const float x1 = bf2f(v[i1]) * r * w[i1], x2 = bf2f(v[i2]) * r * w[i2];
          v[i1] = f2bf(x1 * cs - x2 * sn); v[i2] = f2bf(x2 * cs + x1 * sn);
        }
    }
  }
}

__device__ void nk_copy_cols_f(const bf16_t* S, int ld, int col0, int width, int rows, float* out) {
  GRID_STRIDE(i, (long)rows * width) { const int t = (int)(i / width), j = (int)(i % width); out[i] = bf2f(S[(long)t * ld + col0 + j]); }
}

__device__ __forceinline__ float dot64_bb(const bf16_t* a, const bf16_t* b) {
  float s = 0.f;
  for (int d = 0; d < 64; ++d) s += bf2f(a[d]) * bf2f(b[d]);
  return s;
}
__device__ __forceinline__ float dot64_bf(const bf16_t* a, const float* b) {
  float s = 0.f;
  for (int d = 0; d < 64; ++d) s += bf2f(a[d]) * bf2f(f2bf(b[d]));
  return s;
}

template <int MODE>
__device__ void nk_attn(const bf16_t* QKV, int ld, int kcol0, int vcol0, const float* ck, const float* cv, int cld,
                        const float* sink, const float* lq1, const float* lk1, const float* lq2, const float* lk2, float lam_init, bf16_t* O) {
  GRID_STRIDE(i, (long)T * 64) {
    const int t = (int)(i / 64), r = (int)(i % 64); const bool lat = t >= TCTX; int s0, L; tok_seq(t, s0, L);
    const int b = lat ? (t - TCTX) / DEC_SEQ : 0, ncache = lat ? PAST : 0;
    int jlo = 0, jhi = L - 1;
    if (MODE == 1 && lat) { const int pos = t - s0; jlo = pos - 128 < 0 ? 0 : pos - 128; jhi = pos + 128 > L - 1 ? L - 1 : pos + 128; }
    if (MODE != 2) {
      const int h = r / 4, ch = r % 4, koff = (h / 4) * 64, voff = (h / 4) * 64 + ch * 16; const bf16_t* q = QKV + (long)t * ld + h * 64;
      float m = -3.0e38f;
      for (int p = 0; p < ncache; ++p) m = fmaxf(m, dot64_bf(q, ck + (long)(b * PAST + p) * cld + koff) * 0.125f);
      for (int j = jlo; j <= jhi; ++j) m = fmaxf(m, dot64_bb(q, QKV + (long)(s0 + j) * ld + kcol0 + koff) * 0.125f);
      if (MODE == 1) m = fmaxf(m, sink[h]);
      float sum = 0.f, o[16];
#pragma unroll
      for (int e = 0; e < 16; ++e) o[e] = 0.f;
      for (int p = 0; p < ncache; ++p) {
        const float pr = expf(dot64_bf(q, ck + (long)(b * PAST + p) * cld + koff) * 0.125f - m); sum += pr; const float* v = cv + (long)(b * PAST + p) * cld + voff;
#pragma unroll
        for (int e = 0; e < 16; ++e) o[e] += pr * v[e];
      }
      for (int j = jlo; j <= jhi; ++j) {
        const float pr = expf(dot64_bb(q, QKV + (long)(s0 + j) * ld + kcol0 + koff) * 0.125f - m); sum += pr; const bf16_t* v = QKV + (long)(s0 + j) * ld + vcol0 + voff;
#pragma unroll
        for (int e = 0; e < 16; ++e) o[e] += pr * bf2f(v[e]);
      }
      if (MODE == 1) sum += expf(sink[h] - m);
#pragma unroll
      for (int e = 0; e < 16; ++e) O[(long)t * D + h * 64 + ch * 16 + e] = f2bf(o[e] / sum);
    } else {
      float d1 = 0.f, d2 = 0.f;
      for (int d = 0; d < 64; ++d) { d1 += lq1[d] * lk1[d]; d2 += lq2[d] * lk2[d]; }
      const float lam = expf(d1) - expf(d2) + lam_init;
      const int hd = r / 8, ch = r % 8, voff = hd * 128 + ch * 16; float res[16];
#pragma unroll
      for (int e = 0; e < 16; ++e) res[e] = 0.f;
      for (int c = 0; c < 2; ++c) {
        const int koff = hd * 128 + c * 64; const bf16_t* q = QKV + (long)t * ld + koff;
        float m = -3.0e38f;
        for (int p = 0; p < ncache; ++p) m = fmaxf(m, dot64_bf(q, ck + (long)(b * PAST + p) * cld + koff) * 0.125f);
        for (int j = jlo; j <= jhi; ++j) m = fmaxf(m, dot64_bb(q, QKV + (long)(s0 + j) * ld + kcol0 + koff) * 0.125f);
        float sum = 0.f, o[16];
#pragma unroll
        for (int e = 0; e < 16; ++e) o[e] = 0.f;
        for (int p = 0; p < ncache; ++p) {
          const float pr = expf(dot64_bf(q, ck + (long)(b * PAST + p) * cld + koff) * 0.125f - m); sum += pr; const float* v = cv + (long)(b * PAST + p) * cld + voff;
#pragma unroll
          for (int e = 0; e < 16; ++e) o[e] += pr * v[e];
        }
        for (int j = jlo; j <= jhi; ++j) {
          const float pr = expf(dot64_bb(q, QKV + (long)(s0 + j) * ld + kcol0 + koff) * 0.125f - m); sum += pr; const bf16_t* v = QKV + (long)(s0 + j) * ld + vcol0 + voff;
#pragma unroll
          for (int e = 0; e < 16; ++e) o[e] += pr * bf2f(v[e]);
        }
        const float f = (c == 0 ? 1.0f : -lam) / sum;
#pragma unroll
        for (int e = 0; e < 16; ++e) res[e] += f * o[e];
      }
#pragma unroll
      for (int e = 0; e < 16; ++e) O[(long)t * D + voff + e] = f2bf(res[e]);
    }
  }
}

__device__ void nk_subnorm(bf16_t* O, const float* sub_g, float factor) {
  GRID_STRIDE(i, (long)T * 8) {
    bf16_t* o = O + i * 128; float ss = 0.f;
    for (int e = 0; e < 128; ++e) ss += bf2f(o[e]) * bf2f(o[e]);
    const float r = factor / sqrtf(ss / 128.0f + EPS);
    for (int e = 0; e < 128; ++e) o[e] = f2bf(bf2f(o[e]) * r * sub_g[e]);
  }
}

__device__ void nk_convgate(const bf16_t* U, const float* cw, const float* cb, bf16_t* G) {
  GRID_STRIDE(i, (long)T * DFF) {
    const int t = (int)(i / DFF), f = (int)(i % DFF); int s0, L; tok_seq(t, s0, L); const int pos = t - s0; float uc[2];
#pragma unroll
    for (int hf = 0; hf < 2; ++hf) {
      const int col = hf * DFF + f; const bf16_t* u = U + (long)t * DFF2 + col;
      float a = bf2f(u[0]) * cw[DFF2 + col] + cb[col];
      if (pos > 0) a += bf2f(u[-DFF2]) * cw[col];
      if (pos < L - 1) a += bf2f(u[DFF2]) * cw[2 * DFF2 + col];
      uc[hf] = a;
    }
    G[i] = f2bf(silu_f(uc[0]) * uc[1]);
  }
}

#ifndef HOST_EMU
#ifndef USE_ENGINE
#define USE_ENGINE 1
#endif
namespace pg8 {
#define PG8_LAS __attribute__((address_space(3)))
typedef unsigned short bf16_t;
typedef short bf16x8 __attribute__((ext_vector_type(8)));
typedef float f32x4 __attribute__((ext_vector_type(4)));
typedef unsigned u32x4 __attribute__((ext_vector_type(4)));
typedef unsigned u32x2v __attribute__((ext_vector_type(2)));
constexpr int BM = 256, BK = 64, HALF = 128, HTB = HALF * BK * 2  , STAGE_BYTES = 8 * HTB, NXCD = 8, WGM = 8;

__host__ __device__ __forceinline__ int lds_byte(int r, int c) { const int st = (r >> 4) * 2 + (c >> 5), rr = r & 15, cc = c & 31, ob = rr * 64 + cc * 2; return st * 1024 + (ob ^ (((ob >> 9) & 1) << 5)); }
__host__ __device__ __forceinline__ void stage_rc(int b, int& R, int& C) { const int st = b / 1024, sb = b % 1024, swz = sb ^ (((sb >> 9) & 1) << 5); R = (st >> 1) * 16 + swz / 64; C = (st & 1) * 32 + (swz % 64) / 2; }
__host__ __device__ __forceinline__ int perm32(int rho) { const int n = rho >> 4, i = rho & 15; return 8 * (i >> 2) + 4 * n + (i & 3); }

struct Unit { int pm, pn, kh; };
struct Gemm { const bf16_t* A; const bf16_t* Bt; int M, N, K, lda, ldb, a_pn_step, ksplit; };

struct StaticOrder {
    int nM, nN, nwg, G, c, ks;
    __host__ __device__ __forceinline__ void init(int M, int N, int G_, int c_, int ks_ = 1) { nM = M / BM; nN = (N / BM) * ks_; nwg = nM * nN; G = G_; c = c_; ks = ks_; }
    __host__ __device__ __forceinline__ bool next(int i, Unit& u) const {
        const long L = (long)i * G + c; if (L >= nwg) return false;
        int wgid = (int)L; { const int q = nwg / NXCD, r = nwg % NXCD, xcd = wgid % NXCD, off = wgid / NXCD; wgid = (xcd < r ? xcd * (q + 1) : r * (q + 1) + (xcd - r) * q) + off; }
        const int nig = WGM * nN, gid = wgid / nig, fm = gid * WGM, gsz = (nM - fm) < WGM ? (nM - fm) : WGM;
        u.pm = fm + ((wgid % nig) % gsz); const int pv = (wgid % nig) / gsz; u.kh = pv % ks; u.pn = pv / ks; return true;
    }
    __device__ __forceinline__ void a_ready(const Unit&) const {}
    __device__ __forceinline__ void done(const Unit&) const {}
};

struct LimitedOrder : StaticOrder {
    int maxr;
    __host__ __device__ __forceinline__ bool next(int i, Unit& u) const { return i < maxr && StaticOrder::next(i, u); }
};

__device__ __forceinline__ unsigned cvt_pk_bf16(float lo, float hi) { unsigned r; asm volatile("v_cvt_pk_bf16_f32 %0, %1, %2" : "=v"(r) : "v"(lo), "v"(hi)); return r; }
typedef float f32x2 __attribute__((ext_vector_type(2)));
__device__ __forceinline__ f32x2 gelu_pk(f32x2 v) {
    const f32x2 av = __builtin_elementwise_abs(v), d = av * 0.2316418882f + 1.0f;
    f32x2 t; t.x = __builtin_amdgcn_rcpf(d.x); t.y = __builtin_amdgcn_rcpf(d.y);
    f32x2 q = t * 0.5307027145f + (-0.7265760135f); q = q * t + 0.7107068705f; q = q * t + (-0.142248368f); q = q * t + 0.127414796f; q = q * t;
    const f32x2 s = (v * v) * (-0.72134752044f);
    f32x2 e; e.x = __builtin_amdgcn_exp2f(s.x); e.y = __builtin_amdgcn_exp2f(s.y);
    const f32x2 m = v * (q * e), r = v - m;
    f32x2 o; o.x = v.x < 0.f ? m.x : r.x; o.y = v.y < 0.f ? m.y : r.y; return o;
}

template <int ACT  > struct EpiBf16 {
    static constexpr bool PERM = true, AFTER_DRAIN = false; static_assert(ACT == 0 || ACT == 1, "EpiBf16: ACT is 0 (none) or 1 (gelu_pk)");
    bf16_t* O; int ldc; const float* bias; int split_cols; size_t split_stride; float scale0;
    __device__ __forceinline__ void operator()(const f32x4 (&acc)[2][2][4][2], const Unit& u, int wr, int wc, int fr, int fq) const {
        const int row0 = u.pm * BM + wr * 64 + fr; int colt = u.pn * BM; bf16_t* base = O;
        float sc = 1.f; if (split_cols) { const int t = colt / split_cols; base += (size_t)t * split_stride; colt -= t * split_cols; if (t == 0) sc = scale0; }
        const int col0 = colt + wc * 32 + 8 * fq, bcol0 = u.pn * BM + wc * 32 + 8 * fq;
        f32x4 bv[2][2];
#pragma unroll
        for (int bj = 0; bj < 2; ++bj)
#pragma unroll
            for (int n = 0; n < 2; ++n) bv[bj][n] = bias ? *(const f32x4*)(bias + bcol0 + bj * HALF + 4 * n) : (f32x4){0.f, 0.f, 0.f, 0.f};
#pragma unroll
        for (int ai = 0; ai < 2; ++ai)
#pragma unroll
            for (int m = 0; m < 4; ++m) { bf16_t* rowp = base + (size_t)(row0 + ai * HALF + m * 16) * ldc + col0;
#pragma unroll
                for (int bj = 0; bj < 2; ++bj) { f32x4 v0 = acc[ai][bj][m][0] + bv[bj][0], v1 = acc[ai][bj][m][1] + bv[bj][1];
                    if (ACT == 1) { f32x2 a = gelu_pk((f32x2){v0[0], v0[1]}), b = gelu_pk((f32x2){v0[2], v0[3]}), c = gelu_pk((f32x2){v1[0], v1[1]}), d = gelu_pk((f32x2){v1[2], v1[3]});
                        v0 = (f32x4){a.x, a.y, b.x, b.y}; v1 = (f32x4){c.x, c.y, d.x, d.y}; }
                    v0 = v0 * sc; v1 = v1 * sc; u32x4 w; w.x = cvt_pk_bf16(v0[0], v0[1]); w.y = cvt_pk_bf16(v0[2], v0[3]); w.z = cvt_pk_bf16(v1[0], v1[1]); w.w = cvt_pk_bf16(v1[2], v1[3]);
                    *(u32x4*)(rowp + bj * HALF) = w; } }
    }
};

struct EpiRes {
    static constexpr bool PERM = false, AFTER_DRAIN = false;
    float* X; const float* Xin_c; const float* Xin_l; const float* MODl; int gate_chunk; const float* colscale; const bf16_t* pend; bf16_t* slab;
    __device__ __forceinline__ void operator()(const f32x4 (&acc)[2][2][4][2], const Unit& u, int wr, int wc, int fr, int fq) const {
        const int row0 = u.pm * BM + wr * 64 + fr, col0 = u.pn * BM + wc * 32 + 4 * fq;
        const int trow = u.pm * BM; const int cond = trow < TCTX ? 0 : 1 + (trow - TCTX) / DEC_SEQ;
        const float* gate = MODl + (size_t)cond * MODW + gate_chunk * D;
        f32x4 gv[2][2];
#pragma unroll
        for (int bj = 0; bj < 2; ++bj)
#pragma unroll
            for (int n = 0; n < 2; ++n) { gv[bj][n] = *(const f32x4*)(gate + col0 + bj * HALF + n * 16); if (colscale) gv[bj][n] = gv[bj][n] * *(const f32x4*)(colscale + col0 + bj * HALF + n * 16); }
        if (u.kh == 0) {
          const float* xin = trow < TCTX ? Xin_c : Xin_l;
          f32x4 xb[2][2][2]; u32x2v pb[2][2][2];
#define EPIRES_LOAD(gi_, buf_) do { const size_t off_ = (size_t)(row0 + ((gi_) >> 2) * HALF + ((gi_) & 3) * 16) * D + col0; \
            _Pragma("unroll") for (int bj = 0; bj < 2; ++bj) _Pragma("unroll") for (int n = 0; n < 2; ++n) { xb[buf_][bj][n] = *(const f32x4*)(xin + off_ + bj * HALF + n * 16); \
              if (pend) pb[buf_][bj][n] = *(const u32x2v*)(pend + off_ + bj * HALF + n * 16); } } while (0)
          EPIRES_LOAD(0, 0);
#pragma unroll
          for (int gi = 0; gi < 8; ++gi) {
            if (gi + 1 < 8) { if ((gi & 1) == 0) EPIRES_LOAD(gi + 1, 1); else EPIRES_LOAD(gi + 1, 0); }
            asm volatile("" ::: "memory");
            const int ai = gi >> 2, m = gi & 3; const size_t off = (size_t)(row0 + ai * HALF + m * 16) * D + col0;
#pragma unroll
            for (int bj = 0; bj < 2; ++bj)
#pragma unroll
              for (int n = 0; n < 2; ++n) { f32x4 v = xb[gi & 1][bj][n] + gv[bj][n] * acc[ai][bj][m][n];
                if (pend) { const u32x2v q = pb[gi & 1][bj][n]; v = v + (f32x4){__uint_as_float(q.x << 16), __uint_as_float(q.x & 0xffff0000u), __uint_as_float(q.y << 16), __uint_as_float(q.y & 0xffff0000u)}; }
                *(f32x4*)(X + off + bj * HALF + n * 16) = v; }
          }
#undef EPIRES_LOAD
        } else {
#pragma unroll
          for (int ai = 0; ai < 2; ++ai)
#pragma unroll
            for (int m = 0; m < 4; ++m) { const size_t off = (size_t)(row0 + ai * HALF + m * 16) * D + col0;
#pragma unroll
                for (int bj = 0; bj < 2; ++bj)
#pragma unroll
                    for (int n = 0; n < 2; ++n) { const f32x4 v = gv[bj][n] * acc[ai][bj][m][n]; u32x2v q; q.x = cvt_pk_bf16(v[0], v[1]); q.y = cvt_pk_bf16(v[2], v[3]); *(u32x2v*)(slab + off + bj * HALF + n * 16) = q; } }
        }
    }
};

struct EpiConv {
    static constexpr bool PERM = true, AFTER_DRAIN = false;
    bf16_t* G; const float* cw; const float* cb; float* edgebuf; PG8_LAS unsigned* E;
    __device__ __forceinline__ static unsigned perm(unsigned v, int src4) { return (unsigned)__builtin_amdgcn_ds_bpermute(src4, (int)v); }
    __device__ __forceinline__ static float lo(unsigned u) { return __uint_as_float(u << 16); }
    __device__ __forceinline__ static float hi(unsigned u) { return __uint_as_float(u & 0xffff0000u); }
    __device__ __forceinline__ void operator()(const f32x4 (&acc)[2][2][4][2], const Unit& u, int wr, int wc, int fr_in, int fq_in) const {
        int fr = fr_in, fq = fq_in; asm volatile("" : "+v"(fr), "+v"(fq));
        const int lane = fq * 16 + fr, srcP4 = ((lane & 48) | ((fr + 15) & 15)) << 2, srcN4 = ((lane & 48) | ((fr + 1) & 15)) << 2;
        const int lc = wc * 32 + 8 * fq;
        unsigned pk[2][2][4][4];
#pragma unroll
        for (int ai = 0; ai < 2; ++ai)
#pragma unroll
          for (int bj = 0; bj < 2; ++bj)
#pragma unroll
            for (int m = 0; m < 4; ++m)
#pragma unroll
              for (int n = 0; n < 2; ++n) { const f32x4 v = acc[ai][bj][m][n]; pk[ai][bj][m][2 * n] = cvt_pk_bf16(v[0], v[1]); pk[ai][bj][m][2 * n + 1] = cvt_pk_bf16(v[2], v[3]); }
        if (fr == 0 || fr == 15) { const int which = fr == 0 ? 0 : 1;
#pragma unroll
          for (int ai = 0; ai < 2; ++ai)
#pragma unroll
            for (int bj = 0; bj < 2; ++bj) { u32x4 w;
              if (fr == 0) { w.x = pk[ai][bj][0][0]; w.y = pk[ai][bj][0][1]; w.z = pk[ai][bj][0][2]; w.w = pk[ai][bj][0][3]; } else { w.x = pk[ai][bj][3][0]; w.y = pk[ai][bj][3][1]; w.z = pk[ai][bj][3][2]; w.w = pk[ai][bj][3][3]; }
              *(PG8_LAS u32x4*)(E + (((ai * 2 + wr) * 2 + which) * 2 + bj) * 64 + (lc >> 1)) = w; } }
        if (u.pm * BM >= TCTX) { const bool top = (wr == 0 && fr < 2), bot = (wr == 1 && fr >= 14);
          if (top || bot) { const int r4 = top ? fr : fr - 12; float* eb = edgebuf + ((size_t)((u.pm - TCTX / BM) * (DFF / 128) + u.pn) * 4 + r4) * 256 + lc;
#pragma unroll
            for (int bj = 0; bj < 2; ++bj) { unsigned q0, q1, q2, q3;
              if (top) { q0 = pk[0][bj][0][0]; q1 = pk[0][bj][0][1]; q2 = pk[0][bj][0][2]; q3 = pk[0][bj][0][3]; } else { q0 = pk[1][bj][3][0]; q1 = pk[1][bj][3][1]; q2 = pk[1][bj][3][2]; q3 = pk[1][bj][3][3]; }
              *(f32x4*)(eb + bj * 128) = (f32x4){lo(q0), hi(q0), lo(q1), hi(q1)}; *(f32x4*)(eb + bj * 128 + 4) = (f32x4){lo(q2), hi(q2), lo(q3), hi(q3)}; } } }
        asm volatile("s_waitcnt lgkmcnt(0)" ::: "memory"); __builtin_amdgcn_s_barrier(); asm volatile("" ::: "memory");
        const int gcol = u.pn * 128 + lc;
        float w0a[2][8], w1a[2][8], w2a[2][8], bba[2][8];
#pragma unroll
        for (int bj = 0; bj < 2; ++bj) { const int col = bj * DFF + gcol;
#pragma unroll
          for (int e = 0; e < 8; e += 4) { const f32x4 a0 = *(const f32x4*)(cw + col + e), a1 = *(const f32x4*)(cw + DFF2 + col + e), a2 = *(const f32x4*)(cw + 2 * DFF2 + col + e), a3 = *(const f32x4*)(cb + col + e);
#pragma unroll
            for (int q = 0; q < 4; ++q) { w0a[bj][e + q] = a0[q]; w1a[bj][e + q] = a1[q]; w2a[bj][e + q] = a2[q]; bba[bj][e + q] = a3[q]; } } }
#pragma unroll
        for (int ai = 0; ai < 2; ++ai) {
          float ca[4][8];
#pragma unroll
          for (int bj = 0; bj < 2; ++bj) {
            const float (&w0)[8] = w0a[bj]; const float (&w1)[8] = w1a[bj]; const float (&w2)[8] = w2a[bj]; const float (&bb)[8] = bba[bj];
            u32x4 eP = (u32x4){0u, 0u, 0u, 0u}, eN = (u32x4){0u, 0u, 0u, 0u};
            if (wr == 1) eP = *(const PG8_LAS u32x4*)(E + (((ai * 2 + 0) * 2 + 1) * 2 + bj) * 64 + (lc >> 1));
            else if (ai == 1) eP = *(const PG8_LAS u32x4*)(E + (((0 * 2 + 1) * 2 + 1) * 2 + bj) * 64 + (lc >> 1));
            if (wr == 0) eN = *(const PG8_LAS u32x4*)(E + (((ai * 2 + 1) * 2 + 0) * 2 + bj) * 64 + (lc >> 1));
            else if (ai == 0) eN = *(const PG8_LAS u32x4*)(E + (((1 * 2 + 0) * 2 + 0) * 2 + bj) * 64 + (lc >> 1));
            unsigned spm1[4] = {eP.x, eP.y, eP.z, eP.w}, sn0[4];
#pragma unroll
            for (int h = 0; h < 4; ++h) sn0[h] = perm(pk[ai][bj][0][h], srcN4);
#pragma unroll
            for (int m = 0; m < 4; ++m) {
              unsigned sp[4], sn1[4] = {eN.x, eN.y, eN.z, eN.w};
#pragma unroll
              for (int h = 0; h < 4; ++h) { sp[h] = perm(pk[ai][bj][m][h], srcP4); if (m < 3) sn1[h] = perm(pk[ai][bj][m < 3 ? m + 1 : 3][h], srcN4); }
#pragma unroll
              for (int h = 0; h < 4; ++h) {
                const unsigned pv = fr == 0 ? spm1[h] : sp[h], nx = fr == 15 ? sn1[h] : sn0[h], cu = pk[ai][bj][m][h];
                const float c0 = lo(cu) * w1[2 * h] + bb[2 * h] + lo(pv) * w0[2 * h] + lo(nx) * w2[2 * h];
                const float c1 = hi(cu) * w1[2 * h + 1] + bb[2 * h + 1] + hi(pv) * w0[2 * h + 1] + hi(nx) * w2[2 * h + 1];
                if (bj == 0) { ca[m][2 * h] = c0; ca[m][2 * h + 1] = c1; }
                else { ca[m][2 * h] = ca[m][2 * h] / (1.0f + __expf(-ca[m][2 * h])) * c0; ca[m][2 * h + 1] = ca[m][2 * h + 1] / (1.0f + __expf(-ca[m][2 * h + 1])) * c1; }
                spm1[h] = sp[h]; sn0[h] = sn1[h];
              }
              if (bj == 1) { u32x4 w; w.x = cvt_pk_bf16(ca[m][0], ca[m][1]); w.y = cvt_pk_bf16(ca[m][2], ca[m][3]); w.z = cvt_pk_bf16(ca[m][4], ca[m][5]); w.w = cvt_pk_bf16(ca[m][6], ca[m][7]);
                *(u32x4*)(G + (size_t)(u.pm * BM + ai * HALF + wr * 64 + m * 16 + fr) * DFF + gcol) = w; }
            }
            asm volatile("" ::: "memory");
          }
        }
    }
};

struct EpiQK {
    static constexpr bool PERM = true, AFTER_DRAIN = false;
    bf16_t* O; int ldc, kcol0, vcol0; const float* qn; const float* kn; const float* rope; float* kout; float* vout; int kow; PG8_LAS float* SS;
    __device__ __forceinline__ static float perm(float v, int src4) { return __int_as_float(__builtin_amdgcn_ds_bpermute(src4, __float_as_int(v))); }
    __device__ __forceinline__ void operator()(const f32x4 (&acc)[2][2][4][2], const Unit& u, int wr, int wc, int fr_in, int fq_in) const {
        int fr = fr_in, fq = fq_in; asm volatile("" : "+v"(fr), "+v"(fq));
        const int lane = fq * 16 + fr, x16 = (lane ^ 16) << 2, x32 = (lane ^ 32) << 2;
        const int colt = u.pn * BM, kind = colt < kcol0 ? 0 : (colt < vcol0 ? 1 : 2);
        const bool lat = u.pm * BM >= TCTX;
        float ss[2][2][4];
        if (kind != 2) {
#pragma unroll
          for (int ai = 0; ai < 2; ++ai)
#pragma unroll
            for (int bj = 0; bj < 2; ++bj)
#pragma unroll
              for (int m = 0; m < 4; ++m) { const f32x4 a0 = acc[ai][bj][m][0], a1 = acc[ai][bj][m][1];
                float t = (a0[0] * a0[0] + a0[1] * a0[1]) + (a0[2] * a0[2] + a0[3] * a0[3]) + (a1[0] * a1[0] + a1[1] * a1[1]) + (a1[2] * a1[2] + a1[3] * a1[3]);
                t += perm(t, x16); t += perm(t, x32); ss[ai][bj][m] = t;
                if (fq == 0) SS[(((wr * 4 + wc) * 2 + ai) * 2 + bj) * 64 + m * 16 + fr] = t; }
        }
        asm volatile("s_waitcnt lgkmcnt(0)" ::: "memory"); __builtin_amdgcn_s_barrier(); asm volatile("" ::: "memory");
        const int dh = 32 * (wc & 1) + 8 * fq;
        f32x4 w0 = (f32x4){1.f, 1.f, 1.f, 1.f}, w1 = w0;
        if (kind != 2) { const float* wp = (kind == 0 ? qn : kn) + dh; w0 = *(const f32x4*)wp; w1 = *(const f32x4*)(wp + 4); }
        const bool x2side = (fq & 2) != 0;
        float rinv[8];
#pragma unroll
        for (int e = 0; e < 8; ++e) rinv[e] = __builtin_amdgcn_exp2f(-(float)(8 * (fq & 1) + e) * (13.287712379549449f / 16.0f)) * 0.15915494309189535f;
#pragma unroll
        for (int ai = 0; ai < 2; ++ai)
#pragma unroll
          for (int m = 0; m < 4; ++m) {
            const int row = u.pm * BM + ai * HALF + wr * 64 + m * 16 + fr;
#pragma unroll
            for (int bj = 0; bj < 2; ++bj) {
              float y[8]; { const f32x4 a0 = acc[ai][bj][m][0], a1 = acc[ai][bj][m][1]; y[0] = a0[0]; y[1] = a0[1]; y[2] = a0[2]; y[3] = a0[3]; y[4] = a1[0]; y[5] = a1[1]; y[6] = a1[2]; y[7] = a1[3]; }
              if (kind != 2) {
                const float tot = ss[ai][bj][m] + SS[(((wr * 4 + (wc ^ 1)) * 2 + ai) * 2 + bj) * 64 + m * 16 + fr];
                const float r = 1.0f / sqrtf(tot / 64.0f + EPS);
                y[0] *= r * w0[0]; y[1] *= r * w0[1]; y[2] *= r * w0[2]; y[3] *= r * w0[3]; y[4] *= r * w1[0]; y[5] *= r * w1[1]; y[6] *= r * w1[2]; y[7] *= r * w1[3];
                if (lat) { const int pos = (row - TCTX) % DEC_SEQ; const float posa = (float)((wc & 1) ? (pos & 63) : (pos >> 6));
#pragma unroll
                  for (int e = 0; e < 8; ++e) { const float rev = posa * rinv[e], cs = __builtin_amdgcn_cosf(rev), sn = __builtin_amdgcn_sinf(rev), pp = perm(y[e], x32);
                    y[e] = x2side ? y[e] * cs + pp * sn : y[e] * cs - pp * sn; } }
              }
              const int cl = bj * HALF + wc * 32 + 8 * fq;
              u32x4 w; w.x = cvt_pk_bf16(y[0], y[1]); w.y = cvt_pk_bf16(y[2], y[3]); w.z = cvt_pk_bf16(y[4], y[5]); w.w = cvt_pk_bf16(y[6], y[7]);
              *(u32x4*)(O + (size_t)row * ldc + colt + cl) = w;
              if (!lat && kind != 0) { float* op = (kind == 1 ? kout + (size_t)row * kow + (colt - kcol0) : vout + (size_t)row * kow + (colt - vcol0)) + cl;
                *(f32x4*)op = (f32x4){y[0], y[1], y[2], y[3]}; *(f32x4*)(op + 4) = (f32x4){y[4], y[5], y[6], y[7]}; }
            }
          }
    }
};

template <class Epi, class Sched, bool ALIGN_EPI = false, bool SP2 = false>
__device__ __forceinline__ void gemm_phase(PG8_LAS unsigned char* lds, const Gemm g, const Sched& S, const Epi& E) {
    int tid_ = threadIdx.x; asm volatile("" : "+v"(tid_));
    const int tid = tid_, wid = __builtin_amdgcn_readfirstlane(tid >> 6), lane = tid & 63, wr = wid >> 2, wc = wid & 3, fr = lane & 15, fq = lane >> 4;
    const int K = g.K / g.ksplit, nt = K / BK;
    unsigned voffA[2], voffB[2];
#pragma unroll
    for (int i = 0; i < 2; ++i) { int R, C; stage_rc(tid * 16 + i * 8192, R, C); const int Rb = Epi::PERM ? ((R & ~31) + perm32(R & 31)) : R;
        voffA[i] = (unsigned)(R * g.lda + C) * 2u; voffB[i] = (unsigned)(Rb * g.ldb + C) * 2u; }
    const size_t kstep = (size_t)(BK * 2);
    const size_t hstepA = (size_t)HALF * g.lda * 2, hstepB = (size_t)HALF * g.ldb * 2;
    const size_t tstepA = 2 * hstepA, tstepB = 2 * hstepB, pnstepA = (size_t)g.a_pn_step * 2, khstep = (size_t)K * 2;
    const unsigned ldsw = (unsigned)wid * 1024u;
    const int aoff = lds_byte(wr * 64 + fr, fq * 8), boff = lds_byte(wc * 32 + fr, fq * 8);
#define PG8_SA(b, h) (((b) * 2 + (h)) * HTB)
#define PG8_SB(b, h) ((4 + (b) * 2 + (h)) * HTB)
#define PG8_STAGE(bufoff, gbase, voff) do { _Pragma("unroll") for (int _i = 0; _i < 2; ++_i) \
        __builtin_amdgcn_global_load_lds((const unsigned*)((const char*)(gbase) + (voff)[_i]), (PG8_LAS unsigned*)(lds + (bufoff) + ldsw + _i * 8192), 16, 0, 0); } while (0)
#define PG8_LDA(dst, b, h) do { _Pragma("unroll") for (int m = 0; m < 4; ++m) _Pragma("unroll") for (int k = 0; k < 2; ++k) dst[m][k] = *(const PG8_LAS bf16x8*)(lds + PG8_SA(b, h) + aoff + m * 2048 + k * 1024); } while (0)
#define PG8_LDB(dst, b, h) do { _Pragma("unroll") for (int n = 0; n < 2; ++n) _Pragma("unroll") for (int k = 0; k < 2; ++k) dst[n][k] = *(const PG8_LAS bf16x8*)(lds + PG8_SB(b, h) + boff + n * 2048 + k * 1024); } while (0)
#define PG8_MMA(ai, bj, At, Bt) do { __builtin_amdgcn_s_setprio(1); _Pragma("unroll") for (int m = 0; m < 4; ++m) _Pragma("unroll") for (int n = 0; n < 2; ++n) _Pragma("unroll") for (int k = 0; k < 2; ++k) \
        acc[ai][bj][m][n] = __builtin_amdgcn_mfma_f32_16x16x32_bf16(Bt[n][k], At[m][k], acc[ai][bj][m][n], 0, 0, 0); __builtin_amdgcn_s_setprio(0); } while (0)
#define PG8_WAIT_V(n) asm volatile("s_waitcnt vmcnt(" #n ")" ::: "memory")
#define PG8_WAIT_L(n) asm volatile("s_waitcnt lgkmcnt(" #n ")" ::: "memory")
#define PG8_BAR __builtin_amdgcn_s_barrier()
#define PG8_SCHED __builtin_amdgcn_sched_barrier(0)
    Unit cur, nxt; int ui = 0;
    if (!S.next(0, cur)) return;
    f32x4 acc[2][2][4][2];
#pragma unroll
    for (int a = 0; a < 2; ++a)
#pragma unroll
        for (int b = 0; b < 2; ++b)
#pragma unroll
            for (int m = 0; m < 4; ++m)
#pragma unroll
                for (int n = 0; n < 2; ++n) acc[a][b][m][n] = (f32x4){0.f, 0.f, 0.f, 0.f};
    bf16x8 At[4][2], B0[2][2], B1[2][2];
    const char* cA = (const char*)g.A + (size_t)cur.pm * tstepA + (size_t)cur.pn * pnstepA + (size_t)cur.kh * khstep; const char* cB = (const char*)g.Bt + (size_t)cur.pn * tstepB + (size_t)cur.kh * khstep;
    S.a_ready(cur);
    if constexpr (SP2) {
        PG8_STAGE(PG8_SB(0, 0), cB, voffB); PG8_STAGE(PG8_SB(0, 1), cB + hstepB, voffB); PG8_STAGE(PG8_SA(0, 0), cA, voffA); PG8_STAGE(PG8_SA(0, 1), cA + hstepA, voffA);
        if (wr == 1) PG8_BAR;
        PG8_WAIT_V(2); PG8_BAR;
        PG8_STAGE(PG8_SB(1, 0), cB + kstep, voffB); PG8_STAGE(PG8_SA(1, 0), cA + kstep, voffA); PG8_STAGE(PG8_SB(1, 1), cB + hstepB + kstep, voffB);
        PG8_WAIT_V(6); PG8_BAR;
    } else {
        PG8_STAGE(PG8_SB(0, 0), cB, voffB); PG8_STAGE(PG8_SA(0, 0), cA, voffA); PG8_STAGE(PG8_SB(0, 1), cB + hstepB, voffB); PG8_STAGE(PG8_SA(0, 1), cA + hstepA, voffA);
        if (wr == 1) PG8_BAR;
        PG8_WAIT_V(4); PG8_BAR;
        PG8_STAGE(PG8_SB(1, 0), cB + kstep, voffB); PG8_STAGE(PG8_SA(1, 0), cA + kstep, voffA); PG8_STAGE(PG8_SB(1, 1), cB + hstepB + kstep, voffB);
        PG8_WAIT_V(6); PG8_BAR;
    }
    for (;;) {
        const bool has_next = S.next(ui + 1, nxt);
        const char* nA = has_next ? (const char*)g.A + (size_t)nxt.pm * tstepA + (size_t)nxt.pn * pnstepA + (size_t)nxt.kh * khstep : cA; const char* nB = has_next ? (const char*)g.Bt + (size_t)nxt.pn * tstepB + (size_t)nxt.kh * khstep : cB;
        for (int t = 0; t < nt; t += 2) {
            const bool last = (t == nt - 2);
            const char* a1 = cA + (size_t)(t + 1) * kstep;
            const char* a2 = last ? nA : cA + (size_t)(t + 2) * kstep; const char* b2 = last ? nB : cB + (size_t)(t + 2) * kstep;
            const char* a3 = a2 + kstep; const char* b3 = b2 + kstep;
            if (last && has_next) S.a_ready(nxt);
            if constexpr (SP2) {
            PG8_LDB(B0, 0, 0); PG8_LDB(B1, 0, 1); PG8_SCHED; PG8_LDA(At, 0, 0); PG8_STAGE(PG8_SA(1, 1), a1 + hstepA, voffA);
            PG8_WAIT_V(8); PG8_WAIT_L(0); PG8_BAR; PG8_MMA(0, 0, At, B0); PG8_MMA(0, 1, At, B1); PG8_BAR; PG8_SCHED;
            PG8_LDA(At, 0, 1); PG8_STAGE(PG8_SB(0, 0), b2, voffB); PG8_STAGE(PG8_SB(0, 1), b2 + hstepB, voffB); PG8_STAGE(PG8_SA(0, 0), a2, voffA);
            PG8_WAIT_V(8); PG8_WAIT_L(0); PG8_BAR; PG8_MMA(1, 0, At, B0); PG8_MMA(1, 1, At, B1); PG8_BAR; PG8_SCHED;
            PG8_LDB(B0, 1, 0); PG8_LDB(B1, 1, 1); PG8_SCHED; PG8_LDA(At, 1, 0); PG8_STAGE(PG8_SA(0, 1), a2 + hstepA, voffA);
            PG8_WAIT_V(8); PG8_WAIT_L(0); PG8_BAR; PG8_MMA(0, 0, At, B0); PG8_MMA(0, 1, At, B1); PG8_BAR; PG8_SCHED;
            PG8_LDA(At, 1, 1); PG8_STAGE(PG8_SB(1, 0), b3, voffB); PG8_STAGE(PG8_SB(1, 1), b3 + hstepB, voffB); PG8_STAGE(PG8_SA(1, 0), a3, voffA);
            PG8_WAIT_V(8); PG8_WAIT_L(0); PG8_BAR; PG8_MMA(1, 0, At, B0); PG8_MMA(1, 1, At, B1); PG8_BAR; PG8_SCHED;
            } else {
            PG8_LDB(B0, 0, 0); PG8_SCHED; PG8_LDA(At, 0, 0); PG8_STAGE(PG8_SA(1, 1), a1 + hstepA, voffA);
            PG8_WAIT_L(8); PG8_BAR; PG8_WAIT_L(0); PG8_MMA(0, 0, At, B0); PG8_BAR; PG8_SCHED;
            PG8_LDB(B1, 0, 1); PG8_STAGE(PG8_SB(0, 0), b2, voffB);
            PG8_BAR; PG8_WAIT_L(0); PG8_MMA(0, 1, At, B1); PG8_BAR;
            PG8_LDA(At, 0, 1); PG8_STAGE(PG8_SA(0, 0), a2, voffA);
            PG8_BAR; PG8_WAIT_L(0); PG8_MMA(1, 0, At, B0); PG8_BAR; PG8_SCHED;
            PG8_STAGE(PG8_SB(0, 1), b2 + hstepB, voffB);
            PG8_WAIT_V(6); PG8_BAR; PG8_MMA(1, 1, At, B1); PG8_BAR;
            PG8_LDB(B0, 1, 0); PG8_SCHED; PG8_LDA(At, 1, 0); PG8_STAGE(PG8_SA(0, 1), a2 + hstepA, voffA);
            PG8_WAIT_L(8); PG8_BAR; PG8_WAIT_L(0); PG8_MMA(0, 0, At, B0); PG8_BAR; PG8_SCHED;
            PG8_LDB(B1, 1, 1); PG8_STAGE(PG8_SB(1, 0), b3, voffB);
            PG8_BAR; PG8_WAIT_L(0); PG8_MMA(0, 1, At, B1); PG8_BAR;
            PG8_LDA(At, 1, 1); PG8_STAGE(PG8_SA(1, 0), a3, voffA);
            PG8_BAR; PG8_WAIT_L(0); PG8_MMA(1, 0, At, B0); PG8_BAR; PG8_SCHED;
            PG8_STAGE(PG8_SB(1, 1), b3 + hstepB, voffB);
            PG8_WAIT_V(6); PG8_BAR; PG8_MMA(1, 1, At, B1); PG8_BAR;
            }
        }
        if constexpr (ALIGN_EPI) { if (wr == 0) PG8_BAR; }
        if constexpr (!Epi::AFTER_DRAIN) { E(acc, cur, wr, wc, fr, fq); S.done(cur); }
        if (!has_next) break;
#pragma unroll
        for (int a = 0; a < 2; ++a)
#pragma unroll
            for (int b = 0; b < 2; ++b)
#pragma unroll
                for (int m = 0; m < 4; ++m)
#pragma unroll
                    for (int n = 0; n < 2; ++n) acc[a][b][m][n] = (f32x4){0.f, 0.f, 0.f, 0.f};
        cur = nxt; cA = nA; cB = nB; ++ui;
        if constexpr (ALIGN_EPI) { if (wr == 1) PG8_BAR; }
    }
    PG8_WAIT_V(0);
    if constexpr (!ALIGN_EPI) { if (wr == 0) PG8_BAR; }
    PG8_BAR;
    if constexpr (Epi::AFTER_DRAIN) { E.fused(acc, cur, wr, wc, fr, fq, lds, wid, lane); S.done(cur); }
#undef PG8_SA
#undef PG8_SB
#undef PG8_STAGE
#undef PG8_LDA
#undef PG8_LDB
#undef PG8_MMA
#undef PG8_WAIT_V
#undef PG8_WAIT_L
#undef PG8_BAR
#undef PG8_SCHED
}
}
#endif

enum { I_XP, I_XS, I_CGK, I_CGV, I_CDK, I_CDV, I_CWK, I_CWV, I_C, I_CCTX, I_N1G, I_N2G, I_WMOD, I_BMOD, I_FWIN, I_FCW, I_FCB, I_FWOUT,
       I_POOLW, I_POOLS, I_GQKV, I_GQN, I_GKN, I_GWO, I_DQKV, I_DQN, I_DKN, I_DLQ1, I_DLK1, I_DLQ2, I_DLK2, I_DSUB, I_DWO,
       I_WQKV, I_WQN, I_WKN, I_WSINK, I_WWO, N_IN };
struct Params { const float* in[N_IN]; float* out; unsigned char* ws; };
#ifdef HOST_EMU
static inline const float* pin(const Params& P, int i) { return P.in[i]; }
#else
__device__ __forceinline__ const float* pin(const Params& P, int i) { asm volatile("" : "+s"(i)); return P.in[i]; }
#endif

constexpr size_t MiB = (size_t)1 << 20;
constexpr size_t WS_CTL = 1 * MiB + 576 * 1024, CTL_ZERO_BYTES = 16384;
constexpr size_t WS_EDGE = 1 * MiB + 640 * 1024;
constexpr size_t WS_MOD = 0, WS_RSTD = 1 * MiB, WS_ROPE = 1 * MiB + 256 * 1024;
constexpr size_t WS_WIN = 3 * MiB;
constexpr size_t WS_WOUT = WS_WIN + (size_t)4 * DFF2 * D * 2;
constexpr size_t WS_GQKV = WS_WOUT + (size_t)4 * D * DFF * 2;
constexpr size_t WS_GWO = WS_GQKV + (size_t)1536 * D * 2, WS_DQKV = WS_GWO + (size_t)D * D * 2, WS_DWO = WS_DQKV + (size_t)3072 * D * 2;
constexpr size_t WS_WQKV = WS_DWO + (size_t)D * D * 2, WS_WWO = WS_WQKV + (size_t)1536 * D * 2, WS_POOL = WS_WWO + (size_t)D * D * 2;
constexpr size_t WS_HB = WS_POOL + (size_t)1024 * 256 * 2;
constexpr size_t WS_UB = WS_HB + (size_t)T * D * 2;
constexpr size_t WS_QKV = WS_UB, WS_OB = WS_QKV + (size_t)T * 3072 * 2, WS_PD = WS_QKV;
constexpr size_t UB_BYTES = ((size_t)T * DFF2 * 2 > (size_t)T * 4096 * 2) ? (size_t)T * DFF2 * 2 : (size_t)T * 4096 * 2;
constexpr size_t WS_GB = WS_UB + UB_BYTES;
constexpr size_t WS_SA = WS_GB + (size_t)T * DFF * 2, WS_SB = WS_SA + (size_t)T * D * 4;
constexpr size_t WS_END = WS_SB + (size_t)T * D * 4;
static_assert(WS_END <= 256 * MiB, "d_ws map");

constexpr int STEPS_PER_LAYER = 13, N_PRE = 3, N_STEPS = N_PRE + 4 * STEPS_PER_LAYER;

struct Ctx {
  float* out_; unsigned char* ws_;
#ifdef HOST_EMU
  float* out_p() const { return out_; } unsigned char* ws_p() const { return ws_; }
#else
  __device__ __forceinline__ float* out_p() const { float* p = out_; asm volatile("" : "+s"(p)); return p; }
  __device__ __forceinline__ unsigned char* ws_p() const { unsigned char* p = ws_; asm volatile("" : "+s"(p)); return p; }
#endif
  __device__ __forceinline__ float* X() const { return out_p(); }
  __device__ __forceinline__ float* o_gk() const { return out_p() + (size_t)T * D; }
  __device__ __forceinline__ float* o_gv() const { return o_gk() + (size_t)TCTX * 256; }
  __device__ __forceinline__ float* o_dk() const { return o_gv() + (size_t)TCTX * 256; }
  __device__ __forceinline__ float* o_dv() const { return o_dk() + (size_t)TCTX * 1024; }
  __device__ __forceinline__ float* o_wk() const { return o_dv() + (size_t)TCTX * 1024; }
  __device__ __forceinline__ float* o_wv() const { return o_wk() + (size_t)TCTX * 256; }
  __device__ __forceinline__ float* MOD() const { return (float*)(ws_p() + WS_MOD); }
  __device__ __forceinline__ float* RSTD() const { return (float*)(ws_p() + WS_RSTD); }
  __device__ __forceinline__ float* ROPE() const { return (float*)(ws_p() + WS_ROPE); }
  __device__ __forceinline__ bf16_t* bf(size_t off) const { return (bf16_t*)(ws_p() + off); }
  __device__ __forceinline__ bf16_t* WinT() const { return bf(WS_WIN); }
  __device__ __forceinline__ bf16_t* WoutT() const { return bf(WS_WOUT); }
  __device__ __forceinline__ bf16_t* GqkvT() const { return bf(WS_GQKV); }
  __device__ __forceinline__ bf16_t* GwoT() const { return bf(WS_GWO); }
  __device__ __forceinline__ bf16_t* DqkvT() const { return bf(WS_DQKV); }
  __device__ __forceinline__ bf16_t* DwoT() const { return bf(WS_DWO); }
  __device__ __forceinline__ bf16_t* WqkvT() const { return bf(WS_WQKV); }
  __device__ __forceinline__ bf16_t* WwoT() const { return bf(WS_WWO); }
  __device__ __forceinline__ bf16_t* PoolT() const { return bf(WS_POOL); }
  __device__ __forceinline__ bf16_t* Hb() const { return bf(WS_HB); }
  __device__ __forceinline__ bf16_t* Ub() const { return bf(WS_UB); }
  __device__ __forceinline__ bf16_t* QKVb() const { return bf(WS_QKV); }
  __device__ __forceinline__ bf16_t* Ob() const { return bf(WS_OB); }
  __device__ __forceinline__ bf16_t* PDb() const { return bf(WS_PD); }
  __device__ __forceinline__ bf16_t* Gb() const { return bf(WS_GB); }
};
__device__ __forceinline__ Ctx make_ctx(const Params& P) { Ctx c; c.out_ = P.out; c.ws_ = P.ws; return c; }

#ifndef KSPLIT
#define KSPLIT 2
#endif
struct GemmDesc { const bf16_t* A; int lda, a_pn_step; const bf16_t* Bt; int ldb, N, K; bool res; bf16_t* C; int ldc; int gate_chunk; const float* colscale; int ksplit; };
__device__ __forceinline__ bool gemm_desc(int step, const Params& P, const Ctx& c, GemmDesc& g) {
  if (step < N_PRE) return false;
  const int l = (step - N_PRE) / STEPS_PER_LAYER, s = (step - N_PRE) % STEPS_PER_LAYER;
  g.a_pn_step = 0; g.colscale = nullptr; g.C = nullptr; g.ldc = 0; g.gate_chunk = 0; g.res = false; g.ksplit = 1;
  if (s == 2 && l != 0) { const int N = (l == 2) ? 3072 : 1536; g.A = c.Hb(); g.lda = D; g.Bt = c.bf(l == 1 ? WS_GQKV : (l == 2 ? WS_DQKV : WS_WQKV)); g.ldb = D; g.N = N; g.K = D; g.C = c.QKVb(); g.ldc = N; return true; }
  if (s == 7) {
    g.res = true; g.gate_chunk = 2;
    if (l == 0) { g.A = c.PDb(); g.lda = D; g.a_pn_step = 256; g.Bt = c.PoolT(); g.ldb = 256; g.N = D; g.K = 256; g.colscale = pin(P, I_POOLS); }
    else { g.A = c.Ob(); g.lda = D; g.Bt = c.bf(l == 1 ? WS_GWO : (l == 2 ? WS_DWO : WS_WWO)); g.ldb = D; g.N = D; g.K = D; g.ksplit = KSPLIT; }
    return true;
  }
  if (s == 10) { g.A = c.Hb(); g.lda = D; g.Bt = c.WinT() + (size_t)l * DFF2 * D; g.ldb = D; g.N = DFF2; g.K = D; g.C = c.Ub(); g.ldc = DFF2; return true; }
  if (s == 12) { g.res = true; g.gate_chunk = 5; g.A = c.Gb(); g.lda = DFF; g.Bt = c.WoutT() + (size_t)l * D * DFF; g.ldb = DFF; g.N = D; g.K = DFF; g.ksplit = (DFF % 256 == 0) ? KSPLIT : 1; return true; }
  return false;
}

__device__ __forceinline__ void naive_step(int step, const Params& P, const Ctx& c) {
#define IN(i) (pin(P, (i)))
  if (step == 0) { nk_copy_x(IN(I_XP), IN(I_XS), c.X()); return; }
  if (step == 1) { nk_mod(IN(I_C), IN(I_CCTX), IN(I_WMOD), IN(I_BMOD), c.MOD(), 4); nk_rope_table(c.ROPE()); return; }
  if (step == 2) {
    for (int l = 0; l < 4; ++l) { nk_wt(IN(I_FWIN) + (size_t)l * D * DFF2, D, DFF2, c.WinT() + (size_t)l * DFF2 * D); nk_wt(IN(I_FWOUT) + (size_t)l * DFF * D, DFF, D, c.WoutT() + (size_t)l * D * DFF); }
    nk_wt(IN(I_GQKV), D, 1536, c.GqkvT()); nk_wt(IN(I_GWO), D, D, c.GwoT()); nk_wt(IN(I_DQKV), D, 3072, c.DqkvT()); nk_wt(IN(I_DWO), D, D, c.DwoT());
    nk_wt(IN(I_WQKV), D, 1536, c.WqkvT()); nk_wt(IN(I_WWO), D, D, c.WwoT());
    for (int g = 0; g < 4; ++g) nk_wt(IN(I_POOLW) + g * 256 * 256, 256, 256, c.PoolT() + g * 256 * 256);
    return;
  }
  const int l = (step - N_PRE) / STEPS_PER_LAYER, s = (step - N_PRE) % STEPS_PER_LAYER;
  const float* MODl = c.MOD() + (long)l * NCOND * MODW;
  const bool gq = (l == 1 || l == 3);
  const float* qn = IN(l == 1 ? I_GQN : I_WQN); const float* kn = IN(l == 1 ? I_GKN : I_WKN);
  const float* ck = IN(l == 1 ? I_CGK : I_CWK); const float* cv = IN(l == 1 ? I_CGV : I_CWV);
  const float lam_init = 0.8f - 0.6f * expf(-0.3f * (float)l);
  GemmDesc g;
  if (gemm_desc(step, P, c, g)) {
    if (g.res) nk_gemm_res(g.A, g.lda, g.a_pn_step, g.Bt, g.ldb, c.X(), T, g.N, g.K, MODl, g.gate_chunk, g.colscale);
    else nk_gemm_bf(g.A, g.lda, g.Bt, g.ldb, g.C, g.ldc, T, g.N, g.K);
    return;
  }
  switch (s) {
    case 0: nk_rstd(c.X(), c.RSTD()); break;
    case 1: nk_normmod(c.X(), c.RSTD(), IN(I_N1G) + l * D, MODl, 0, 1, c.Hb()); break;
    case 2: if (l == 0) nk_pool(c.Hb(), c.PDb()); break;
    case 3:
      if (l == 0) break;
      if (gq) { nk_qknorm_rope(c.QKVb(), 1536, 16, 4, 1024, qn, kn, l == 1 ? c.o_gk() : c.o_wk()); nk_copy_cols_f(c.QKVb(), 1536, 1280, 256, TCTX, l == 1 ? c.o_gv() : c.o_wv()); }
      else { nk_qknorm_rope(c.QKVb(), 3072, 16, 16, 1024, IN(I_DQN), IN(I_DKN), c.o_dk()); nk_copy_cols_f(c.QKVb(), 3072, 2048, 1024, TCTX, c.o_dv()); }
      break;
    case 5:
      if (l == 0) break;
      if (l == 1) nk_attn<0>(c.QKVb(), 1536, 1024, 1280, ck, cv, 256, nullptr, nullptr, nullptr, nullptr, nullptr, 0.f, c.Ob());
      else if (l == 3) nk_attn<1>(c.QKVb(), 1536, 1024, 1280, ck, cv, 256, IN(I_WSINK), nullptr, nullptr, nullptr, nullptr, 0.f, c.Ob());
      else nk_attn<2>(c.QKVb(), 3072, 1024, 2048, IN(I_CDK), IN(I_CDV), 1024, nullptr, IN(I_DLQ1), IN(I_DLK1), IN(I_DLQ2), IN(I_DLK2), lam_init, c.Ob());
      break;
    case 6: if (l == 2) nk_subnorm(c.Ob(), IN(I_DSUB), 1.0f - lam_init); break;
    case 8: nk_rstd(c.X(), c.RSTD()); break;
    case 9: nk_normmod(c.X(), c.RSTD(), IN(I_N2G) + l * D, MODl, 3, 4, c.Hb()); break;
    case 11: nk_convgate(c.Ub(), IN(I_FCW) + (long)l * 3 * DFF2, IN(I_FCB) + (long)l * DFF2, c.Gb()); break;
    default: break;
  }
#undef IN
}
__device__ __forceinline__ bool step_is_noop(int step) {
  if (step < N_PRE) return false;
  const int l = (step - N_PRE) / STEPS_PER_LAYER, s = (step - N_PRE) % STEPS_PER_LAYER;
  if (s == 4) return true;
  if (l == 0 && (s == 3 || s == 5)) return true;
  if (l != 2 && s == 6) return true;
  return false;
}


#ifndef HOST_EMU
#define LAS __attribute__((address_space(3)))
typedef float f32x4 __attribute__((ext_vector_type(4)));
typedef float f32x2 __attribute__((ext_vector_type(2)));
typedef unsigned u32x4 __attribute__((ext_vector_type(4)));
typedef unsigned u32x2 __attribute__((ext_vector_type(2)));
typedef __bf16 bf16x2_t __attribute__((ext_vector_type(2)));
__device__ __forceinline__ unsigned pk_bf16(float lo, float hi) { f32x2 v = {lo, hi}; bf16x2_t b = __builtin_convertvector(v, bf16x2_t); return __builtin_bit_cast(unsigned, b); }
__device__ __forceinline__ float bf_lo(unsigned u) { return __uint_as_float(u << 16); }
__device__ __forceinline__ float bf_hi(unsigned u) { return __uint_as_float(u & 0xffff0000u); }
__device__ __forceinline__ int opaque_i(int v) { asm volatile("" : "+v"(v)); return v; }
__device__ __forceinline__ int opaque_block() { int b = (int)blockIdx.x; asm volatile("" : "+s"(b)); return b; }
__device__ __forceinline__ float shx(float v, int mask, int lane) { return __int_as_float(__builtin_amdgcn_ds_bpermute((lane ^ mask) << 2, __float_as_int(v))); }
__device__ __forceinline__ float wave_sum(float v, int lane) {
#pragma unroll
  for (int o = 1; o < 64; o <<= 1) v += shx(v, o, lane);
  return v;
}
struct WaveId { int lane, wave, gw, ngw; };
__device__ __forceinline__ WaveId wave_id() { WaveId w; const int tid = opaque_i((int)threadIdx.x); w.lane = tid & 63; w.wave = __builtin_amdgcn_readfirstlane(tid >> 6); w.gw = opaque_block() * 8 + w.wave; w.ngw = (int)gridDim.x * 8; return w; }

__device__ __forceinline__ void ph_norm(const float* Xc, const float* Xl, const bf16_t* pend, const float* g, const float* MODl, int sh_chunk, int sc_chunk, bf16_t* Hb) {
  const WaveId w = wave_id();
  constexpr int NR = 3;
  for (int t0 = w.gw; t0 < T; t0 += NR * w.ngw) {
    f32x4 v[NR][4]; u32x2 q[NR][4];
#pragma unroll
    for (int r = 0; r < NR; ++r) { const int t = t0 + r * w.ngw; if (t < T) {
        const f32x4* xr = (const f32x4*)((t < TCTX ? Xc : Xl) + (size_t)t * D) + w.lane;
#pragma unroll
        for (int j = 0; j < 4; ++j) { v[r][j] = xr[64 * j]; if (pend) q[r][j] = ((const u32x2*)(pend + (size_t)t * D) + w.lane)[64 * j]; } } }
#pragma unroll
    for (int r = 0; r < NR; ++r) { const int t = t0 + r * w.ngw; if (t < T) {
        float ss = 0.f;
#pragma unroll
        for (int j = 0; j < 4; ++j) { if (pend) v[r][j] = v[r][j] + (f32x4){bf_lo(q[r][j].x), bf_hi(q[r][j].x), bf_lo(q[r][j].y), bf_hi(q[r][j].y)};
          ss += (v[r][j].x * v[r][j].x + v[r][j].y * v[r][j].y) + (v[r][j].z * v[r][j].z + v[r][j].w * v[r][j].w); }
        const float rstd = 1.0f / sqrtf(wave_sum(ss, w.lane) / (float)D + EPS);
        const float* m = MODl + (size_t)tok_cond(t) * MODW;
        u32x2* o = (u32x2*)(Hb + (size_t)t * D) + w.lane;
#pragma unroll
        for (int j = 0; j < 4; ++j) {
          const int col = 4 * w.lane + 256 * j;
          const f32x4 gg = *(const f32x4*)(g + col), sc = *(const f32x4*)(m + sc_chunk * D + col), sh = *(const f32x4*)(m + sh_chunk * D + col);
          const f32x4 y = v[r][j] * rstd * gg * (1.0f + sc) + sh;
          u32x2 pk; pk.x = pk_bf16(y.x, y.y); pk.y = pk_bf16(y.z, y.w); o[64 * j] = pk;
        } } }
  }
}

__device__ __forceinline__ void unpack8(const u32x4 r, float (&x)[8]) { x[0] = bf_lo(r.x); x[1] = bf_hi(r.x); x[2] = bf_lo(r.y); x[3] = bf_hi(r.y); x[4] = bf_lo(r.z); x[5] = bf_hi(r.z); x[6] = bf_lo(r.w); x[7] = bf_hi(r.w); }
__device__ __forceinline__ u32x4 pack8(const float (&y)[8]) { u32x4 r; r.x = pk_bf16(y[0], y[1]); r.y = pk_bf16(y[2], y[3]); r.z = pk_bf16(y[4], y[5]); r.w = pk_bf16(y[6], y[7]); return r; }

__device__ __forceinline__ void ph_pool(const bf16_t* Hb, bf16_t* PDb) {
  const int tid0 = (opaque_block() * 512 + opaque_i((int)threadIdx.x)), nth = (int)(gridDim.x * blockDim.x);
  for (int i = tid0; i < T * 128; i += nth) {
    const int t = i >> 7, c8 = i & 127, g = c8 >> 5, wdw = 2 << g; int s0, L; tok_seq(t, s0, L);
    const int pos = t - s0; int lo = pos - wdw / 2, hi = pos - wdw / 2 + wdw; lo = lo < 0 ? 0 : lo; hi = hi > L ? L : hi;
    float acc[8], x[8];
#pragma unroll
    for (int e = 0; e < 8; ++e) acc[e] = 0.f;
    u32x4 rw[16];
#pragma unroll
    for (int k = 0; k < 16; ++k) { const int j = pos - wdw / 2 + k; const bool ok = k < wdw && j >= 0 && j < L;
      rw[k] = ok ? *(const u32x4*)(Hb + (size_t)(s0 + j) * D + 8 * c8) : (u32x4){0u, 0u, 0u, 0u}; }
    const u32x4 own = *(const u32x4*)(Hb + (size_t)t * D + 8 * c8);
#pragma unroll
    for (int k = 0; k < 16; ++k) { unpack8(rw[k], x);
#pragma unroll
      for (int e = 0; e < 8; ++e) acc[e] += x[e]; }
    unpack8(own, x);
    const float cnt = (float)(hi - lo); float y[8];
#pragma unroll
    for (int e = 0; e < 8; ++e) y[e] = acc[e] / cnt - x[e];
    *(u32x4*)(PDb + (size_t)t * D + 8 * c8) = pack8(y);
  }
}

__device__ __forceinline__ void ph_qkpost(bf16_t* QKV, int ld, int nq, int nk, int nv, int kcol0, int vcol0, const float* qn, const float* kn, const float* rope, float* kout, float* vout) {
  const WaveId w = wave_id(); const int NG = (nq + nk + nv) >> 3, sl = w.lane >> 3, j = w.lane & 7;
  for (int it = w.gw; it < T * NG; it += w.ngw) {
    const int t = it / NG, sg = it - t * NG, slot = sg * 8 + sl; const bool lat = t >= TCTX;
    const int kind = slot < nq ? 0 : (slot < nq + nk ? 1 : 2);
    const int col = kind == 0 ? slot * 64 : (kind == 1 ? kcol0 + (slot - nq) * 64 : vcol0 + (slot - nq - nk) * 64);
    bf16_t* p = QKV + (size_t)t * ld + col + 8 * j;
    float x[8], y[8]; unpack8(*(const u32x4*)p, x);
    float ss = 0.f;
#pragma unroll
    for (int e = 0; e < 8; ++e) ss += x[e] * x[e];
    ss += shx(ss, 1, w.lane); ss += shx(ss, 2, w.lane); ss += shx(ss, 4, w.lane);
    const float r = 1.0f / sqrtf(ss / 64.0f + EPS);
    const float* wp = (kind == 1 ? kn : qn) + 8 * j; const f32x4 w0 = *(const f32x4*)wp, w1 = *(const f32x4*)(wp + 4);
    y[0] = x[0] * r * w0.x; y[1] = x[1] * r * w0.y; y[2] = x[2] * r * w0.z; y[3] = x[3] * r * w0.w;
    y[4] = x[4] * r * w1.x; y[5] = x[5] * r * w1.y; y[6] = x[6] * r * w1.z; y[7] = x[7] * r * w1.w;
    if (lat) {
      const int pos = (t - TCTX) % DEC_SEQ, a = j >> 2; const f32x4* tb = (const f32x4*)(rope + ((size_t)(pos * 2 + a) * 16 + 8 * (j & 1)) * 2);
      const bool x2side = (j & 2) != 0;
#pragma unroll
      for (int e2 = 0; e2 < 4; ++e2) { const f32x4 cs = tb[e2];
        const float p0 = shx(y[2 * e2], 2, w.lane), p1 = shx(y[2 * e2 + 1], 2, w.lane);
        y[2 * e2] = x2side ? y[2 * e2] * cs.x + p0 * cs.y : y[2 * e2] * cs.x - p0 * cs.y;
        y[2 * e2 + 1] = x2side ? y[2 * e2 + 1] * cs.z + p1 * cs.w : y[2 * e2 + 1] * cs.z - p1 * cs.w; }
    }
    if (kind != 2) *(u32x4*)p = pack8(y);
    if (!lat) {
      if (kind == 1) { float* o = kout + (size_t)t * (nk * 64) + (slot - nq) * 64 + 8 * j; *(f32x4*)o = (f32x4){y[0], y[1], y[2], y[3]}; *(f32x4*)(o + 4) = (f32x4){y[4], y[5], y[6], y[7]}; }
      if (kind == 2) { float* o = vout + (size_t)t * (nv * 64) + (slot - nq - nk) * 64 + 8 * j; *(f32x4*)o = (f32x4){x[0], x[1], x[2], x[3]}; *(f32x4*)(o + 4) = (f32x4){x[4], x[5], x[6], x[7]}; }
    }
  }
}

__device__ __forceinline__ void ph_convgate(const bf16_t* U, const float* cw, const float* cb, bf16_t* G) {
  constexpr int NCG = DFF / 8, RC = 8;
  const int tid0 = (opaque_block() * 512 + opaque_i((int)threadIdx.x)), nth = (int)(gridDim.x * blockDim.x);
  for (int i = tid0; i < (T / RC) * NCG; i += nth) {
    const int rc = i / NCG, cg = i - rc * NCG, r0 = rc * RC; int s0, L; tok_seq(r0, s0, L); const int pos0 = r0 - s0;
    const bool has_prev = pos0 > 0, has_next = pos0 + RC < L;
    u32x4 raw[2][RC + 2];
#pragma unroll
    for (int hf = 0; hf < 2; ++hf) {
      const bf16_t* base = U + (size_t)r0 * DFF2 + hf * DFF + 8 * cg;
      raw[hf][0] = *(const u32x4*)(has_prev ? base - DFF2 : base);
#pragma unroll
      for (int k = 0; k < RC; ++k) raw[hf][k + 1] = *(const u32x4*)(base + (size_t)k * DFF2);
      raw[hf][RC + 1] = *(const u32x4*)(has_next ? base + (size_t)RC * DFF2 : base);
    }
    float w0[2][8], w1[2][8], w2[2][8], bb[2][8];
#pragma unroll
    for (int hf = 0; hf < 2; ++hf) { const int col = hf * DFF + 8 * cg;
#pragma unroll
      for (int e = 0; e < 8; e += 4) { const f32x4 a0 = *(const f32x4*)(cw + col + e), a1 = *(const f32x4*)(cw + DFF2 + col + e), a2 = *(const f32x4*)(cw + 2 * DFF2 + col + e), a3 = *(const f32x4*)(cb + col + e);
#pragma unroll
        for (int q = 0; q < 4; ++q) { w0[hf][e + q] = a0[q]; w1[hf][e + q] = a1[q]; w2[hf][e + q] = a2[q]; bb[hf][e + q] = a3[q]; } } }
    if (!has_prev) { raw[0][0] = (u32x4){0u, 0u, 0u, 0u}; raw[1][0] = (u32x4){0u, 0u, 0u, 0u}; }
    if (!has_next) { raw[0][RC + 1] = (u32x4){0u, 0u, 0u, 0u}; raw[1][RC + 1] = (u32x4){0u, 0u, 0u, 0u}; }
    float up[2][8], uc[2][8], un[2][8];
    unpack8(raw[0][0], up[0]); unpack8(raw[1][0], up[1]); unpack8(raw[0][1], uc[0]); unpack8(raw[1][1], uc[1]);
#pragma unroll
    for (int r = 0; r < RC; ++r) {
      unpack8(raw[0][r + 2], un[0]); unpack8(raw[1][r + 2], un[1]);
      float y[8];
#pragma unroll
      for (int e = 0; e < 8; ++e) {
        const float a = uc[0][e] * w1[0][e] + bb[0][e] + up[0][e] * w0[0][e] + un[0][e] * w2[0][e];
        const float b = uc[1][e] * w1[1][e] + bb[1][e] + up[1][e] * w0[1][e] + un[1][e] * w2[1][e];
        y[e] = a / (1.0f + __expf(-a)) * b;
      }
      *(u32x4*)(G + (size_t)(r0 + r) * DFF + 8 * cg) = pack8(y);
#pragma unroll
      for (int hf = 0; hf < 2; ++hf)
#pragma unroll
        for (int e = 0; e < 8; ++e) { up[hf][e] = uc[hf][e]; uc[hf][e] = un[hf][e]; }
    }
  }
}


__device__ __forceinline__ void ph_conv_fixup(const float* edgebuf, const float* cw, const float* cb, bf16_t* G) {
  const int tid0 = (opaque_block() * 512 + opaque_i((int)threadIdx.x)), nth = (int)(gridDim.x * blockDim.x);
  for (int i = tid0; i < 6 * DFF; i += nth) {
    const int sm = i / DFF, f = i - sm * DFF, tu = (sm / 3) * 4 + (sm % 3), pn = f >> 7, cc = f & 127;
    const float* eu = edgebuf + ((size_t)(tu * (DFF / 128) + pn) * 4) * 256 + cc; const float* el = edgebuf + ((size_t)((tu + 1) * (DFF / 128) + pn) * 4) * 256 + cc;
    float o[2][2];
#pragma unroll
    for (int bj = 0; bj < 2; ++bj) { const int col = bj * DFF + f; const float w0 = cw[col], w1 = cw[DFF2 + col], w2 = cw[2 * DFF2 + col], bb = cb[col];
      const float u254 = eu[2 * 256 + bj * 128], u255 = eu[3 * 256 + bj * 128], l0 = el[0 * 256 + bj * 128], l1 = el[1 * 256 + bj * 128];
      o[0][bj] = u255 * w1 + bb + u254 * w0 + l0 * w2; o[1][bj] = l0 * w1 + bb + u255 * w0 + l1 * w2; }
    const int rowU = TCTX + (tu + 1) * 256 - 1;
    G[(size_t)rowU * DFF + f] = (bf16_t)(pk_bf16(o[0][0] / (1.0f + __expf(-o[0][0])) * o[0][1], 0.f) & 0xffffu);
    G[(size_t)(rowU + 1) * DFF + f] = (bf16_t)(pk_bf16(o[1][0] / (1.0f + __expf(-o[1][0])) * o[1][1], 0.f) & 0xffffu);
  }
}

__device__ __forceinline__ void conv_fixup_unit(const float* edgebuf, const float* cw, const float* cb, bf16_t* G, int pm, int f0, int nf) {
  if (pm * 256 < TCTX) return;
  const int tl = pm - TCTX / 256, tid = opaque_i((int)threadIdx.x);
  const bool up = (tl & 3) != 0, dn = (tl & 3) != 3;
#pragma unroll
  for (int it = 0; it < (DFF + 511) / 512; ++it) {
    const int i = tid + 512 * it; if (i >= nf) continue;
    const int f = f0 + i, pn = f >> 7, cc = f & 127;
    const float* eo = edgebuf + ((size_t)(tl * (DFF / 128) + pn) * 4) * 256 + cc;
    float ga[2], gb[2];
#pragma unroll
    for (int bj = 0; bj < 2; ++bj) { const int col = bj * DFF + f; const float w0 = cw[col], w1 = cw[DFF2 + col], w2 = cw[2 * DFF2 + col], bb = cb[col];
      const float o0 = eo[0 * 256 + bj * 128], o1 = eo[1 * 256 + bj * 128], o254 = eo[2 * 256 + bj * 128], o255 = eo[3 * 256 + bj * 128];
      float pu = 0.f, nd = 0.f;
      if (up) pu = (eo - (size_t)(DFF / 128) * 4 * 256)[3 * 256 + bj * 128];
      if (dn) nd = (eo + (size_t)(DFF / 128) * 4 * 256)[0 * 256 + bj * 128];
      const float c0 = o0 * w1 + bb + pu * w0 + o1 * w2, c255 = o255 * w1 + bb + o254 * w0 + nd * w2;
      if (bj == 0) { ga[0] = c0; ga[1] = c255; } else { gb[0] = c0; gb[1] = c255; } }
    if (up) G[(size_t)(pm * 256) * DFF + f] = (bf16_t)(pk_bf16(ga[0] / (1.0f + __expf(-ga[0])) * gb[0], 0.f) & 0xffffu);
    if (dn) G[(size_t)(pm * 256 + 255) * DFF + f] = (bf16_t)(pk_bf16(ga[1] / (1.0f + __expf(-ga[1])) * gb[1], 0.f) & 0xffffu);
  }
}

__device__ __forceinline__ void win_subunit(const bf16_t* Hb, const bf16_t* WinT, const float* cw, const float* cb, bf16_t* G, float* edgebuf, LAS unsigned char* lds, int pm, int pn, int j) {
  typedef short bf16x8 __attribute__((ext_vector_type(8)));
  const int tid = opaque_i((int)threadIdx.x), lane = tid & 63, wave = tid >> 6, c = lane & 15, g = lane >> 4;
  const bf16_t* a0p = Hb + (size_t)(pm * 256 + 32 * wave + c) * D + 8 * g; const bf16_t* a1p = a0p + (size_t)16 * D;
  const bf16_t* bp = WinT + (size_t)(pn * 256 + (c < 8 ? 8 * j + c : 128 + 8 * j + (c - 8))) * D + 8 * g;
  f32x4 acc0 = (f32x4){0.f, 0.f, 0.f, 0.f}, acc1 = acc0;
#pragma unroll 8
  for (int ks = 0; ks < D / 32; ++ks) {
    const bf16x8 a0 = *(const bf16x8*)(a0p + 32 * ks), a1 = *(const bf16x8*)(a1p + 32 * ks), b = *(const bf16x8*)(bp + 32 * ks);
    acc0 = __builtin_amdgcn_mfma_f32_16x16x32_bf16(a0, b, acc0, 0, 0, 0); acc1 = __builtin_amdgcn_mfma_f32_16x16x32_bf16(a1, b, acc1, 0, 0, 0);
  }
  LAS float* U = (LAS float*)lds;
#pragma unroll
  for (int r = 0; r < 4; ++r) { U[(32 * wave + 4 * g + r) * 16 + c] = bf_lo(pk_bf16(acc0[r], 0.f)); U[(32 * wave + 16 + 4 * g + r) * 16 + c] = bf_lo(pk_bf16(acc1[r], 0.f)); }
  __syncthreads();
  const int row = tid >> 1, q4 = (tid & 1) * 4, gcol = pn * 128 + 8 * j + q4;
  float y[4], ua[4], ub[4];
#pragma unroll
  for (int e = 0; e < 4; ++e) {
    float cv[2];
#pragma unroll
    for (int bj = 0; bj < 2; ++bj) { const int col = bj * DFF + gcol + e, lc = bj * 8 + q4 + e;
      const float uc = U[row * 16 + lc], up = row > 0 ? U[(row - 1) * 16 + lc] : 0.f, un = row < 255 ? U[(row + 1) * 16 + lc] : 0.f;
      cv[bj] = uc * cw[DFF2 + col] + cb[col] + up * cw[col] + un * cw[2 * DFF2 + col]; if (bj == 0) ua[e] = uc; else ub[e] = uc; }
    y[e] = cv[0] / (1.0f + __expf(-cv[0])) * cv[1];
  }
  u32x2 o; o.x = pk_bf16(y[0], y[1]); o.y = pk_bf16(y[2], y[3]);
  *(u32x2*)(G + (size_t)(pm * 256 + row) * DFF + gcol) = o;
  if (pm * 256 >= TCTX && (row < 2 || row >= 254)) {
    float* eb = edgebuf + ((size_t)((pm - TCTX / 256) * (DFF / 128) + pn) * 4 + (row < 2 ? row : row - 252)) * 256 + 8 * j + q4;
    *(f32x4*)eb = (f32x4){ua[0], ua[1], ua[2], ua[3]}; *(f32x4*)(eb + 128) = (f32x4){ub[0], ub[1], ub[2], ub[3]};
  }
  __syncthreads();
}

__device__ __forceinline__ void transpose_item(const float* W, int K, int N, bf16_t* WT, LAS float* scr, int item, int lane, bool pair_ab = false) {
  const int nblk = N / 32, kb = item / nblk, nb = item % nblk, k0 = 64 * kb, n0 = 32 * nb;
  int r0 = n0; if (pair_ab) { const int half = n0 >= DFF ? 1 : 0, np = n0 - half * DFF; r0 = 256 * (np / 128) + 128 * half + np % 128; }
  { const int r8 = lane >> 3, c4 = lane & 7; f32x4 v[8];
#pragma unroll
    for (int i = 0; i < 8; ++i) v[i] = *(const f32x4*)(W + (size_t)(k0 + 8 * i + r8) * N + n0 + 4 * c4);
#pragma unroll
    for (int i = 0; i < 8; ++i) { LAS float* d = scr + (8 * i + r8) * 33 + 4 * c4; d[0] = v[i].x; d[1] = v[i].y; d[2] = v[i].z; d[3] = v[i].w; } }
  asm volatile("s_waitcnt lgkmcnt(0)" ::: "memory");
  const int c = lane & 7;
#pragma unroll
  for (int j = 0; j < 4; ++j) { const int n = (lane >> 3) + 8 * j; const LAS float* sp = scr + (8 * c) * 33 + n;
    u32x4 o; o.x = pk_bf16(sp[0 * 33], sp[1 * 33]); o.y = pk_bf16(sp[2 * 33], sp[3 * 33]); o.z = pk_bf16(sp[4 * 33], sp[5 * 33]); o.w = pk_bf16(sp[6 * 33], sp[7 * 33]);
    *(u32x4*)(WT + (size_t)(r0 + n) * K + k0 + 8 * c) = o; }
  asm volatile("s_waitcnt lgkmcnt(0)" ::: "memory");
}


constexpr int CI_IN = (D / 64) * (DFF2 / 32), CI_OUT = (DFF / 64) * (D / 32), CI_Q15 = (D / 64) * (1536 / 32), CI_Q30 = (D / 64) * (3072 / 32), CI_O = (D / 64) * (D / 32), CI_P = (256 / 64) * (256 / 32);
__device__ __forceinline__ constexpr int layer_items(int l) { return CI_IN + CI_OUT + (l == 0 ? 4 * CI_P : ((l == 2 ? CI_Q30 : CI_Q15) + CI_O)); }
__device__ __forceinline__ constexpr int bg_total_items() { return layer_items(1) + layer_items(2) + layer_items(3); }
__device__ __forceinline__ constexpr int bg_end_of_layer(int l) { return l <= 0 ? 0 : (l == 1 ? layer_items(1) : (l == 2 ? layer_items(1) + layer_items(2) : bg_total_items())); }
__device__ __forceinline__ void convert_item(const Params& P, const Ctx& c, LAS float* scr, int l, int r, int lane) {
  if (r < CI_IN) { transpose_item(pin(P, I_FWIN) + (size_t)l * D * DFF2, D, DFF2, c.WinT() + (size_t)l * DFF2 * D, scr, r, lane, FUSE_CONV != 0); return; } r -= CI_IN;
  if (r < CI_OUT) { transpose_item(pin(P, I_FWOUT) + (size_t)l * DFF * D, DFF, D, c.WoutT() + (size_t)l * D * DFF, scr, r, lane); return; } r -= CI_OUT;
  if (l == 0) { const int g = r / CI_P; transpose_item(pin(P, I_POOLW) + g * 256 * 256, 256, 256, c.PoolT() + g * 256 * 256, scr, r % CI_P, lane); return; }
  const int nq = l == 2 ? CI_Q30 : CI_Q15;
  if (r < nq) { transpose_item(pin(P, l == 1 ? I_GQKV : (l == 2 ? I_DQKV : I_WQKV)), D, l == 2 ? 3072 : 1536, c.bf(l == 1 ? WS_GQKV : (l == 2 ? WS_DQKV : WS_WQKV)), scr, r, lane); return; } r -= nq;
  transpose_item(pin(P, l == 1 ? I_GWO : (l == 2 ? I_DWO : I_WWO)), D, D, c.bf(l == 1 ? WS_GWO : (l == 2 ? WS_DWO : WS_WWO)), scr, r, lane);
}
__device__ __forceinline__ void bg_item(const Params& P, const Ctx& c, LAS float* scr, int q, int lane) {
  const int l = q < bg_end_of_layer(1) ? 1 : (q < bg_end_of_layer(2) ? 2 : 3);
  convert_item(P, c, scr, l, q - bg_end_of_layer(l - 1), lane);
}
__device__ __forceinline__ void bg_work(const Params& P, const Ctx& c, LAS unsigned char* lds, unsigned budget_ticks, int upto) {
  if (!BG_QUEUE) return;
  const WaveId w = wave_id(); LAS float* scr = (LAS float*)(lds + w.wave * 16384);
  unsigned* ctr = (unsigned*)(c.ws_p() + WS_CTL) + 3520;
  const unsigned long long t0 = __builtin_amdgcn_s_memrealtime();
  for (;;) {
    if (budget_ticks != 0xffffffffu && (unsigned)(__builtin_amdgcn_s_memrealtime() - t0) > budget_ticks) break;
    unsigned q = 0xffffffffu;
    if (w.lane == 0 && (int)__hip_atomic_load(ctr, __ATOMIC_RELAXED, __HIP_MEMORY_SCOPE_AGENT) < upto) q = __hip_atomic_fetch_add(ctr, 1u, __ATOMIC_RELAXED, __HIP_MEMORY_SCOPE_AGENT);
    q = (unsigned)__builtin_amdgcn_readfirstlane((int)q);
    if (q >= (unsigned)bg_total_items()) break;
    bg_item(P, c, scr, (int)q, w.lane);
  }
}

__device__ __forceinline__ void ph_prologue(const Params& P, const Ctx& c, LAS unsigned char* lds) {
  const WaveId w = wave_id(); const int tid = opaque_i((int)threadIdx.x);
  {
    LAS float* S = (LAS float*)lds;
    LAS float* red = (LAS float*)(lds + 12288);
    for (int i = tid; i < 3 * D; i += 512) { const int cd = i / D, k = i - cd * D; const float v = cd == 0 ? pin(P, I_CCTX)[k] : pin(P, I_C)[(cd - 1) * D + k]; S[i] = v / (1.0f + expf(-v)); }
    __syncthreads();
    for (int item = opaque_block(); item < 4 * 48; item += (int)gridDim.x) {
      const int l = item / 48, n0 = (item % 48) * 128, h = w.lane >> 5, n4 = w.lane & 31;
      const float* W = pin(P, I_WMOD) + (size_t)l * D * MODW + n0 + 4 * n4;
      f32x4 acc[3] = {{0.f, 0.f, 0.f, 0.f}, {0.f, 0.f, 0.f, 0.f}, {0.f, 0.f, 0.f, 0.f}};
#pragma unroll 8
      for (int i = 0; i < 64; ++i) { const int k = 128 * w.wave + 2 * i + h; const f32x4 wv = *(const f32x4*)(W + (size_t)k * MODW);
        acc[0] += S[k] * wv; acc[1] += S[D + k] * wv; acc[2] += S[2 * D + k] * wv; }
#pragma unroll
      for (int cd = 0; cd < 3; ++cd) { acc[cd].x += shx(acc[cd].x, 32, w.lane); acc[cd].y += shx(acc[cd].y, 32, w.lane); acc[cd].z += shx(acc[cd].z, 32, w.lane); acc[cd].w += shx(acc[cd].w, 32, w.lane); }
      if (h == 0) {
#pragma unroll
        for (int cd = 0; cd < 3; ++cd) *(LAS f32x4*)(red + (w.wave * 3 + cd) * 128 + 4 * n4) = acc[cd]; }
      __syncthreads();
      if (tid < 384) { const int cd = tid >> 7, nn = tid & 127; float sum = pin(P, I_BMOD)[(size_t)l * MODW + n0 + nn];
#pragma unroll
        for (int ww = 0; ww < 8; ++ww) sum += red[(ww * 3 + cd) * 128 + nn];
        c.MOD()[((size_t)l * NCOND + cd) * MODW + n0 + nn] = sum; }
      __syncthreads();
    }
  }
  for (int i = opaque_block() * 512 + tid; i < DEC_SEQ * 32; i += (int)gridDim.x * 512) {
    const int pos = i / 32, a = (i / 16) % 2, f = i % 16;
    const float inv = powf(10000.0f, -(float)(2 * f) / 32.0f), ang = (a == 0 ? (float)(pos / 64) : (float)(pos % 64)) * inv;
    c.ROPE()[2 * i] = cosf(ang); c.ROPE()[2 * i + 1] = sinf(ang);
  }
  __syncthreads();
  {
    LAS float* scr = (LAS float*)(lds + w.wave * 16384);
    const int nitems = BG_QUEUE ? layer_items(0) : layer_items(0) + bg_total_items();
    for (int it = w.gw; it < nitems; it += w.ngw) {
      if (it < layer_items(0)) convert_item(P, c, scr, 0, it, w.lane); else bg_item(P, c, scr, it - layer_items(0), w.lane);
    }
  }
  __syncthreads();
}
#endif


#ifndef HOST_EMU
namespace att {
typedef short bf16x8 __attribute__((ext_vector_type(8)));
typedef short s16x4 __attribute__((ext_vector_type(4)));
constexpr float SC = 0.125f * 1.4426950408889634f, LOG2E = 1.4426950408889634f, NEGBIG = -1.0e30f, REF2 = 16.0f;
constexpr int OFF_K = 0, OFF_V = 32768, OFF_COMB = 73728;
struct Args {
  const bf16_t* QKV; int ld, kcol0, vcol0; const float* ck; const float* cv; int cld; const float* sink;
  const float* lq1; const float* lk1; const float* lq2; const float* lk2; float lam_init; const float* sub_g; bf16_t* O;
  const float* qn; const float* kn; const float* rope; float* kout; float* vout;
};
__device__ __forceinline__ s16x4 tr_read(const LAS unsigned char* p) { return __builtin_bit_cast(s16x4, __builtin_amdgcn_ds_read_tr16_b64_v4i16((LAS s16x4*)p)); }

template <int MODE>
__device__ __forceinline__ void unit(const Args& A, bool lat, int b, int hh, int chunk, float lam, LAS unsigned char* lds) {
  constexpr int KW = MODE == 2 ? 128 : 64, NDB = KW / 16, KROWB = KW * 2, VROWB = KW * 2 + 32, RPU = MODE == 2 ? 64 : 32, CPR = KW / 8, NCH = CPR / 8;
  constexpr int KBUF = 16384, VBUF = 20480;
  const int tid = opaque_i((int)threadIdx.x), lane = tid & 63, wave = __builtin_amdgcn_readfirstlane(tid >> 6), c = lane & 15, g = lane >> 4;
  const int s0 = lat ? TCTX + b * DEC_SEQ : b * SEQ, L = lat ? DEC_SEQ : SEQ, p0 = chunk * RPU;
  const int qpos = p0 + (MODE == 2 ? (wave & 3) * 16 : (wave & 1) * 16) + c;
  const int map = MODE == 2 ? (wave >> 2) : 0;
  const int hcol = MODE == 2 ? hh * 128 + map * 64 : (hh * 4 + (wave >> 1)) * 64;
  const int kcol = A.kcol0 + hh * KW, vcol = A.vcol0 + hh * KW, ccol = hh * KW;
  const int ncache = lat ? PAST / 64 : 0;
  int tlo = 0, thi = L / 64 - 1;
  if (MODE == 1 && lat) { const int lo = p0 - 128 < 0 ? 0 : p0 - 128, hi = p0 + RPU - 1 + 128 > L - 1 ? L - 1 : p0 + RPU - 1 + 128; tlo = lo / 64; thi = hi / 64; }
  const int NT = ncache + (thi - tlo + 1);
  bf16x8 qf[2];
  { const bf16_t* qp = A.QKV + (size_t)(s0 + qpos) * A.ld + hcol + 8 * g; qf[0] = *(const bf16x8*)qp; qf[1] = *(const bf16x8*)(qp + 32); }
  if (FUSE_QKPOST) {
    float x[2][8]; unpack8(__builtin_bit_cast(u32x4, qf[0]), x[0]); unpack8(__builtin_bit_cast(u32x4, qf[1]), x[1]);
    float ss = 0.f;
#pragma unroll
    for (int ks = 0; ks < 2; ++ks)
#pragma unroll
      for (int e = 0; e < 8; ++e) ss += x[ks][e] * x[ks][e];
    ss += shx(ss, 16, lane); ss += shx(ss, 32, lane);
    const float r = 1.0f / sqrtf(ss / 64.0f + EPS);
#pragma unroll
    for (int ks = 0; ks < 2; ++ks) { const f32x4 w0 = *(const f32x4*)(A.qn + 32 * ks + 8 * g), w1 = *(const f32x4*)(A.qn + 32 * ks + 8 * g + 4);
      x[ks][0] *= r * w0.x; x[ks][1] *= r * w0.y; x[ks][2] *= r * w0.z; x[ks][3] *= r * w0.w; x[ks][4] *= r * w1.x; x[ks][5] *= r * w1.y; x[ks][6] *= r * w1.z; x[ks][7] *= r * w1.w; }
    if (lat) { const bool x2side = (g & 2) != 0;
#pragma unroll
      for (int ks = 0; ks < 2; ++ks) { const f32x4* tb = (const f32x4*)(A.rope + ((size_t)(qpos * 2 + ks) * 16 + 8 * (g & 1)) * 2);
#pragma unroll
        for (int e2 = 0; e2 < 4; ++e2) { const f32x4 cs = tb[e2]; const float p0 = shx(x[ks][2 * e2], 32, lane), p1 = shx(x[ks][2 * e2 + 1], 32, lane);
          x[ks][2 * e2] = x2side ? x[ks][2 * e2] * cs.x + p0 * cs.y : x[ks][2 * e2] * cs.x - p0 * cs.y;
          x[ks][2 * e2 + 1] = x2side ? x[ks][2 * e2 + 1] * cs.z + p1 * cs.w : x[ks][2 * e2 + 1] * cs.z - p1 * cs.w; } } }
    qf[0] = __builtin_bit_cast(bf16x8, pack8(x[0])); qf[1] = __builtin_bit_cast(bf16x8, pack8(x[1]));
  }
  f32x4 o[NDB];
#pragma unroll
  for (int db = 0; db < NDB; ++db) o[db] = (f32x4){0.f, 0.f, 0.f, 0.f};
  float m = NEGBIG, lsum = 0.f;
  f32x4 rkA[NCH][2], rvA[NCH][2], rkB[NCH][2], rvB[NCH][2];
  auto load_tileA = [&](int t) {
    if (t < ncache) {
#pragma unroll
      for (int i = 0; i < NCH; ++i) { const int id = tid + 512 * i, row = id / CPR, ch = id % CPR; const size_t off = (size_t)(b * PAST + t * 64 + row) * A.cld + ccol + ch * 8;
        rkA[i][0] = *(const f32x4*)(A.ck + off); rkA[i][1] = *(const f32x4*)(A.ck + off + 4); rvA[i][0] = *(const f32x4*)(A.cv + off); rvA[i][1] = *(const f32x4*)(A.cv + off + 4); }
    } else {
      const int r0 = s0 + (tlo + t - ncache) * 64;
#pragma unroll
      for (int i = 0; i < NCH; ++i) { const int id = tid + 512 * i, row = id / CPR, ch = id % CPR; const bf16_t* rp = A.QKV + (size_t)(r0 + row) * A.ld + ch * 8;
        rkA[i][0] = *(const f32x4*)(rp + kcol); rvA[i][0] = *(const f32x4*)(rp + vcol); }
    }
  };
  auto write_tileA = [&](int t, int buf) {
    LAS unsigned char* Kb = lds + OFF_K + buf * KBUF; LAS unsigned char* Vb = lds + OFF_V + buf * VBUF;
#pragma unroll
    for (int i = 0; i < NCH; ++i) { const int id = tid + 512 * i, row = id / CPR, ch = id % CPR;
      const int pch = KW == 64 ? (ch ^ ((row >> 1) & 7)) : (ch ^ (row & 15));
      u32x4 kq, vq;
      if (t < ncache) {
        kq.x = pk_bf16(rkA[i][0].x, rkA[i][0].y); kq.y = pk_bf16(rkA[i][0].z, rkA[i][0].w); kq.z = pk_bf16(rkA[i][1].x, rkA[i][1].y); kq.w = pk_bf16(rkA[i][1].z, rkA[i][1].w);
        vq.x = pk_bf16(rvA[i][0].x, rvA[i][0].y); vq.y = pk_bf16(rvA[i][0].z, rvA[i][0].w); vq.z = pk_bf16(rvA[i][1].x, rvA[i][1].y); vq.w = pk_bf16(rvA[i][1].z, rvA[i][1].w);
      } else { kq = __builtin_bit_cast(u32x4, rkA[i][0]); vq = __builtin_bit_cast(u32x4, rvA[i][0]);
        if (FUSE_QKPOST) {
          const int j = ch & 7, kpos = (tlo + t - ncache) * 64 + row;
          float x[8]; unpack8(kq, x); float ss = 0.f;
#pragma unroll
          for (int e = 0; e < 8; ++e) ss += x[e] * x[e];
          ss += shx(ss, 1, lane); ss += shx(ss, 2, lane); ss += shx(ss, 4, lane);
          const float r = 1.0f / sqrtf(ss / 64.0f + EPS);
          const f32x4 w0 = *(const f32x4*)(A.kn + 8 * j), w1 = *(const f32x4*)(A.kn + 8 * j + 4);
          x[0] *= r * w0.x; x[1] *= r * w0.y; x[2] *= r * w0.z; x[3] *= r * w0.w; x[4] *= r * w1.x; x[5] *= r * w1.y; x[6] *= r * w1.z; x[7] *= r * w1.w;
          if (lat) { const int a = j >> 2; const f32x4* tb = (const f32x4*)(A.rope + ((size_t)(kpos * 2 + a) * 16 + 8 * (j & 1)) * 2); const bool x2side = (j & 2) != 0;
#pragma unroll
            for (int e2 = 0; e2 < 4; ++e2) { const f32x4 cs = tb[e2]; const float p0 = shx(x[2 * e2], 2, lane), p1 = shx(x[2 * e2 + 1], 2, lane);
              x[2 * e2] = x2side ? x[2 * e2] * cs.x + p0 * cs.y : x[2 * e2] * cs.x - p0 * cs.y;
              x[2 * e2 + 1] = x2side ? x[2 * e2 + 1] * cs.z + p1 * cs.w : x[2 * e2 + 1] * cs.z - p1 * cs.w; } }
          kq = pack8(x);
          if (!lat && kpos >= p0 && kpos < p0 + RPU) {
            constexpr int KOW = MODE == 2 ? 1024 : 256; const size_t oo = (size_t)(s0 + kpos) * KOW + hh * KW + ch * 8;
            *(f32x4*)(A.kout + oo) = (f32x4){x[0], x[1], x[2], x[3]}; *(f32x4*)(A.kout + oo + 4) = (f32x4){x[4], x[5], x[6], x[7]};
            float v[8]; unpack8(vq, v); *(f32x4*)(A.vout + oo) = (f32x4){v[0], v[1], v[2], v[3]}; *(f32x4*)(A.vout + oo + 4) = (f32x4){v[4], v[5], v[6], v[7]}; }
        } }
      *(LAS u32x4*)(Kb + row * KROWB + pch * 16) = kq; *(LAS u32x4*)(Vb + row * VROWB + ch * 16) = vq; }
  };
  auto load_tileB = [&](int t) {
    if (t < ncache) {
#pragma unroll
      for (int i = 0; i < NCH; ++i) { const int id = tid + 512 * i, row = id / CPR, ch = id % CPR; const size_t off = (size_t)(b * PAST + t * 64 + row) * A.cld + ccol + ch * 8;
        rkB[i][0] = *(const f32x4*)(A.ck + off); rkB[i][1] = *(const f32x4*)(A.ck + off + 4); rvB[i][0] = *(const f32x4*)(A.cv + off); rvB[i][1] = *(const f32x4*)(A.cv + off + 4); }
    } else {
      const int r0 = s0 + (tlo + t - ncache) * 64;
#pragma unroll
      for (int i = 0; i < NCH; ++i) { const int id = tid + 512 * i, row = id / CPR, ch = id % CPR; const bf16_t* rp = A.QKV + (size_t)(r0 + row) * A.ld + ch * 8;
        rkB[i][0] = *(const f32x4*)(rp + kcol); rvB[i][0] = *(const f32x4*)(rp + vcol); }
    }
  };
  auto write_tileB = [&](int t, int buf) {
    LAS unsigned char* Kb = lds + OFF_K + buf * KBUF; LAS unsigned char* Vb = lds + OFF_V + buf * VBUF;
#pragma unroll
    for (int i = 0; i < NCH; ++i) { const int id = tid + 512 * i, row = id / CPR, ch = id % CPR;
      const int pch = KW == 64 ? (ch ^ ((row >> 1) & 7)) : (ch ^ (row & 15));
      u32x4 kq, vq;
      if (t < ncache) {
        kq.x = pk_bf16(rkB[i][0].x, rkB[i][0].y); kq.y = pk_bf16(rkB[i][0].z, rkB[i][0].w); kq.z = pk_bf16(rkB[i][1].x, rkB[i][1].y); kq.w = pk_bf16(rkB[i][1].z, rkB[i][1].w);
        vq.x = pk_bf16(rvB[i][0].x, rvB[i][0].y); vq.y = pk_bf16(rvB[i][0].z, rvB[i][0].w); vq.z = pk_bf16(rvB[i][1].x, rvB[i][1].y); vq.w = pk_bf16(rvB[i][1].z, rvB[i][1].w);
      } else { kq = __builtin_bit_cast(u32x4, rkB[i][0]); vq = __builtin_bit_cast(u32x4, rvB[i][0]);
        if (FUSE_QKPOST) {
          const int j = ch & 7, kpos = (tlo + t - ncache) * 64 + row;
          float x[8]; unpack8(kq, x); float ss = 0.f;
#pragma unroll
          for (int e = 0; e < 8; ++e) ss += x[e] * x[e];
          ss += shx(ss, 1, lane); ss += shx(ss, 2, lane); ss += shx(ss, 4, lane);
          const float r = 1.0f / sqrtf(ss / 64.0f + EPS);
          const f32x4 w0 = *(const f32x4*)(A.kn + 8 * j), w1 = *(const f32x4*)(A.kn + 8 * j + 4);
          x[0] *= r * w0.x; x[1] *= r * w0.y; x[2] *= r * w0.z; x[3] *= r * w0.w; x[4] *= r * w1.x; x[5] *= r * w1.y; x[6] *= r * w1.z; x[7] *= r * w1.w;
          if (lat) { const int a = j >> 2; const f32x4* tb = (const f32x4*)(A.rope + ((size_t)(kpos * 2 + a) * 16 + 8 * (j & 1)) * 2); const bool x2side = (j & 2) != 0;
#pragma unroll
            for (int e2 = 0; e2 < 4; ++e2) { const f32x4 cs = tb[e2]; const float p0 = shx(x[2 * e2], 2, lane), p1 = shx(x[2 * e2 + 1], 2, lane);
              x[2 * e2] = x2side ? x[2 * e2] * cs.x + p0 * cs.y : x[2 * e2] * cs.x - p0 * cs.y;
              x[2 * e2 + 1] = x2side ? x[2 * e2 + 1] * cs.z + p1 * cs.w : x[2 * e2 + 1] * cs.z - p1 * cs.w; } }
          kq = pack8(x);
          if (!lat && kpos >= p0 && kpos < p0 + RPU) {
            constexpr int KOW = MODE == 2 ? 1024 : 256; const size_t oo = (size_t)(s0 + kpos) * KOW + hh * KW + ch * 8;
            *(f32x4*)(A.kout + oo) = (f32x4){x[0], x[1], x[2], x[3]}; *(f32x4*)(A.kout + oo + 4) = (f32x4){x[4], x[5], x[6], x[7]};
            float v[8]; unpack8(vq, v); *(f32x4*)(A.vout + oo) = (f32x4){v[0], v[1], v[2], v[3]}; *(f32x4*)(A.vout + oo + 4) = (f32x4){v[4], v[5], v[6], v[7]}; }
        } }
      *(LAS u32x4*)(Kb + row * KROWB + pch * 16) = kq; *(LAS u32x4*)(Vb + row * VROWB + ch * 16) = vq; }
  };
#define ATT_BAR() do { asm volatile("s_waitcnt lgkmcnt(0)" ::: "memory"); __builtin_amdgcn_s_barrier(); asm volatile("" ::: "memory"); } while (0)
  auto compute = [&](int t, int cur) {
    const LAS unsigned char* Kb = lds + OFF_K + cur * KBUF; const LAS unsigned char* Vb = lds + OFF_V + cur * VBUF;
    f32x4 s[4];
#pragma unroll
    for (int kb = 0; kb < 4; ++kb) { s[kb] = (f32x4){0.f, 0.f, 0.f, 0.f};
#pragma unroll
      for (int ks = 0; ks < 2; ++ks) { const int row = 16 * kb + c, ch = map * 8 + 4 * ks + g, pch = KW == 64 ? (ch ^ ((row >> 1) & 7)) : (ch ^ (row & 15));
        const bf16x8 kf = *(const LAS bf16x8*)(Kb + row * KROWB + pch * 16);
        s[kb] = __builtin_amdgcn_mfma_f32_16x16x32_bf16(kf, qf[ks], s[kb], 0, 0, 0); } }
    const bool band = (MODE == 1) && lat && (t >= ncache); const int tb = (tlo + t - ncache) * 64;
    float ps = 0.f;
    if (ATT_FIXED_REF) {
#pragma unroll
      for (int kb = 0; kb < 4; ++kb)
#pragma unroll
        for (int r = 0; r < 4; ++r) { float p = __builtin_amdgcn_exp2f(s[kb][r] * SC - REF2);
          if (band) { const int dlt = qpos - (tb + 16 * kb + 4 * g + r); if (dlt > 128 || dlt < -128) p = 0.f; }
          s[kb][r] = p; ps += p; }
      lsum += ps;
    } else {
    float mx = NEGBIG;
#pragma unroll
    for (int kb = 0; kb < 4; ++kb)
#pragma unroll
      for (int r = 0; r < 4; ++r) { float v = s[kb][r] * SC;
        if (band) { const int dlt = qpos - (tb + 16 * kb + 4 * g + r); if (dlt > 128 || dlt < -128) v = NEGBIG; }
        s[kb][r] = v; mx = fmaxf(mx, v); }
    mx = fmaxf(mx, shx(mx, 16, lane)); mx = fmaxf(mx, shx(mx, 32, lane));
    const float mn = fmaxf(m, mx), alpha = __builtin_amdgcn_exp2f(m - mn); m = mn;
#pragma unroll
    for (int kb = 0; kb < 4; ++kb)
#pragma unroll
      for (int r = 0; r < 4; ++r) { const float p = __builtin_amdgcn_exp2f(s[kb][r] - mn); s[kb][r] = p; ps += p; }
    lsum = lsum * alpha + ps;
#pragma unroll
    for (int db = 0; db < NDB; ++db) o[db] = o[db] * alpha;
    }
    bf16x8 pf[2];
#pragma unroll
    for (int ks = 0; ks < 2; ++ks) { u32x4 pk; pk.x = pk_bf16(s[2 * ks][0], s[2 * ks][1]); pk.y = pk_bf16(s[2 * ks][2], s[2 * ks][3]); pk.z = pk_bf16(s[2 * ks + 1][0], s[2 * ks + 1][1]); pk.w = pk_bf16(s[2 * ks + 1][2], s[2 * ks + 1][3]);
      pf[ks] = __builtin_bit_cast(bf16x8, pk); }
#pragma unroll
    for (int db = 0; db < NDB; ++db)
#pragma unroll
      for (int ks = 0; ks < 2; ++ks) { const LAS unsigned char* vp = Vb + (32 * ks + 4 * g + (c >> 2)) * VROWB + 32 * db + 8 * (c & 3);
        const s16x4 lo = tr_read(vp), hi = tr_read(vp + 16 * VROWB);
        const bf16x8 vt = (bf16x8){lo[0], lo[1], lo[2], lo[3], hi[0], hi[1], hi[2], hi[3]};
        o[db] = __builtin_amdgcn_mfma_f32_16x16x32_bf16(vt, pf[ks], o[db], 0, 0, 0); }
  };
  load_tileA(0); if (NT > 1) load_tileB(1);
  write_tileA(0, 0); ATT_BAR();
  for (int t = 0; t < NT; t += 2) {
    if (t + 2 < NT) load_tileA(t + 2);
    compute(t, 0);
    if (t + 1 < NT) write_tileB(t + 1, 1);
    ATT_BAR();
    if (t + 1 >= NT) break;
    if (t + 3 < NT) load_tileB(t + 3);
    compute(t + 1, 1);
    if (t + 2 < NT) write_tileA(t + 2, 0);
    ATT_BAR();
  }
  lsum += shx(lsum, 16, lane); lsum += shx(lsum, 32, lane);
  if (MODE == 1) lsum += __builtin_amdgcn_exp2f(A.sink[hh * 4 + (wave >> 1)] * LOG2E - (ATT_FIXED_REF ? REF2 : m));
  const float rl = 1.0f / lsum;
  if (MODE != 2) {
    bf16_t* op = A.O + (size_t)(s0 + qpos) * D + hcol + 4 * g;
#pragma unroll
    for (int db = 0; db < NDB; ++db) { u32x2 pk; pk.x = pk_bf16(o[db][0] * rl, o[db][1] * rl); pk.y = pk_bf16(o[db][2] * rl, o[db][3] * rl); *(u32x2*)(op + 16 * db) = pk; }
  } else {
    LAS float* comb = (LAS float*)(lds + OFF_COMB);
    const int row = (wave & 3) * 16 + c;
    if (map == 1) {
#pragma unroll
      for (int db = 0; db < NDB; ++db) *(LAS f32x4*)(comb + row * 132 + 16 * db + 4 * g) = o[db] * rl;
    }
    __syncthreads();
    if (map == 0) {
      float ss = 0.f;
#pragma unroll
      for (int db = 0; db < NDB; ++db) { const f32x4 o2 = *(const LAS f32x4*)(comb + row * 132 + 16 * db + 4 * g); o[db] = o[db] * rl - lam * o2;
        ss += (o[db][0] * o[db][0] + o[db][1] * o[db][1]) + (o[db][2] * o[db][2] + o[db][3] * o[db][3]); }
      ss += shx(ss, 16, lane); ss += shx(ss, 32, lane);
      const float rs = (1.0f - A.lam_init) / sqrtf(ss / 128.0f + EPS);
      bf16_t* op = A.O + (size_t)(s0 + qpos) * D + hh * 128 + 4 * g;
#pragma unroll
      for (int db = 0; db < NDB; ++db) { const f32x4 sg = *(const f32x4*)(A.sub_g + 16 * db + 4 * g); u32x2 pk; pk.x = pk_bf16(o[db][0] * rs * sg.x, o[db][1] * rs * sg.y); pk.y = pk_bf16(o[db][2] * rs * sg.z, o[db][3] * rs * sg.w);
        *(u32x2*)(op + 16 * db) = pk; }
    }
    __syncthreads();
  }
}

template <int MODE>
__device__ __forceinline__ void phase(const Args& A, LAS unsigned char* lds) {
  constexpr int NH = MODE == 2 ? 8 : 4, RPU = MODE == 2 ? 64 : 32, CPS_L = DEC_SEQ / RPU, CPS_C = SEQ / RPU, NLAT = DEC_BATCH * NH * CPS_L, NCTX = BATCH * NH * CPS_C;
  float lam = 0.f;
  if (MODE == 2) { const int lane = opaque_i((int)threadIdx.x) & 63; const float d1 = wave_sum(A.lq1[lane] * A.lk1[lane], lane), d2 = wave_sum(A.lq2[lane] * A.lk2[lane], lane); lam = expf(d1) - expf(d2) + A.lam_init; }
  for (int u = opaque_block(); u < NLAT; u += (int)gridDim.x) unit<MODE>(A, true, u / (NH * CPS_L), (u / CPS_L) % NH, u % CPS_L, lam, lds);
  for (int u = opaque_block(); u < NCTX; u += (int)gridDim.x) unit<MODE>(A, false, u / (NH * CPS_C), (u / CPS_C) % NH, u % CPS_C, lam, lds);
}
}
#endif


#ifndef HOST_EMU
#define XB_TMO      128
#define XB_XCNT(j)  (256  + 64 * (j))
#define XB_XSUB(j)  (1280 + 64 * (j))
#define XB_XGEN(j)  (2304 + 64 * (j))
#define XB_TOP      3328
#define XB_TOPGEN   3392
#define XCD_BAR_WORDS 3456
#define XB_SPIN_CAP (1u << 18)

__device__ __forceinline__ unsigned xb_ld(unsigned* p)              { return __hip_atomic_load(p, __ATOMIC_RELAXED, __HIP_MEMORY_SCOPE_AGENT); }
__device__ __forceinline__ unsigned xb_add(unsigned* p, unsigned v) { return __hip_atomic_fetch_add(p, v, __ATOMIC_RELAXED, __HIP_MEMORY_SCOPE_AGENT); }
__device__ __forceinline__ unsigned xb_xcc_id() { return (unsigned)__builtin_amdgcn_s_getreg((3 << 11) | 20) & 0xFu; }
#define XB_SPIN(cond, bar) do { unsigned _sp = 0; while (cond) { __builtin_amdgcn_s_sleep(1); \
    if ((++_sp & 255u) == 0u) { if (xb_ld(&(bar)[XB_TMO])) break; if (_sp > XB_SPIN_CAP) { atomicAdd(&(bar)[XB_TMO], 1u); break; } } } } while (0)

struct XcdBarrier {
    unsigned* bar; unsigned x;
    volatile LAS unsigned* st;
};

__device__ __forceinline__ XcdBarrier xcd_barrier_post(unsigned* bar, volatile LAS unsigned* st) {
    XcdBarrier b; b.bar = bar; b.x = xb_xcc_id(); b.st = st;
    if (threadIdx.x == 0) (void)xb_add(&bar[XB_XCNT(b.x)], 1u);
    return b;
}
__device__ __forceinline__ void xcd_barrier_complete(unsigned* bar, unsigned x, unsigned& nloc, unsigned& nx) {
    const unsigned G = gridDim.x * gridDim.y * gridDim.z;
    unsigned sum, cnt, mine, sp = 0u;
    for (;;) {
        sum = 0u; cnt = 0u; mine = 0u;
#pragma unroll
        for (unsigned j = 0; j < 16; ++j) { const unsigned c = xb_ld(&bar[XB_XCNT(j)]); sum += c; cnt += (c > 0u) ? 1u : 0u; mine = (j == x) ? c : mine; }
        if (sum == G) break;
        __builtin_amdgcn_s_sleep(1);
        if ((++sp & 255u) == 0u) { if (xb_ld(&bar[XB_TMO])) break; if (sp > XB_SPIN_CAP) { atomicAdd(&bar[XB_TMO], 1u); break; } }
    }
    nloc = mine > 0u ? mine : 1u; nx = cnt > 0u ? cnt : 1u;
}

__device__ __forceinline__ void xcd_barrier(const XcdBarrier& b) {
    asm volatile("s_waitcnt vmcnt(0)" ::: "memory");
    __syncthreads();
    if (threadIdx.x == 0) {
        unsigned* bar = b.bar;
        __builtin_amdgcn_s_waitcnt(0);
        unsigned nloc = b.st[0], nx = b.st[1];
        if (nloc == 0u) { xcd_barrier_complete(bar, b.x, nloc, nx); b.st[0] = nloc; b.st[1] = nx; }
        const unsigned old = xb_add(&bar[XB_XSUB(b.x)], 1u);
        const unsigned gen = old / nloc;
        if (old + 1u == (gen + 1u) * nloc) {
            __builtin_amdgcn_fence(__ATOMIC_RELEASE, "agent");
            asm volatile("s_waitcnt vmcnt(0)" ::: "memory");
            const unsigned og = xb_add(&bar[XB_TOP], 1u);
            const unsigned tg = og / nx;
            if (og + 1u == (tg + 1u) * nx) xb_add(&bar[XB_TOPGEN], 1u);
            else XB_SPIN(xb_ld(&bar[XB_TOPGEN]) == tg, bar);
            __builtin_amdgcn_fence(__ATOMIC_ACQUIRE, "agent");
            xb_add(&bar[XB_XGEN(b.x)], 1u);
            asm volatile("s_waitcnt vmcnt(0)" ::: "memory");
        } else {
            XB_SPIN(xb_ld(&bar[XB_XGEN(b.x)]) == gen, bar);
            __builtin_amdgcn_fence(__ATOMIC_ACQUIRE, "agent");
            asm volatile("s_waitcnt vmcnt(0)" ::: "memory");
        }
    }
    __syncthreads();
}
#endif

#ifndef HOST_EMU
constexpr int LDS_BYTES = 147456;
#ifndef FAST_PRO
#define FAST_PRO 1
#endif
#ifndef FAST_NORM
#define FAST_NORM 1
#endif
#ifndef FAST_POOL
#define FAST_POOL 1
#endif
#ifndef FAST_QKPOST
#define FAST_QKPOST 1
#endif
#ifndef FAST_CONV
#define FAST_CONV 1
#endif
#ifndef FAST_ATTN
#define FAST_ATTN 1
#endif
#ifndef REP_GEMM
#define REP_GEMM 0
#endif
#ifndef REP_ATTN
#define REP_ATTN 0
#endif
#ifndef REP_ELEM
#define REP_ELEM 0
#endif
#ifndef REP_PRO
#define REP_PRO 0
#endif
#ifndef REP_SYNC
#define REP_SYNC 0
#endif
#ifndef USE_CG_SYNC
#define USE_CG_SYNC 0
#endif
__global__ void __launch_bounds__(512, 2) mega(Params P) {
  extern __shared__ __attribute__((aligned(16))) unsigned char lds_raw[];
  cg::grid_group grid = cg::this_grid();
  PG8_LAS unsigned char* lds = (PG8_LAS unsigned char*)lds_raw;
  const Ctx c = make_ctx(P);
  volatile LAS unsigned* MISC = (volatile LAS unsigned*)((LAS unsigned char*)lds_raw + 131072 + 320);
  if (threadIdx.x < 32) MISC[threadIdx.x] = 0u;
  __syncthreads();
  { unsigned* b0_ = (unsigned*)(P.ws + WS_CTL); asm volatile("" : "+s"(b0_)); (void)xcd_barrier_post(b0_, MISC + 8); }
#define BAR_NOW() do { XcdBarrier bar_; { unsigned* b0_ = (unsigned*)(P.ws + WS_CTL); asm volatile("" : "+s"(b0_)); bar_.bar = b0_; } bar_.x = xb_xcc_id(); bar_.st = (volatile LAS unsigned*)((LAS unsigned char*)lds_raw + 131072 + 320) + 8; xcd_barrier(bar_); } while (0)
#define GSYNC() do { if (USE_CG_SYNC) grid.sync(); else BAR_NOW(); if (REP_SYNC) { if (USE_CG_SYNC) grid.sync(); else BAR_NOW(); } } while (0)
#define NAIVE(step) do { naive_step((step), P, c); } while (0)
#define GEMM_RUN(step, rep_) do { GemmDesc g; gemm_desc((step), P, c, g); \
    pg8::Gemm gg{g.A, g.Bt, T, g.N, g.K, g.lda, g.ldb, g.a_pn_step, g.ksplit}; pg8::StaticOrder S; S.init(T, g.N, (int)gridDim.x, opaque_block(), g.ksplit); \
    if (g.res) { bf16_t* slab_ = (bf16_t*)(c.ws_p() + (pend == (const bf16_t*)(c.ws_p() + WS_SA) ? WS_SB : WS_SA)); \
      float* xw_ = (rep_) == 0 ? c.X() : (float*)(g.K == DFF ? c.Ub() : c.Gb()); const bool first_ = ((step) == N_PRE + 7); \
      pg8::EpiRes E{xw_, first_ ? pin(P, I_XP) : (const float*)xw_, first_ ? pin(P, I_XS) - (size_t)TCTX * D : (const float*)xw_, MODl, g.gate_chunk, g.colscale, pend, slab_}; pg8::gemm_phase<pg8::EpiRes, pg8::StaticOrder, true, true>(lds, gg, S, E); \
      if ((rep_) == 0) pend = g.ksplit > 1 ? (const bf16_t*)slab_ : nullptr; } \
    else { pg8::EpiBf16<0> E{g.C, g.ldc, nullptr, 0, 0, 1.f}; pg8::gemm_phase<pg8::EpiBf16<0>, pg8::StaticOrder, true, true>(lds, gg, S, E); } } while (0)
#define GEMM_STEP(step) do { GEMM_RUN(step, 0); if (REP_GEMM) { __syncthreads(); GEMM_RUN(step, 1); } } while (0)
  const bf16_t* pend = nullptr;
#define BG_AFTER_GEMM(nunits, ticks) do { const int G_ = (int)gridDim.x, b_ = opaque_block(), r_ = ((nunits) + G_ - 1) / G_, full_ = (nunits) - (r_ - 1) * G_; \
    if (b_ >= full_) bg_work(P, c, (LAS unsigned char*)lds_raw, (ticks), bg_total_items()); } while (0)
  if (FAST_PRO) { for (int rep_ = 0; rep_ < 1 + REP_PRO; ++rep_) ph_prologue(P, c, (LAS unsigned char*)lds_raw); GSYNC(); }
  else { NAIVE(0); GSYNC(); NAIVE(1); GSYNC(); NAIVE(2); GSYNC(); }
#pragma unroll 1
  for (int l = 0; l < 4; ++l) {
    const int s0 = N_PRE + l * STEPS_PER_LAYER;
    const float* MODl = c.MOD() + (size_t)l * NCOND * MODW;
    if (l > 0) bg_work(P, c, (LAS unsigned char*)lds_raw, 0xffffffffu, bg_end_of_layer(l));
    if (FAST_NORM) { for (int rep_ = 0; rep_ < 1 + REP_ELEM; ++rep_) ph_norm(l == 0 ? pin(P, I_XP) : (const float*)c.X(), l == 0 ? pin(P, I_XS) - (size_t)TCTX * D : (const float*)c.X(), pend, pin(P, I_N1G) + l * D, MODl, 0, 1, c.Hb()); GSYNC(); }
    else { NAIVE(s0 + 0); GSYNC(); NAIVE(s0 + 1); GSYNC(); }
    if (l == 0) {
      if (FAST_POOL) { for (int rep_ = 0; rep_ < 1 + REP_ELEM; ++rep_) ph_pool(c.Hb(), c.PDb()); } else NAIVE(s0 + 2);
      GSYNC();
    } else {
      if (FUSE_QKEPI) {
        GemmDesc g; gemm_desc(s0 + 2, P, c, g);
        pg8::Gemm gg{g.A, g.Bt, T, g.N, g.K, g.lda, g.ldb, g.a_pn_step, 1}; pg8::StaticOrder S; S.init(T, g.N, (int)gridDim.x, opaque_block(), 1);
        pg8::EpiQK E{c.QKVb(), g.N, 1024, l == 2 ? 2048 : 1280, pin(P, l == 1 ? I_GQN : (l == 2 ? I_DQN : I_WQN)), pin(P, l == 1 ? I_GKN : (l == 2 ? I_DKN : I_WKN)), c.ROPE(),
                     l == 1 ? c.o_gk() : (l == 2 ? c.o_dk() : c.o_wk()), l == 1 ? c.o_gv() : (l == 2 ? c.o_dv() : c.o_wv()), l == 2 ? 1024 : 256, (PG8_LAS float*)(lds + 131072 + 1024)};
        pg8::gemm_phase<pg8::EpiQK, pg8::StaticOrder, true, true>(lds, gg, S, E);
      } else GEMM_STEP(s0 + 2);
      GSYNC();
      if (FUSE_QKPOST || FUSE_QKEPI) {   }
      else if (FAST_QKPOST) {
        if (l == 2) ph_qkpost(c.QKVb(), 3072, 16, 16, 16, 1024, 2048, pin(P, I_DQN), pin(P, I_DKN), c.ROPE(), c.o_dk(), c.o_dv());
        else ph_qkpost(c.QKVb(), 1536, 16, 4, 4, 1024, 1280, pin(P, l == 1 ? I_GQN : I_WQN), pin(P, l == 1 ? I_GKN : I_WKN), c.ROPE(), l == 1 ? c.o_gk() : c.o_wk(), l == 1 ? c.o_gv() : c.o_wv());
      } else NAIVE(s0 + 3);
      if (!FUSE_QKPOST && !FUSE_QKEPI) GSYNC();
      if (FAST_ATTN) {
        const float lam_init = 0.8f - 0.6f * expf(-0.3f * (float)l);
        for (int rep_ = 0; rep_ < 1 + REP_ATTN; ++rep_) {
        if (l == 2) { const att::Args A{c.QKVb(), 3072, 1024, 2048, pin(P, I_CDK), pin(P, I_CDV), 1024, nullptr, pin(P, I_DLQ1), pin(P, I_DLK1), pin(P, I_DLQ2), pin(P, I_DLK2), lam_init, pin(P, I_DSUB), c.Ob(), pin(P, I_DQN), pin(P, I_DKN), c.ROPE(), c.o_dk(), c.o_dv()};
          att::phase<2>(A, (LAS unsigned char*)lds_raw); }
        else if (l == 1) { const att::Args A{c.QKVb(), 1536, 1024, 1280, pin(P, I_CGK), pin(P, I_CGV), 256, nullptr, nullptr, nullptr, nullptr, nullptr, 0.f, nullptr, c.Ob(), pin(P, I_GQN), pin(P, I_GKN), c.ROPE(), c.o_gk(), c.o_gv()};
          att::phase<0>(A, (LAS unsigned char*)lds_raw); }
        else { const att::Args A{c.QKVb(), 1536, 1024, 1280, pin(P, I_CWK), pin(P, I_CWV), 256, pin(P, I_WSINK), nullptr, nullptr, nullptr, nullptr, 0.f, nullptr, c.Ob(), pin(P, I_WQN), pin(P, I_WKN), c.ROPE(), c.o_wk(), c.o_wv()};
          att::phase<1>(A, (LAS unsigned char*)lds_raw); }
        }
        GSYNC();
      } else {
        NAIVE(s0 + 5); GSYNC();
        if (l == 2) { NAIVE(s0 + 6); GSYNC(); }
      }
    }
    GEMM_STEP(s0 + 7); BG_AFTER_GEMM((T / 256) * (D / 256) * (l == 0 ? 1 : KSPLIT), l == 0 ? 400u : 800u); GSYNC();
    if (FAST_NORM) { for (int rep_ = 0; rep_ < 1 + REP_ELEM; ++rep_) ph_norm(c.X(), c.X(), pend, pin(P, I_N2G) + l * D, MODl, 3, 4, c.Hb()); GSYNC(); }
    else { NAIVE(s0 + 8); GSYNC(); NAIVE(s0 + 9); GSYNC(); }
    if (FUSE_CONV) {
      GemmDesc g; gemm_desc(s0 + 10, P, c, g);
      pg8::Gemm gg{g.A, g.Bt, T, g.N, g.K, g.lda, g.ldb, g.a_pn_step, 1}; pg8::LimitedOrder S; S.init(T, g.N, (int)gridDim.x, opaque_block(), 1);
      const int G_ = (int)gridDim.x, full_rounds = S.nwg / G_, left = S.nwg - full_rounds * G_;
      S.maxr = (WIN_TAIL && left * 4 < G_) ? full_rounds : full_rounds + 1;
      pg8::EpiConv E{c.Gb(), pin(P, I_FCW) + (size_t)l * 3 * DFF2, pin(P, I_FCB) + (size_t)l * DFF2, (float*)(c.ws_p() + WS_EDGE), (PG8_LAS unsigned*)(lds + 131072 + 1024)};
      pg8::gemm_phase<pg8::EpiConv, pg8::LimitedOrder, true, true>(lds, gg, S, E);
      if (S.maxr == full_rounds) {
        for (int su = opaque_block(); su < left * 16; su += G_) {
          pg8::StaticOrder S2; S2.init(T, g.N, G_, su >> 4, 1); pg8::Unit u; S2.next(full_rounds, u);
          win_subunit(g.A, g.Bt, pin(P, I_FCW) + (size_t)l * 3 * DFF2, pin(P, I_FCB) + (size_t)l * DFF2, c.Gb(), (float*)(c.ws_p() + WS_EDGE), (LAS unsigned char*)lds_raw, u.pm, u.pn, su & 15);
        }
      }
    } else {
    GEMM_STEP(s0 + 10); GSYNC();
    if (FAST_CONV) { for (int rep_ = 0; rep_ < 1 + REP_ELEM; ++rep_) ph_convgate(c.Ub(), pin(P, I_FCW) + (size_t)l * 3 * DFF2, pin(P, I_FCB) + (size_t)l * DFF2, c.Gb()); } else NAIVE(s0 + 11);
    }
    GSYNC();
    if (FUSE_CONV) {
      GemmDesc g; gemm_desc(s0 + 12, P, c, g); pg8::StaticOrder S; S.init(T, g.N, (int)gridDim.x, opaque_block(), g.ksplit); pg8::Unit u;
      for (int i = 0; S.next(i, u); ++i) conv_fixup_unit((const float*)(c.ws_p() + WS_EDGE), pin(P, I_FCW) + (size_t)l * 3 * DFF2, pin(P, I_FCB) + (size_t)l * DFF2, c.Gb(), u.pm, u.kh * (DFF / g.ksplit), DFF / g.ksplit);
      asm volatile("s_waitcnt vmcnt(0)" ::: "memory"); __syncthreads();
    }
    GEMM_STEP(s0 + 12); BG_AFTER_GEMM((T / 256) * (D / 256) * ((DFF % 256 == 0) ? KSPLIT : 1), 2800u);
    if (l < 3) GSYNC();
  }
  if (pend) {
    GSYNC();
    const WaveId w = wave_id();
    for (int t = w.gw; t < T; t += w.ngw) { f32x4* xr = (f32x4*)(c.X() + (size_t)t * D) + w.lane; const u32x2* pr = (const u32x2*)(pend + (size_t)t * D) + w.lane;
#pragma unroll
      for (int j = 0; j < 4; ++j) { const u32x2 q = pr[64 * j]; xr[64 * j] = xr[64 * j] + (f32x4){bf_lo(q.x), bf_hi(q.x), bf_lo(q.y), bf_hi(q.y)}; } }
  }
}
#endif

extern "C" void kernel_launch(void* const* d_in, const int* in_sizes, int n_in, void* d_out, int out_size, void* d_ws, size_t ws_size,
                              hipStream_t stream) {
  (void)in_sizes; (void)n_in; (void)out_size;
  Params P{};
  for (int i = 0; i < N_IN; ++i) P.in[i] = (const float*)d_in[i];
  P.out = (float*)d_out; P.ws = (unsigned char*)d_ws;
#ifdef HOST_EMU
  for (int step = 0; step < N_STEPS; ++step) { if (step_is_noop(step)) continue; emu_launch(256, 8, [&] { const Ctx c = make_ctx(P); naive_step(step, P, c); }); }
#else
  static int grid_blocks = 0;
  if (!grid_blocks) {
    if (ws_size < WS_END) { fprintf(stderr, "kernel_launch: workspace too small (%zu < %zu)\n", ws_size, (size_t)WS_END); grid_blocks = -1; return; }
    int dev = 0, cus = 0, per_cu = 0;
    (void)hipGetDevice(&dev);
    (void)hipDeviceGetAttribute(&cus, hipDeviceAttributeMultiprocessorCount, dev);
    (void)hipFuncSetAttribute((const void*)mega, hipFuncAttributeMaxDynamicSharedMemorySize, LDS_BYTES);
    (void)hipOccupancyMaxActiveBlocksPerMultiprocessor(&per_cu, mega, 512, LDS_BYTES);
    if (per_cu < 1) { fprintf(stderr, "kernel_launch: occupancy query says %d blocks per CU\n", per_cu); per_cu = 1; }
    if (per_cu > 1) per_cu = 1;
    grid_blocks = cus * per_cu;
  }
  if (grid_blocks < 0) return;
  if (hipMemsetAsync((char*)d_ws + WS_CTL, 0, CTL_ZERO_BYTES, stream) != hipSuccess) { fprintf(stderr, "kernel_launch: hipMemsetAsync of the control words failed\n"); return; }
  void* args[] = {&P};
  hipError_t e = hipLaunchCooperativeKernel((void*)mega, dim3(grid_blocks), dim3(512), args, LDS_BYTES, stream);
  if (e != hipSuccess) fprintf(stderr, "cooperative launch failed: %s (grid %d)\n", hipGetErrorString(e), grid_blocks);
#endif
}
```
